# Optimizing an MI355X kernel written in HIP

```python
import jax
import jax.numpy as jnp
from jax import lax
import numpy as np

D_MODEL = 1024
BATCH = 16
SEQ = 2048
DEPTH = 2

HEAD_DIM = 64
LRU_WIDTH = D_MODEL // 2
LRU_BLOCKS = 8
LRU_BLOCK_DIM = LRU_WIDTH // LRU_BLOCKS
CONV_WIDTH = 4
LRU_C = 8.0
NSA_HEADS = D_MODEL // 128
NSA_KV_HEADS = 2
NSA_GROUP = NSA_HEADS // NSA_KV_HEADS
NSA_WIDTH = NSA_HEADS * HEAD_DIM
NSA_KV_WIDTH = NSA_KV_HEADS * HEAD_DIM
CMP_LEN = 32
CMP_STRIDE = 16
SLC_LEN = 64
N_SELECT = 16
WINDOW = 512
SLC_Q_CHUNK = 32
FOX_HEADS = D_MODEL // 128
FOX_WIDTH = FOX_HEADS * HEAD_DIM
Q_BLOCK = 128
D_MIX = LRU_WIDTH + NSA_WIDTH + FOX_WIDTH
IN_SPLITS = (LRU_WIDTH, LRU_WIDTH,
             NSA_WIDTH, NSA_KV_WIDTH, NSA_KV_WIDTH, NSA_KV_WIDTH, NSA_KV_WIDTH, NSA_KV_WIDTH, NSA_KV_WIDTH,
             3 * NSA_HEADS, NSA_WIDTH,
             FOX_WIDTH, FOX_WIDTH, FOX_WIDTH, FOX_HEADS, FOX_WIDTH)
D_IN = sum(IN_SPLITS)
IN_OFFSETS = tuple(int(o) for o in np.cumsum(IN_SPLITS)[:-1])
NORM_EPS = 1e-6
NEG_INF = -1e30
FORCE_SCORE = 1e9
ATTN_SCALE = HEAD_DIM ** -0.5

kernel_name = 'hybrid_rglru_nsa_fox_block'


def rmsnorm(x, g):
    x32 = x.astype(jnp.float32)
    y = x32 * lax.rsqrt(jnp.mean(x32 * x32, axis=-1, keepdims=True) + NORM_EPS)
    return (y * g.astype(jnp.float32)).astype(x.dtype)


def split_heads(t, n_heads):
    return t.reshape(t.shape[0], t.shape[1], n_heads, HEAD_DIM)


def safe_softmax(s, mask):
    s = jnp.where(mask, s.astype(jnp.float32), NEG_INF)
    m = jnp.max(s, axis=-1, keepdims=True)
    e = jnp.where(mask, jnp.exp(s - m), 0.0)
    return e / jnp.maximum(jnp.sum(e, axis=-1, keepdims=True), 1e-30)


def linear_combine(c1, c2):
    a1, b1 = c1
    a2, b2 = c2
    return a1 * a2, a2 * b1 + b2


def rglru_group(u, z, conv_w, conv_b, wa, ba, wx, bx, lam):
    bsz, seq, width = u.shape
    u_pad = jnp.pad(u, ((0, 0), (CONV_WIDTH - 1, 0), (0, 0)))
    xc = conv_b + sum(u_pad[:, k:k + seq] * conv_w[k] for k in range(CONV_WIDTH))
    xh = xc.reshape(bsz, seq, LRU_BLOCKS, LRU_BLOCK_DIM)
    r = jax.nn.sigmoid(jnp.einsum('bshi,hij->bshj', xh, wa).reshape(bsz, seq, width) + ba)
    i = jax.nn.sigmoid(jnp.einsum('bshi,hij->bshj', xh, wx).reshape(bsz, seq, width) + bx)
    log_a = -LRU_C * r.astype(jnp.float32) * jax.nn.softplus(-lam.astype(jnp.float32))
    a = jnp.exp(log_a)
    b = jnp.sqrt(-jnp.expm1(2.0 * log_a)) * (i * xc).astype(jnp.float32)
    _, h = lax.associative_scan(linear_combine, (a, b), axis=1)
    return h.astype(u.dtype) * jax.nn.silu(z)


def nsa_compressed(q, kc, vc, pe_k, pe_v, wck, wcv, k_g):
    bsz, seq = kc.shape[0], kc.shape[1]
    n_cmp = (seq - CMP_LEN) // CMP_STRIDE + 1
    n_slc = seq // SLC_LEN
    starts = jnp.arange(n_cmp) * CMP_STRIDE
    tok = starts[:, None] + jnp.arange(CMP_LEN)[None, :]
    k_cmp = jnp.einsum('bnlgd,lde->bnge', kc[:, tok] + pe_k[:, None, :], wck)
    v_cmp = jnp.einsum('bnlgd,lde->bnge', vc[:, tok] + pe_v[:, None, :], wcv)
    k_cmp = rmsnorm(k_cmp, k_g)
    qg = q.reshape(bsz, seq, NSA_KV_HEADS, NSA_GROUP, HEAD_DIM)
    s = jnp.einsum('bsgrd,bngd->bgrsn', qg, k_cmp) * ATTN_SCALE
    t = jnp.arange(seq)
    mask = (starts + CMP_LEN - 1)[None, :] <= t[:, None]
    p = safe_softmax(s, mask)
    o = jnp.einsum('bgrsn,bngd->bsgrd', p, v_cmp).reshape(bsz, seq, NSA_HEADS, HEAD_DIM)
    slc_starts = jnp.arange(n_slc) * SLC_LEN
    overlap = ((starts[:, None] <= slc_starts[None, :] + SLC_LEN - 1)
               & (starts[:, None] + CMP_LEN - 1 >= slc_starts[None, :])).astype(jnp.float32)
    importance = jnp.einsum('bgrsn,nj->bgsj', p, overlap)
    return o.astype(q.dtype), importance


def nsa_selected(q, ks, vs, importance):
    bsz, seq = ks.shape[0], ks.shape[1]
    n_slc = seq // SLC_LEN
    k_sel = min(N_SELECT, n_slc)
    t = jnp.arange(seq)
    blk_t = t // SLC_LEN
    j = jnp.arange(n_slc)
    valid = j[None, :] <= blk_t[:, None]
    forced = (j[None, :] == 0) | (j[None, :] == blk_t[:, None]) | (j[None, :] == blk_t[:, None] - 1)
    score = jnp.where(valid, jnp.where(forced, FORCE_SCORE, importance), NEG_INF)
    vals, idx = lax.top_k(score, k_sel)
    sel_ok = vals > 0.5 * NEG_INF
    ks_blk = ks.reshape(bsz, n_slc, SLC_LEN, NSA_KV_HEADS, HEAD_DIM).transpose(0, 3, 1, 2, 4)
    vs_blk = vs.reshape(bsz, n_slc, SLC_LEN, NSA_KV_HEADS, HEAD_DIM).transpose(0, 3, 1, 2, 4)
    n_chunk = seq // SLC_Q_CHUNK
    q_c = q.reshape(bsz, n_chunk, SLC_Q_CHUNK, NSA_KV_HEADS, NSA_GROUP, HEAD_DIM).transpose(1, 0, 2, 3, 4, 5)
    idx_c = idx.reshape(bsz, NSA_KV_HEADS, n_chunk, SLC_Q_CHUNK, k_sel).transpose(2, 0, 1, 3, 4)
    ok_c = sel_ok.reshape(bsz, NSA_KV_HEADS, n_chunk, SLC_Q_CHUNK, k_sel).transpose(2, 0, 1, 3, 4)
    t_c = t.reshape(n_chunk, SLC_Q_CHUNK)
    bi = jnp.arange(bsz)[:, None, None, None]
    gi = jnp.arange(NSA_KV_HEADS)[None, :, None, None]

    def chunk(args):
        qb, ib, okb, tb = args
        kk = ks_blk[bi, gi, ib]
        vv = vs_blk[bi, gi, ib]
        s = jnp.einsum('bcgrd,bgcknd->bgrckn', qb, kk) * ATTN_SCALE
        pos = ib[..., None] * SLC_LEN + jnp.arange(SLC_LEN)
        mask = okb[..., None] & (pos <= tb[None, None, :, None, None])
        s = s.reshape(bsz, NSA_KV_HEADS, NSA_GROUP, SLC_Q_CHUNK, k_sel * SLC_LEN)
        mask = mask.reshape(bsz, NSA_KV_HEADS, 1, SLC_Q_CHUNK, k_sel * SLC_LEN)
        p = safe_softmax(s, mask)
        vv = vv.reshape(bsz, NSA_KV_HEADS, SLC_Q_CHUNK, k_sel * SLC_LEN, HEAD_DIM)
        return jnp.einsum('bgrcm,bgcmd->bcgrd', p, vv).astype(q.dtype)

    o = lax.map(chunk, (q_c, idx_c, ok_c, t_c))
    return o.transpose(1, 0, 2, 3, 4, 5).reshape(bsz, seq, NSA_HEADS, HEAD_DIM)


def nsa_window(q, kw, vw):
    bsz, seq = kw.shape[0], kw.shape[1]
    n_blk = seq // Q_BLOCK
    span = Q_BLOCK + WINDOW
    k_pad = jnp.pad(kw, ((0, 0), (WINDOW, 0), (0, 0), (0, 0)))
    v_pad = jnp.pad(vw, ((0, 0), (WINDOW, 0), (0, 0), (0, 0)))
    q_b = q.reshape(bsz, n_blk, Q_BLOCK, NSA_KV_HEADS, NSA_GROUP, HEAD_DIM).transpose(1, 0, 2, 3, 4, 5)

    def blk(args):
        b_idx, qb = args
        start = b_idx * Q_BLOCK
        kb = lax.dynamic_slice_in_dim(k_pad, start, span, axis=1)
        vb = lax.dynamic_slice_in_dim(v_pad, start, span, axis=1)
        t = start + jnp.arange(Q_BLOCK)
        s_pos = start - WINDOW + jnp.arange(span)
        diff = t[:, None] - s_pos[None, :]
        mask = (s_pos[None, :] >= 0) & (diff >= 0) & (diff < WINDOW)
        s = jnp.einsum('bqgrd,bkgd->bgrqk', qb, kb) * ATTN_SCALE
        p = safe_softmax(s, mask)
        return jnp.einsum('bgrqk,bkgd->bqgrd', p, vb).astype(q.dtype)

    o = lax.map(blk, (jnp.arange(n_blk), q_b))
    return o.transpose(1, 0, 2, 3, 4, 5).reshape(bsz, seq, NSA_HEADS, HEAD_DIM)


def nsa_group(q, kc, vc, ks, vs, kw, vw, gate_logits, z, q_g, k_g, pe_k, pe_v, wck, wcv, gate_b):
    bsz, seq = q.shape[0], q.shape[1]
    q = rmsnorm(split_heads(q, NSA_HEADS), q_g)
    kc, vc, ks, vs, kw, vw = (split_heads(t, NSA_KV_HEADS) for t in (kc, vc, ks, vs, kw, vw))
    o_cmp, importance = nsa_compressed(q, kc, vc, pe_k, pe_v, wck, wcv, k_g[0])
    o_slc = nsa_selected(q, rmsnorm(ks, k_g[1]), vs, importance)
    o_win = nsa_window(q, rmsnorm(kw, k_g[2]), vw)
    g = jax.nn.sigmoid(gate_logits + gate_b).reshape(bsz, seq, NSA_HEADS, 3)
    o = g[..., 0:1] * o_cmp + g[..., 1:2] * o_slc + g[..., 2:3] * o_win
    return o.reshape(bsz, seq, NSA_WIDTH).astype(z.dtype) * jax.nn.silu(z)


def fox_group(q, k, v, f_logits, z, q_g, k_g, f_b):
    bsz, seq = q.shape[0], q.shape[1]
    q = rmsnorm(split_heads(q, FOX_HEADS), q_g)
    k = rmsnorm(split_heads(k, FOX_HEADS), k_g)
    v = split_heads(v, FOX_HEADS)
    log_f = jax.nn.log_sigmoid(f_logits.astype(jnp.float32) + f_b.astype(jnp.float32))
    c = jnp.cumsum(log_f, axis=1).transpose(0, 2, 1)
    n_blk = seq // Q_BLOCK
    q_b = q.reshape(bsz, n_blk, Q_BLOCK, FOX_HEADS, HEAD_DIM).transpose(1, 0, 2, 3, 4)
    c_b = c.reshape(bsz, FOX_HEADS, n_blk, Q_BLOCK).transpose(2, 0, 1, 3)
    s_pos = jnp.arange(seq)

    def blk(args):
        b_idx, qb, cb = args
        t = b_idx * Q_BLOCK + jnp.arange(Q_BLOCK)
        s = (jnp.einsum('bqhd,bshd->bhqs', qb, k).astype(jnp.float32) * ATTN_SCALE
             + cb[..., None] - c[:, :, None, :])
        mask = s_pos[None, :] <= t[:, None]
        p = safe_softmax(s, mask)
        return jnp.einsum('bhqs,bshd->bqhd', p, v).astype(q.dtype)

    o = lax.map(blk, (jnp.arange(n_blk), q_b, c_b))
    o = o.transpose(1, 0, 2, 3, 4).reshape(bsz, seq, FOX_WIDTH)
    return o.astype(z.dtype) * jax.nn.silu(z)


def hybrid_layer(x, norm_g, w_in, w_out, conv_w, conv_b, lru_wa, lru_ba, lru_wx, lru_bx, lru_lambda,
                 nsa_q_g, nsa_k_g, cmp_pe_k, cmp_pe_v, cmp_wk, cmp_wv, nsa_gate_b,
                 fox_q_g, fox_k_g, fox_f_b):
    h = rmsnorm(x, norm_g)
    proj = jnp.einsum('bsd,de->bse', h, w_in)
    (lru_u, lru_z, nsa_q, nsa_kc, nsa_vc, nsa_ks, nsa_vs, nsa_kw, nsa_vw, nsa_gl, nsa_z,
     fox_q, fox_k, fox_v, fox_fl, fox_z) = jnp.split(proj, IN_OFFSETS, axis=-1)
    y_lru = rglru_group(lru_u, lru_z, conv_w, conv_b, lru_wa, lru_ba, lru_wx, lru_bx, lru_lambda)
    y_nsa = nsa_group(nsa_q, nsa_kc, nsa_vc, nsa_ks, nsa_vs, nsa_kw, nsa_vw, nsa_gl, nsa_z,
                      nsa_q_g, nsa_k_g, cmp_pe_k, cmp_pe_v, cmp_wk, cmp_wv, nsa_gate_b)
    y_fox = fox_group(fox_q, fox_k, fox_v, fox_fl, fox_z, fox_q_g, fox_k_g, fox_f_b)
    y = jnp.concatenate([y_lru, y_nsa, y_fox], axis=-1)
    return x + jnp.einsum('bse,ed->bsd', y, w_out)


def setup_inputs(seed: int = 0) -> dict:
    key = jax.random.key(seed)
    ks = jax.random.split(key, 22)
    f32 = jnp.float32

    def nrm(k, shape, scale):
        return jax.random.normal(k, shape, f32) * scale

    L = DEPTH
    a0 = jax.random.uniform(ks[10], (L, LRU_WIDTH), f32, 0.9, 0.999)
    return {
        'x': nrm(ks[0], (BATCH, SEQ, D_MODEL), 1.0),
        'norm_g': 1.0 + nrm(ks[1], (L, D_MODEL), 0.1),
        'w_in': nrm(ks[2], (L, D_MODEL, D_IN), D_MODEL ** -0.5),
        'w_out': nrm(ks[3], (L, D_MIX, D_MODEL), D_MIX ** -0.5),
        'conv_w': nrm(ks[4], (L, CONV_WIDTH, LRU_WIDTH), CONV_WIDTH ** -0.5),
        'conv_b': nrm(ks[5], (L, LRU_WIDTH), 0.02),
        'lru_wa': nrm(ks[6], (L, LRU_BLOCKS, LRU_BLOCK_DIM, LRU_BLOCK_DIM), LRU_BLOCK_DIM ** -0.5),
        'lru_ba': nrm(ks[7], (L, LRU_WIDTH), 0.1),
        'lru_wx': nrm(ks[8], (L, LRU_BLOCKS, LRU_BLOCK_DIM, LRU_BLOCK_DIM), LRU_BLOCK_DIM ** -0.5),
        'lru_bx': nrm(ks[9], (L, LRU_WIDTH), 0.1),
        'lru_lambda': jnp.log(a0) - jnp.log1p(-a0),
        'nsa_q_g': 1.0 + nrm(ks[11], (L, HEAD_DIM), 0.1),
        'nsa_k_g': 1.0 + nrm(ks[12], (L, 3, HEAD_DIM), 0.1),
        'cmp_pe_k': nrm(ks[13], (L, CMP_LEN, HEAD_DIM), 0.1),
        'cmp_pe_v': nrm(ks[14], (L, CMP_LEN, HEAD_DIM), 0.1),
        'cmp_wk': nrm(ks[15], (L, CMP_LEN, HEAD_DIM, HEAD_DIM), (CMP_LEN * HEAD_DIM) ** -0.5),
        'cmp_wv': nrm(ks[16], (L, CMP_LEN, HEAD_DIM, HEAD_DIM), (CMP_LEN * HEAD_DIM) ** -0.5),
        'nsa_gate_b': nrm(ks[17], (L, 3 * NSA_HEADS), 0.1),
        'fox_q_g': 1.0 + nrm(ks[18], (L, HEAD_DIM), 0.1),
        'fox_k_g': 1.0 + nrm(ks[19], (L, HEAD_DIM), 0.1),
        'fox_f_b': 2.0 + nrm(ks[20], (L, FOX_HEADS), 0.5),
    }


def reference(x, norm_g, w_in, w_out, conv_w, conv_b, lru_wa, lru_ba, lru_wx, lru_bx, lru_lambda,
              nsa_q_g, nsa_k_g, cmp_pe_k, cmp_pe_v, cmp_wk, cmp_wv, nsa_gate_b,
              fox_q_g, fox_k_g, fox_f_b):
    for l in range(DEPTH):
        x = hybrid_layer(x, norm_g[l], w_in[l], w_out[l], conv_w[l], conv_b[l], lru_wa[l], lru_ba[l],
                         lru_wx[l], lru_bx[l], lru_lambda[l], nsa_q_g[l], nsa_k_g[l], cmp_pe_k[l],
                         cmp_pe_v[l], cmp_wk[l], cmp_wv[l], nsa_gate_b[l], fox_q_g[l], fox_k_g[l],
                         fox_f_b[l])
    return x
```

```cpp
#define DUP 0
#include <hip/hip_runtime.h>
#include <hip/hip_cooperative_groups.h>
#include <stdint.h>
#include <stdio.h>
namespace cg = cooperative_groups;

#define DI __device__ __forceinline__
typedef unsigned short bf16_t;
typedef short bf16x8 __attribute__((ext_vector_type(8)));
typedef float f32x4 __attribute__((ext_vector_type(4)));
typedef float f32x16 __attribute__((ext_vector_type(16)));
typedef unsigned u32x4 __attribute__((ext_vector_type(4)));
typedef unsigned u32x2 __attribute__((ext_vector_type(2)));

constexpr int NB = 16, SEQ = 2048, DM = 1024, NT = NB * SEQ;
constexpr int DIN = 4896, DMIX = 1536, PP = 4864, NPAD = 5120;
constexpr int C_U = 0, C_Z = 512, C_NQ = 1024, C_KC = 1536, C_VC = 1664, C_KS = 1792, C_VS = 1920, C_KW = 2048, C_VW = 2176,
              C_NZ = 2304, C_FQ = 2816, C_FK = 3328, C_FV = 3840, C_FZ = 4352;
constexpr float LOG2E = 1.4426950408889634f, QS = 0.125f * LOG2E, EPS = 1e-6f;

constexpr size_t WS_P = 0;
constexpr size_t WS_HY = WS_P + (size_t)NT * PP * 2;
constexpr size_t WS_H = WS_HY + (size_t)NT * DMIX * 2;
constexpr size_t WS_SS = WS_H + (size_t)NT * DM * 2;
constexpr size_t WS_GL = WS_SS + (size_t)NT * 4;
constexpr size_t WS_WIN = WS_GL + (size_t)NT * 32 * 4;
constexpr size_t WS_WOUT = WS_WIN + (size_t)2 * NPAD * DM * 2;
constexpr size_t WS_WA = WS_WOUT + (size_t)2 * DM * DMIX * 2;
constexpr size_t WS_WX = WS_WA + 131072;
constexpr size_t WS_WCK = WS_WX + 131072;
constexpr size_t WS_WCV = WS_WCK + 524288;
constexpr size_t WS_BKV = WS_WCV + 524288;
constexpr size_t WS_BND = WS_BKV + 1024;
constexpr size_t WS_GAINS = WS_BKV + 2048;
constexpr size_t WS_C2 = WS_BKV + 8192;
constexpr size_t WS_KCMP = WS_C2 + (size_t)NB * 8 * SEQ * 4;
constexpr size_t WS_VCMP = WS_KCMP + 524288;
constexpr size_t WS_CTL = WS_VCMP + 524288;
constexpr size_t WS_CTL_BYTES = 16384;
constexpr size_t WS_END = WS_CTL + WS_CTL_BYTES;

constexpr int LDS_BYTES = 143360;

struct Args { const float* in[21]; float* out; unsigned char* ws; int ph_lo, ph_hi; };
enum { I_X = 0, I_NG, I_WIN, I_WOUT, I_CW, I_CB, I_WA, I_BA, I_WX, I_BX, I_LAM, I_NQG, I_NKG, I_PEK, I_PEV, I_WCK, I_WCV, I_GB, I_FQG, I_FKG, I_FFB };

DI int opaque_tid() { int t = threadIdx.x; asm volatile("" : "+v"(t)); return t; }
DI unsigned f2bf(float f) { unsigned u = __float_as_uint(f); return (u + 0x7fffu + ((u >> 16) & 1u)) >> 16; }
DI float bf2f(unsigned h) { return __uint_as_float(h << 16); }
DI unsigned pk2(float lo, float hi) { return f2bf(lo) | (f2bf(hi) << 16); }
DI float wave_sum(float v) { for (int o = 32; o; o >>= 1) v += __shfl_xor(v, o); return v; }
DI float sigmoidf_(float x) { return 1.f / (1.f + __expf(-x)); }
DI float siluf_(float x) { return x / (1.f + __expf(-x)); }
DI void unpack8(u32x4 r, float* f) {
#pragma unroll
    for (int i = 0; i < 4; ++i) { f[2 * i] = bf2f(r[i] & 0xffffu); f[2 * i + 1] = bf2f(r[i] >> 16); }
}

DI int win_col(int pc) {
    if (pc < 2304) return pc; if (pc < 4352) return pc + 24; if (pc < 4864) return pc + 32;
    if (pc < 4888) return 2304 + pc - 4864; if (pc < 4896) return 4376 + pc - 4888; return -1;
}
DI void wtile(const float* src, int ldsrc, bf16_t* dst, int K, int n0, int k0, int mode, float* t) {
    const int tid = opaque_tid();
#pragma unroll
    for (int i = 0; i < 8; ++i) {
        int kk = (tid >> 6) + 8 * i, nn = tid & 63, n = n0 + nn; int oc = mode ? win_col(n) : n;
        t[kk * 65 + nn] = oc >= 0 ? src[(size_t)(k0 + kk) * ldsrc + oc] : 0.f;
    }
    __syncthreads();
    {   const int nn = tid >> 3, k8 = (tid & 7) * 8; u32x4 w;
#pragma unroll
        for (int i = 0; i < 4; ++i) w[i] = pk2(t[(k8 + 2 * i) * 65 + nn], t[(k8 + 2 * i + 1) * 65 + nn]);
        *(u32x4*)(dst + (size_t)(n0 + nn) * K + k0 + k8) = w; }
    __syncthreads();
}
DI void wtile4(const float* src, int ldsrc, bf16_t* dst, int K, int n0, int k0, int mode, float* t  ) {
    const int tid = opaque_tid();
#pragma unroll
    for (int i = 0; i < 8; ++i)
#pragma unroll
        for (int q = 0; q < 4; ++q) {
            const int kk = (tid >> 6) + 8 * i, nn = (tid & 63) + 64 * q, n = n0 + nn; const int oc = mode ? win_col(n) : n;
            t[kk * 257 + nn] = oc >= 0 ? src[(size_t)(k0 + kk) * ldsrc + oc] : 0.f;
        }
    __syncthreads();
#pragma unroll
    for (int q = 0; q < 4; ++q) { const int nn = (tid >> 3) + 64 * q, k8 = (tid & 7) * 8; u32x4 w;
#pragma unroll
        for (int i = 0; i < 4; ++i) w[i] = pk2(t[(k8 + 2 * i) * 257 + nn], t[(k8 + 2 * i + 1) * 257 + nn]);
        *(u32x4*)(dst + (size_t)(n0 + nn) * K + k0 + k8) = w; }
    __syncthreads();
}
DI void phase_wprep(const Args& a, float* ldsf) {
    unsigned char* ws = a.ws;
    constexpr int PER = 320 + 96 + 8 + 8 + 32 + 32 + 2;
    for (int u = blockIdx.x; u < 2 * PER; u += gridDim.x) {
        int l = u / PER, r = u % PER;
        if (r < 320 && l == 1 && gridDim.x >= 256) continue;
        if (r < 320) { wtile4(a.in[I_WIN] + (size_t)l * DM * DIN, DIN, (bf16_t*)(ws + WS_WIN) + (size_t)l * NPAD * DM, DM, (r % 20) * 256, (r / 20) * 64, 1, ldsf); continue; }
        r -= 320;
        if (r < 96) { wtile4(a.in[I_WOUT] + (size_t)l * DMIX * DM, DM, (bf16_t*)(ws + WS_WOUT) + (size_t)l * DM * DMIX, DMIX, (r % 4) * 256, (r / 4) * 64, 0, ldsf); continue; }
        r -= 96;
        if (r < 8) { wtile(a.in[I_WA] + (size_t)(l * 8 + r) * 4096, 64, (bf16_t*)(ws + WS_WA) + (size_t)(l * 8 + r) * 4096, 64, 0, 0, 0, ldsf); continue; }
        r -= 8;
        if (r < 8) { wtile(a.in[I_WX] + (size_t)(l * 8 + r) * 4096, 64, (bf16_t*)(ws + WS_WX) + (size_t)(l * 8 + r) * 4096, 64, 0, 0, 0, ldsf); continue; }
        r -= 8;
        if (r < 32) { wtile(a.in[I_WCK] + (size_t)l * 131072, 64, (bf16_t*)(ws + WS_WCK) + (size_t)l * 131072, 2048, 0, r * 64, 0, ldsf); continue; }
        r -= 32;
        if (r < 32) { wtile(a.in[I_WCV] + (size_t)l * 131072, 64, (bf16_t*)(ws + WS_WCV) + (size_t)l * 131072, 2048, 0, r * 64, 0, ldsf); continue; }
        r -= 32;
        {
            const float* pe = a.in[r ? I_PEV : I_PEK] + (size_t)l * 2048; const float* w = a.in[r ? I_WCV : I_WCK] + (size_t)l * 131072;
            const int e = threadIdx.x & 63, part = threadIdx.x >> 6; float s = 0.f;
#pragma unroll 16
            for (int k = part * 256; k < part * 256 + 256; ++k) s += pe[k] * w[(size_t)k * 64 + e];
            ldsf[part * 64 + e] = s; __syncthreads();
            if (threadIdx.x < 64) { float t = 0.f; for (int p = 0; p < 8; ++p) t += ldsf[p * 64 + e]; ((float*)(ws + WS_BKV))[(l * 2 + r) * 64 + e] = t; }
            if (r == 1 && threadIdx.x < 64) { float* gn = (float*)(ws + WS_GAINS) + l * 320;
                gn[e] = a.in[I_NQG][l * 64 + e] * QS; gn[64 + e] = a.in[I_NKG][(l * 3 + 1) * 64 + e]; gn[128 + e] = a.in[I_NKG][(l * 3 + 2) * 64 + e]; gn[192 + e] = a.in[I_FQG][l * 64 + e] * QS; gn[256 + e] = a.in[I_FKG][l * 64 + e]; }
            if (r == 0 && threadIdx.x < 64) {
                float gq = fabsf(a.in[I_NQG][l * 64 + e]), k0 = fabsf(a.in[I_NKG][(l * 3 + 0) * 64 + e]), k1 = fabsf(a.in[I_NKG][(l * 3 + 1) * 64 + e]), k2 = fabsf(a.in[I_NKG][(l * 3 + 2) * 64 + e]);
                float fq = fabsf(a.in[I_FQG][l * 64 + e]), fk = fabsf(a.in[I_FKG][l * 64 + e]);
                for (int o = 32; o; o >>= 1) { gq = fmaxf(gq, __shfl_xor(gq, o)); k0 = fmaxf(k0, __shfl_xor(k0, o)); k1 = fmaxf(k1, __shfl_xor(k1, o)); k2 = fmaxf(k2, __shfl_xor(k2, o)); fq = fmaxf(fq, __shfl_xor(fq, o)); fk = fmaxf(fk, __shfl_xor(fk, o)); }
                if (e == 0) { float* bnd = (float*)(ws + WS_BND) + l * 4; bnd[0] = QS * 64.f * gq * k0 * 1.01f + 0.5f; bnd[1] = QS * 64.f * gq * k1 * 1.01f + 0.5f; bnd[2] = QS * 64.f * gq * k2 * 1.01f + 0.5f; bnd[3] = QS * 64.f * fq * fk * 1.01f + 0.5f; }
            }
            __syncthreads();
        }
    }
}

DI void win1_late(const Args& a, float* ldsf) {
    if (gridDim.x < 256 || blockIdx.x < 128) return;
    for (int r = (int)blockIdx.x - 128; r < 1280; r += (int)gridDim.x - 128)
        wtile(a.in[I_WIN] + (size_t)DM * DIN, DIN, (bf16_t*)(a.ws + WS_WIN) + (size_t)NPAD * DM, DM, (r % 80) * 64, (r / 80) * 64, 1, ldsf);
}

DI void phase_rms(const float* x, const float* g, bf16_t* H) {
    const int tid_ = opaque_tid(); const int lane = tid_ & 63, wid = tid_ >> 6;
    const int stride = gridDim.x * 8;
    int row = blockIdx.x * 8 + wid;
    f32x4 v[4], vn[4];
    if (row < NT) {
#pragma unroll
        for (int i = 0; i < 4; ++i) vn[i] = ((const f32x4*)(x + (size_t)row * DM))[lane + 64 * i];
    }
    for (; row < NT; row += stride) {
#pragma unroll
        for (int i = 0; i < 4; ++i) v[i] = vn[i];
        if (row + stride < NT) {
#pragma unroll
            for (int i = 0; i < 4; ++i) vn[i] = ((const f32x4*)(x + (size_t)(row + stride) * DM))[lane + 64 * i];
        }
        float ss = 0.f;
#pragma unroll
        for (int i = 0; i < 4; ++i) ss += v[i][0] * v[i][0] + v[i][1] * v[i][1] + v[i][2] * v[i][2] + v[i][3] * v[i][3];
        ss = wave_sum(ss);
        const float r = rsqrtf(ss * (1.f / DM) + EPS);
#pragma unroll
        for (int i = 0; i < 4; ++i) {
            const f32x4 gg = ((const f32x4*)g)[lane + 64 * i];
            u32x2 o; o[0] = pk2(v[i][0] * r * gg[0], v[i][1] * r * gg[1]); o[1] = pk2(v[i][2] * r * gg[2], v[i][3] * r * gg[3]);
            *(u32x2*)(H + (size_t)row * DM + (lane + 64 * i) * 4) = o;
        }
    }
}

namespace pg8 {
#define PG8_LAS __attribute__((address_space(3)))
typedef unsigned short bf16_t;
typedef short bf16x8 __attribute__((ext_vector_type(8)));
typedef float f32x4 __attribute__((ext_vector_type(4)));
typedef unsigned u32x4 __attribute__((ext_vector_type(4)));
constexpr int BM = 256, BK = 64, HALF = 128, HTB = HALF * BK * 2  , STAGE_BYTES = 8 * HTB, NXCD = 8, WGM = 8;

__host__ __device__ __forceinline__ int lds_byte(int r, int c) { const int st = (r >> 4) * 2 + (c >> 5), rr = r & 15, cc = c & 31, ob = rr * 64 + cc * 2; return st * 1024 + (ob ^ (((ob >> 9) & 1) << 5)); }
__host__ __device__ __forceinline__ void stage_rc(int b, int& R, int& C) { const int st = b / 1024, sb = b % 1024, swz = sb ^ (((sb >> 9) & 1) << 5); R = (st >> 1) * 16 + swz / 64; C = (st & 1) * 32 + (swz % 64) / 2; }
__host__ __device__ __forceinline__ int perm32(int rho) { const int n = rho >> 4, i = rho & 15; return 8 * (i >> 2) + 4 * n + (i & 3); }

struct Unit { int pm, pn; };
struct Gemm { const bf16_t* A; const bf16_t* Bt; int M, N, K; };

struct StaticOrder {
    int nM, nN, nwg, G, c;
    __host__ __device__ void init(int M, int N, int G_, int c_) { nM = M / BM; nN = N / BM; nwg = nM * nN; G = G_; c = c_; }
    __host__ __device__ bool next(int i, Unit& u) const {
        const long L = (long)i * G + c; if (L >= nwg) return false;
        int wgid = (int)L; { const int q = nwg / NXCD, r = nwg % NXCD, xcd = wgid % NXCD, off = wgid / NXCD; wgid = (xcd < r ? xcd * (q + 1) : r * (q + 1) + (xcd - r) * q) + off; }
        const int nig = WGM * nN, gid = wgid / nig, fm = gid * WGM, gsz = (nM - fm) < WGM ? (nM - fm) : WGM;
        u.pm = fm + ((wgid % nig) % gsz); u.pn = (wgid % nig) / gsz; return true;
    }
    __device__ __forceinline__ void a_ready(const Unit&) const {}
    __device__ __forceinline__ void done(const Unit&) const {}
};
__device__ __forceinline__ unsigned cvt_pk_bf16(float lo, float hi) { unsigned r; asm volatile("v_cvt_pk_bf16_f32 %0, %1, %2" : "=v"(r) : "v"(lo), "v"(hi)); return r; }

struct EpiProjF {
    static constexpr bool PERM = true, AFTER_DRAIN = false;
    bf16_t* P; const float* ss; PG8_LAS float* xs  ; const float* gains  ;
    __device__ __forceinline__ void operator()(const f32x4 (&acc)[2][2][4][2], const Unit& u, int wr, int wc, int fr, int fq) const {
        const int row0 = u.pm * BM + wr * 64 + fr;
        const int col0 = u.pn * BM + wc * 32 + 8 * fq;
        const int pn = u.pn, wid = wr * 4 + wc;
        const bool need = (pn == 4) | (pn == 5) | (pn == 7) | (pn == 8) | ((pn >= 11) & (pn <= 14));
        float hs[2][4][2];
        if (need) {
#pragma unroll
            for (int ai = 0; ai < 2; ++ai)
#pragma unroll
                for (int m = 0; m < 4; ++m)
#pragma unroll
                    for (int bj = 0; bj < 2; ++bj) { const f32x4 v0 = acc[ai][bj][m][0], v1 = acc[ai][bj][m][1];
                        float s = v0[0] * v0[0] + v0[1] * v0[1] + v0[2] * v0[2] + v0[3] * v0[3] + v1[0] * v1[0] + v1[1] * v1[1] + v1[2] * v1[2] + v1[3] * v1[3];
                        s += __shfl_xor(s, 16); s += __shfl_xor(s, 32);
                        hs[ai][m][bj] = s;
                        if (fq == 0) xs[(((wid * 2 + ai) * 4 + m) * 2 + bj) * 16 + fr] = s; }
            asm volatile("s_waitcnt lgkmcnt(0)" ::: "memory");
            __builtin_amdgcn_s_barrier();
        }
        const int kind = (pn <= 5) ? 0 : (pn == 7) ? 1 : (pn == 8) ? 2 : (pn <= 12) ? 3 : 4;
#pragma unroll
        for (int bj = 0; bj < 2; ++bj) {
            const bool hn = need && !((pn == 7 || pn == 8) && bj == 1);
            f32x4 g0 = (f32x4){1.f, 1.f, 1.f, 1.f}, g1 = g0;
            if (hn) { g0 = *(const f32x4*)(gains + kind * 64 + (wc & 1) * 32 + 8 * fq); g1 = *(const f32x4*)(gains + kind * 64 + (wc & 1) * 32 + 8 * fq + 4); }
#pragma unroll
            for (int ai = 0; ai < 2; ++ai)
#pragma unroll
                for (int m = 0; m < 4; ++m) { const int row = row0 + ai * HALF + m * 16;
                    const float rr = ss ? rsqrtf(ss[row] * (1.f / 1024) + 1e-6f) : 1.f;
                    float rs = rr;
                    if (hn) { const float tot = (hs[ai][m][bj] + xs[((((wid ^ 1) * 2 + ai) * 4 + m) * 2 + bj) * 16 + fr]) * rr * rr; rs = rr * rsqrtf(tot * (1.f / 64) + 1e-6f); }
                    const f32x4 v0 = acc[ai][bj][m][0] * rs * g0, v1 = acc[ai][bj][m][1] * rs * g1;
                    u32x4 w; w.x = cvt_pk_bf16(v0[0], v0[1]); w.y = cvt_pk_bf16(v0[2], v0[3]); w.z = cvt_pk_bf16(v1[0], v1[1]); w.w = cvt_pk_bf16(v1[2], v1[3]);
                    *(u32x4*)(P + (size_t)row * 4864 + col0 + bj * HALF) = w; }
        }
    }
};
struct EpiOutF {
    static constexpr bool PERM = true, AFTER_DRAIN = false;
    const float* res; float* out; bf16_t* Hn; const float* g; float* ss;
    __device__ __forceinline__ void operator()(const f32x4 (&acc)[2][2][4][2], const Unit& u, int wr, int wc, int fr, int fq) const {
        const int row0 = u.pm * BM + wr * 64 + fr, col0 = u.pn * BM + wc * 32 + 8 * fq;
#pragma unroll
        for (int ai = 0; ai < 2; ++ai)
#pragma unroll
            for (int m = 0; m < 4; ++m) { const int row = row0 + ai * HALF + m * 16; const size_t off = (size_t)row * 1024 + col0;
                float sq = 0.f;
#pragma unroll
                for (int bj = 0; bj < 2; ++bj) { unsigned w[4];
#pragma unroll
                    for (int n = 0; n < 2; ++n) { const f32x4 o = *(const f32x4*)(res + off + bj * HALF + 4 * n) + acc[ai][bj][m][n];
                        *(f32x4*)(out + off + bj * HALF + 4 * n) = o;
                        if (Hn) { sq += o[0] * o[0] + o[1] * o[1] + o[2] * o[2] + o[3] * o[3]; const f32x4 h = o * *(const f32x4*)(g + col0 + bj * HALF + 4 * n);
                            w[2 * n] = cvt_pk_bf16(h[0], h[1]); w[2 * n + 1] = cvt_pk_bf16(h[2], h[3]); } }
                    if (Hn) *(u32x4*)(Hn + off + bj * HALF) = (u32x4){w[0], w[1], w[2], w[3]};
                    __builtin_amdgcn_sched_barrier(0); }
                if (Hn) { sq += __shfl_xor(sq, 16); sq += __shfl_xor(sq, 32); if (fq == 0) atomicAdd(ss + row, sq); } }
    }
};

template <class Epi, class Sched, bool ALIGN_EPI = false, bool SP2 = false>
__device__ __forceinline__ void gemm_phase(PG8_LAS unsigned char* lds, const Gemm g, const Sched& S, const Epi& E) {
    int tid = threadIdx.x; asm volatile("" : "+v"(tid));
    const int wid = __builtin_amdgcn_readfirstlane(tid >> 6), lane = tid & 63, wr = wid >> 2, wc = wid & 3, fr = lane & 15, fq = lane >> 4;
    const int K = g.K, nt = K / BK;
    unsigned voffA[2], voffB[2];
#pragma unroll
    for (int i = 0; i < 2; ++i) { int R, C; stage_rc(tid * 16 + i * 8192, R, C); const int Rb = Epi::PERM ? ((R & ~31) + perm32(R & 31)) : R;
        voffA[i] = (unsigned)(R * K + C) * 2u; voffB[i] = (unsigned)(Rb * K + C) * 2u; }
    const size_t kstep = (size_t)(BK * 2);
    const size_t hstep = (size_t)HALF * K * 2;
    const size_t tstep = 2 * hstep;
    const unsigned ldsw = (unsigned)wid * 1024u;
    const int aoff = lds_byte(wr * 64 + fr, fq * 8), boff = lds_byte(wc * 32 + fr, fq * 8);
#define PG8_SA(b, h) (((b) * 2 + (h)) * HTB)
#define PG8_SB(b, h) ((4 + (b) * 2 + (h)) * HTB)
#define PG8_STAGE(bufoff, gbase, voff) do { _Pragma("unroll") for (int _i = 0; _i < 2; ++_i) \
        __builtin_amdgcn_global_load_lds((const unsigned*)((const char*)(gbase) + (voff)[_i]), (PG8_LAS unsigned*)(lds + (bufoff) + ldsw + _i * 8192), 16, 0, 0); } while (0)
#define PG8_LDA(dst, b, h) do { _Pragma("unroll") for (int m = 0; m < 4; ++m) _Pragma("unroll") for (int k = 0; k < 2; ++k) dst[m][k] = *(const PG8_LAS bf16x8*)(lds + PG8_SA(b, h) + aoff + m * 2048 + k * 1024); } while (0)
#define PG8_LDB(dst, b, h) do { _Pragma("unroll") for (int n = 0; n < 2; ++n) _Pragma("unroll") for (int k = 0; k < 2; ++k) dst[n][k] = *(const PG8_LAS bf16x8*)(lds + PG8_SB(b, h) + boff + n * 2048 + k * 1024); } while (0)
#define PG8_MMA(ai, bj, At, Bt) do { __builtin_amdgcn_s_setprio(1); _Pragma("unroll") for (int m = 0; m < 4; ++m) _Pragma("unroll") for (int n = 0; n < 2; ++n) _Pragma("unroll") for (int k = 0; k < 2; ++k) \
        acc[ai][bj][m][n] = __builtin_amdgcn_mfma_f32_16x16x32_bf16(Bt[n][k], At[m][k], acc[ai][bj][m][n], 0, 0, 0); __builtin_amdgcn_s_setprio(0); } while (0)
#define PG8_WAIT_V(n) asm volatile("s_waitcnt vmcnt(" #n ")" ::: "memory")
#define PG8_WAIT_L(n) asm volatile("s_waitcnt lgkmcnt(" #n ")" ::: "memory")
#define PG8_BAR __builtin_amdgcn_s_barrier()
#define PG8_SCHED __builtin_amdgcn_sched_barrier(0)
    Unit cur, nxt; int ui = 0;
    if (!S.next(0, cur)) return;
    f32x4 acc[2][2][4][2];
#pragma unroll
    for (int a = 0; a < 2; ++a)
#pragma unroll
        for (int b = 0; b < 2; ++b)
#pragma unroll
            for (int m = 0; m < 4; ++m)
#pragma unroll
                for (int n = 0; n < 2; ++n) acc[a][b][m][n] = (f32x4){0.f, 0.f, 0.f, 0.f};
    bf16x8 At[4][2], B0[2][2], B1[2][2];
    const char* cA = (const char*)g.A + (size_t)cur.pm * tstep; const char* cB = (const char*)g.Bt + (size_t)cur.pn * tstep;
    S.a_ready(cur);
    if constexpr (SP2) {
        PG8_STAGE(PG8_SB(0, 0), cB, voffB); PG8_STAGE(PG8_SB(0, 1), cB + hstep, voffB); PG8_STAGE(PG8_SA(0, 0), cA, voffA); PG8_STAGE(PG8_SA(0, 1), cA + hstep, voffA);
        if (wr == 1) PG8_BAR;
        PG8_WAIT_V(2); PG8_BAR;
        PG8_STAGE(PG8_SB(1, 0), cB + kstep, voffB); PG8_STAGE(PG8_SA(1, 0), cA + kstep, voffA); PG8_STAGE(PG8_SB(1, 1), cB + hstep + kstep, voffB);
        PG8_WAIT_V(6); PG8_BAR;
    } else {
        PG8_STAGE(PG8_SB(0, 0), cB, voffB); PG8_STAGE(PG8_SA(0, 0), cA, voffA); PG8_STAGE(PG8_SB(0, 1), cB + hstep, voffB); PG8_STAGE(PG8_SA(0, 1), cA + hstep, voffA);
        if (wr == 1) PG8_BAR;
        PG8_WAIT_V(4); PG8_BAR;
        PG8_STAGE(PG8_SB(1, 0), cB + kstep, voffB); PG8_STAGE(PG8_SA(1, 0), cA + kstep, voffA); PG8_STAGE(PG8_SB(1, 1), cB + hstep + kstep, voffB);
        PG8_WAIT_V(6); PG8_BAR;
    }
    for (;;) {
        const bool has_next = S.next(ui + 1, nxt);
        const char* nA = has_next ? (const char*)g.A + (size_t)nxt.pm * tstep : cA; const char* nB = has_next ? (const char*)g.Bt + (size_t)nxt.pn * tstep : cB;
        for (int t = 0; t < nt; t += 2) {
            const bool last = (t == nt - 2);
            const char* a1 = cA + (size_t)(t + 1) * kstep;
            const char* a2 = last ? nA : cA + (size_t)(t + 2) * kstep; const char* b2 = last ? nB : cB + (size_t)(t + 2) * kstep;
            const char* a3 = a2 + kstep; const char* b3 = b2 + kstep;
            if (last && has_next) S.a_ready(nxt);
            if constexpr (SP2) {
            PG8_LDB(B0, 0, 0); PG8_LDB(B1, 0, 1); PG8_SCHED; PG8_LDA(At, 0, 0); PG8_STAGE(PG8_SA(1, 1), a1 + hstep, voffA);
            PG8_WAIT_V(8); PG8_WAIT_L(0); PG8_BAR; PG8_MMA(0, 0, At, B0); PG8_MMA(0, 1, At, B1); PG8_BAR; PG8_SCHED;
            PG8_LDA(At, 0, 1); PG8_STAGE(PG8_SB(0, 0), b2, voffB); PG8_STAGE(PG8_SB(0, 1), b2 + hstep, voffB); PG8_STAGE(PG8_SA(0, 0), a2, voffA);
            PG8_WAIT_V(8); PG8_WAIT_L(0); PG8_BAR; PG8_MMA(1, 0, At, B0); PG8_MMA(1, 1, At, B1); PG8_BAR; PG8_SCHED;
            PG8_LDB(B0, 1, 0); PG8_LDB(B1, 1, 1); PG8_SCHED; PG8_LDA(At, 1, 0); PG8_STAGE(PG8_SA(0, 1), a2 + hstep, voffA);
            PG8_WAIT_V(8); PG8_WAIT_L(0); PG8_BAR; PG8_MMA(0, 0, At, B0); PG8_MMA(0, 1, At, B1); PG8_BAR; PG8_SCHED;
            PG8_LDA(At, 1, 1); PG8_STAGE(PG8_SB(1, 0), b3, voffB); PG8_STAGE(PG8_SB(1, 1), b3 + hstep, voffB); PG8_STAGE(PG8_SA(1, 0), a3, voffA);
            PG8_WAIT_V(8); PG8_WAIT_L(0); PG8_BAR; PG8_MMA(1, 0, At, B0); PG8_MMA(1, 1, At, B1); PG8_BAR; PG8_SCHED;
            } else {
            PG8_LDB(B0, 0, 0); PG8_SCHED; PG8_LDA(At, 0, 0); PG8_STAGE(PG8_SA(1, 1), a1 + hstep, voffA);
            PG8_WAIT_L(8); PG8_BAR; PG8_WAIT_L(0); PG8_MMA(0, 0, At, B0); PG8_BAR; PG8_SCHED;
            PG8_LDB(B1, 0, 1); PG8_STAGE(PG8_SB(0, 0), b2, voffB);
            PG8_BAR; PG8_WAIT_L(0); PG8_MMA(0, 1, At, B1); PG8_BAR;
            PG8_LDA(At, 0, 1); PG8_STAGE(PG8_SA(0, 0), a2, voffA);
            PG8_BAR; PG8_WAIT_L(0); PG8_MMA(1, 0, At, B0); PG8_BAR; PG8_SCHED;
            PG8_STAGE(PG8_SB(0, 1), b2 + hstep, voffB);
            PG8_WAIT_V(6); PG8_BAR; PG8_MMA(1, 1, At, B1); PG8_BAR;
            PG8_LDB(B0, 1, 0); PG8_SCHED; PG8_LDA(At, 1, 0); PG8_STAGE(PG8_SA(0, 1), a2 + hstep, voffA);
            PG8_WAIT_L(8); PG8_BAR; PG8_WAIT_L(0); PG8_MMA(0, 0, At, B0); PG8_BAR; PG8_SCHED;
            PG8_LDB(B1, 1, 1); PG8_STAGE(PG8_SB(1, 0), b3, voffB);
            PG8_BAR; PG8_WAIT_L(0); PG8_MMA(0, 1, At, B1); PG8_BAR;
            PG8_LDA(At, 1, 1); PG8_STAGE(PG8_SA(1, 0), a3, voffA);
            PG8_BAR; PG8_WAIT_L(0); PG8_MMA(1, 0, At, B0); PG8_BAR; PG8_SCHED;
            PG8_STAGE(PG8_SB(1, 1), b3 + hstep, voffB);
            PG8_WAIT_V(6); PG8_BAR; PG8_MMA(1, 1, At, B1); PG8_BAR;
            }
        }
        if constexpr (ALIGN_EPI) { if (wr == 0) PG8_BAR; }
        if constexpr (!Epi::AFTER_DRAIN) { E(acc, cur, wr, wc, fr, fq); S.done(cur); }
        if (!has_next) break;
#pragma unroll
        for (int a = 0; a < 2; ++a)
#pragma unroll
            for (int b = 0; b < 2; ++b)
#pragma unroll
                for (int m = 0; m < 4; ++m)
#pragma unroll
                    for (int n = 0; n < 2; ++n) acc[a][b][m][n] = (f32x4){0.f, 0.f, 0.f, 0.f};
        cur = nxt; cA = nA; cB = nB; ++ui;
        if constexpr (ALIGN_EPI) { if (wr == 1) PG8_BAR; }
    }
    PG8_WAIT_V(0);
    if constexpr (!ALIGN_EPI) { if (wr == 0) PG8_BAR; }
    PG8_BAR;
    if constexpr (Epi::AFTER_DRAIN) { E.fused(acc, cur, wr, wc, fr, fq, lds, wid, lane); S.done(cur); }
#undef PG8_SA
#undef PG8_SB
#undef PG8_STAGE
#undef PG8_LDA
#undef PG8_LDB
#undef PG8_MMA
#undef PG8_WAIT_V
#undef PG8_WAIT_L
#undef PG8_BAR
#undef PG8_SCHED
}
}


DI void gates_gemm(const bf16_t* H, const bf16_t* WgT  , float* GL, const float* ss, bool upper_half_only) {
    const int tid_ = opaque_tid(); const int lane = tid_ & 63, wid = tid_ >> 6, r32 = lane & 31, hi = lane >> 5;
    const int nb = (upper_half_only && gridDim.x >= 256) ? (int)gridDim.x - 128 : (int)gridDim.x, b0 = (int)gridDim.x - nb;
    if ((int)blockIdx.x < b0) return;
    for (int u = ((int)blockIdx.x - b0) + nb * wid; u < NT / 32; u += nb * 8) {
        const bf16_t* ap = H + (size_t)(u * 32 + r32) * DM + hi * 8; const bf16_t* bp = WgT + (size_t)r32 * DM + hi * 8;
        f32x16 acc;
#pragma unroll
        for (int i = 0; i < 16; ++i) acc[i] = 0.f;
#pragma unroll 8
        for (int k = 0; k < DM; k += 16) acc = __builtin_amdgcn_mfma_f32_32x32x16_bf16(*(const bf16x8*)(ap + k), *(const bf16x8*)(bp + k), acc, 0, 0, 0);
#pragma unroll
        for (int i = 0; i < 16; ++i) { const int row = u * 32 + (i & 3) + 8 * (i >> 2) + 4 * hi; const float rs = ss ? rsqrtf(ss[row] * (1.f / 1024) + EPS) : 1.f; GL[(size_t)row * 32 + r32] = acc[i] * rs; }
    }
}

DI float log_sigmoid_(float x) { return fminf(x, 0.f) - log1pf(__expf(-fabsf(x))); }
DI void prep_cumsum(const Args& a, int l, float* LS) {
    const float* GL = (const float*)(a.ws + WS_GL); float* C2 = (float*)(a.ws + WS_C2);
    const int tid = opaque_tid(), lane = tid & 63, wid = tid >> 6;
    for (int b = blockIdx.x; b < NB; b += gridDim.x) {
        __syncthreads();
#pragma unroll
        for (int i = 0; i < 4; ++i) {
            const int t = tid + 512 * i;
            const f32x4 v0 = *(const f32x4*)(GL + (size_t)(b * SEQ + t) * 32 + 24), v1 = *(const f32x4*)(GL + (size_t)(b * SEQ + t) * 32 + 28);
#pragma unroll
            for (int h = 0; h < 4; ++h) { LS[h * 2112 + (t >> 5) * 33 + (t & 31)] = log_sigmoid_(v0[h] + a.in[I_FFB][l * 8 + h]); LS[(h + 4) * 2112 + (t >> 5) * 33 + (t & 31)] = log_sigmoid_(v1[h] + a.in[I_FFB][l * 8 + 4 + h]); }
        }
        __syncthreads();
        {   float* row = LS + wid * 2112 + lane * 33;
            float tot = 0.f;
            for (int k = 0; k < 32; ++k) tot += row[k];
            float inc = tot;
#pragma unroll
            for (int o = 1; o < 64; o <<= 1) { const float n = __shfl_up(inc, o); if (lane >= o) inc += n; }
            float run = inc - tot;
            for (int k = 0; k < 32; ++k) { run += row[k]; row[k] = run * LOG2E; }
        }
        __syncthreads();
#pragma unroll
        for (int i = 0; i < 4; ++i) { const int t = tid + 512 * i;
#pragma unroll
            for (int h = 0; h < 8; ++h) C2[(size_t)(b * 8 + h) * SEQ + t] = LS[h * 2112 + (t >> 5) * 33 + (t & 31)]; }
    }
    __syncthreads();
}
DI void prep_compress(const Args& a, int l, const bf16_t* P) {
    unsigned char* ws = a.ws;
    const int tid_ = opaque_tid(); const int lane = tid_ & 63, wid = tid_ >> 6, fr = lane & 15, fq = lane >> 4;
    const int nbk = gridDim.x > 32 ? (int)gridDim.x - 16 : (int)gridDim.x, bk0 = (int)gridDim.x - nbk;
    if ((int)blockIdx.x < bk0) return;
    for (int it = ((int)blockIdx.x - bk0) + nbk * wid; it < NB * 2 * 2 * 8; it += nbk * 8) {
        const int nq = it & 7, kv = (it >> 3) & 1, g = (it >> 4) & 1, b = it >> 5;
        const int n = 16 * nq + fr; const bool ok = n < 127;
        const bf16_t* src = P + (size_t)(b * SEQ + (ok ? 16 * n : 0)) * PP + (kv ? C_VC : C_KC) + g * 64 + fq * 8;
        const bf16_t* W = (const bf16_t*)(ws + (kv ? WS_WCV : WS_WCK)) + (size_t)l * 131072 + (size_t)fr * 2048 + fq * 8;
        f32x4 acc[4];
#pragma unroll
        for (int nt = 0; nt < 4; ++nt) acc[nt] = (f32x4){0.f, 0.f, 0.f, 0.f};
#pragma unroll 4
        for (int ks = 0; ks < 64; ++ks) {
            bf16x8 af = *(const bf16x8*)(src + (size_t)(ks >> 1) * PP + (ks & 1) * 32);
            if (!ok) af = (bf16x8){0, 0, 0, 0, 0, 0, 0, 0};
#pragma unroll
            for (int nt = 0; nt < 4; ++nt) { const bf16x8 bw = *(const bf16x8*)(W + (size_t)nt * 16 * 2048 + ks * 32); acc[nt] = __builtin_amdgcn_mfma_f32_16x16x32_bf16(af, bw, acc[nt], 0, 0, 0); }
        }
        const float* bias = (const float*)(ws + WS_BKV) + (l * 2 + kv) * 64;
        float v[4][4];
#pragma unroll
        for (int nt = 0; nt < 4; ++nt)
#pragma unroll
            for (int i = 0; i < 4; ++i) v[nt][i] = acc[nt][i] + bias[16 * nt + fr];
        bf16_t* out = (bf16_t*)(ws + (kv ? WS_VCMP : WS_KCMP)) + (size_t)(b * 2 + g) * 128 * 64;
#pragma unroll
        for (int i = 0; i < 4; ++i) {
            const int row = 16 * nq + 4 * fq + i;
            float sc = 1.f;
            if (kv == 0) { float ss = v[0][i] * v[0][i] + v[1][i] * v[1][i] + v[2][i] * v[2][i] + v[3][i] * v[3][i];
                ss += __shfl_xor(ss, 1); ss += __shfl_xor(ss, 2); ss += __shfl_xor(ss, 4); ss += __shfl_xor(ss, 8); sc = rsqrtf(ss * (1.f / 64) + EPS); }
#pragma unroll
            for (int nt = 0; nt < 4; ++nt) { const int e = 16 * nt + fr; float o = v[nt][i] * sc; if (kv == 0) o *= a.in[I_NKG][(l * 3 + 0) * 64 + e]; if (row >= 127) o = 0.f;
                out[(size_t)row * 64 + e] = (bf16_t)f2bf(o); }
        }
    }
}


constexpr int A_KB = 0, A_VB = 18432, A_CB = A_VB + 16384, A_IG = A_CB + 512, A_IL = A_IG + 33792, A_SELM = A_IL + 33792, A_UN = A_SELM + 256, A_UNIT = A_UN + 16, A_SC = A_UNIT + 16, A_KG = A_SC + 2048, A_END = A_KG + 512;
static_assert(A_END <= LDS_BYTES, "attention LDS map");
struct ACtx { int r32, hi, tid, tok; bf16x8 qr[4]; };
typedef float f32x2_t __attribute__((ext_vector_type(2))); typedef __bf16 bf16x2_t __attribute__((ext_vector_type(2)));
typedef short v4i16_t __attribute__((ext_vector_type(4)));
#define LAS3 __attribute__((address_space(3)))
DI unsigned cvtpk(float lo, float hi) { f32x2_t v = {lo, hi}; bf16x2_t bb = __builtin_convertvector(v, bf16x2_t); return __builtin_bit_cast(unsigned, bb); }
DI v4i16_t vtr(const LAS3 unsigned char* p) { return __builtin_amdgcn_ds_read_tr16_b64_v4i16((LAS3 v4i16_t*)p); }

DI void load_q(ACtx& x, const bf16_t* qrow) {
#pragma unroll
    for (int d0 = 0; d0 < 4; ++d0) x.qr[d0] = *(const bf16x8*)(qrow + d0 * 16 + x.hi * 8);
}

template <int MODE, bool ONLINE>
DI void attn_tile_compute(const unsigned char* lds, int cur, int j, const ACtx& x, unsigned selm, int cblk, int wtokmin, float bref, float ctb, f32x16 (&oT)[2], float& m, float& l) {
    const bf16_t* KB = (const bf16_t*)(lds + A_KB) + cur * 4608;
    const int lane = x.tid & 63;
    f32x16 p0, p1;
    if (MODE == 3) {
        const float* CB = (const float*)(lds + A_CB) + cur * 64 + 4 * x.hi;
#pragma unroll
        for (int q = 0; q < 4; ++q) { const f32x4 c0 = *(const f32x4*)(CB + 8 * q), c1 = *(const f32x4*)(CB + 32 + 8 * q);
#pragma unroll
            for (int i = 0; i < 4; ++i) { p0[4 * q + i] = (ONLINE ? 0.f : ctb) - c0[i]; p1[4 * q + i] = (ONLINE ? 0.f : ctb) - c1[i]; } }
    } else {
#pragma unroll
        for (int i = 0; i < 16; ++i) { p0[i] = ONLINE ? 0.f : -bref; p1[i] = ONLINE ? 0.f : -bref; }
    }
#pragma unroll
    for (int d0 = 0; d0 < 4; ++d0) {
        const bf16x8 k0 = *(const bf16x8*)(KB + x.r32 * 72 + d0 * 16 + x.hi * 8);
        const bf16x8 k1 = *(const bf16x8*)(KB + (32 + x.r32) * 72 + d0 * 16 + x.hi * 8);
        p0 = __builtin_amdgcn_mfma_f32_32x32x16_bf16(k0, x.qr[d0], p0, 0, 0, 0);
        p1 = __builtin_amdgcn_mfma_f32_32x32x16_bf16(k1, x.qr[d0], p1, 0, 0, 0);
    }
    const float NEG = -INFINITY;
    const int kb = 64 * j + 4 * x.hi;
#define KK(r) (kb + ((r) & 3) + 8 * ((r) >> 2))
    if (MODE == 3) {
        if (64 * j + 63 > wtokmin) {
#pragma unroll
            for (int r = 0; r < 16; ++r) { const int kk = KK(r); if (kk > x.tok) p0[r] = NEG; if (kk + 32 > x.tok) p1[r] = NEG; }
        }
    } else if (MODE == 0) {
#pragma unroll
        for (int r = 0; r < 16; ++r) { const int n = KK(r); if (16 * n + 31 > x.tok) p0[r] = NEG; if (16 * (n + 32) + 31 > x.tok) p1[r] = NEG; }
    } else if (MODE == 1) {
        const bool on = (selm >> j) & 1u;
        const bool allon = __ballot(on) == ~0ull;
        if (j == cblk) {
#pragma unroll
            for (int r = 0; r < 16; ++r) { const int kk = KK(r); if (!on || kk > x.tok) p0[r] = NEG; if (!on || kk + 32 > x.tok) p1[r] = NEG; }
        } else if (!allon) {
#pragma unroll
            for (int r = 0; r < 16; ++r) { if (!on) { p0[r] = NEG; p1[r] = NEG; } }
        }
    } else {
        if (j == cblk) {
#pragma unroll
            for (int r = 0; r < 16; ++r) { const int kk = KK(r); if (kk > x.tok) p0[r] = NEG; if (kk + 32 > x.tok) p1[r] = NEG; }
        } else if (j == cblk - 8) {
#pragma unroll
            for (int r = 0; r < 16; ++r) { const int kk = KK(r); if (x.tok - kk >= 512) p0[r] = NEG; if (x.tok - kk - 32 >= 512) p1[r] = NEG; }
        }
    }
#undef KK
    if (ONLINE) {
        float mx = fmaxf(p0[0], p1[0]);
#pragma unroll
        for (int r = 1; r < 16; ++r) mx = fmaxf(mx, fmaxf(p0[r], p1[r]));
        mx = fmaxf(mx, __shfl_xor(mx, 32));
        const float mn = fmaxf(m, mx);
        if (__any(mn > m)) {
            const float sc = __builtin_amdgcn_exp2f(m - mn); l *= sc;
#pragma unroll
            for (int r = 0; r < 16; ++r) { oT[0][r] *= sc; oT[1][r] *= sc; }
        }
        m = mn;
#pragma unroll
        for (int r = 0; r < 16; ++r) { p0[r] -= mn; p1[r] -= mn; }
    }
    f32x2_t ls2 = {0.f, 0.f};
#pragma unroll
    for (int r = 0; r < 16; r += 2) { p0[r] = __builtin_amdgcn_exp2f(p0[r]); p0[r + 1] = __builtin_amdgcn_exp2f(p0[r + 1]); p1[r] = __builtin_amdgcn_exp2f(p1[r]); p1[r + 1] = __builtin_amdgcn_exp2f(p1[r + 1]);
        ls2 += (f32x2_t){p0[r], p0[r + 1]}; ls2 += (f32x2_t){p1[r], p1[r + 1]}; }
    l += ls2[0] + ls2[1];
    bf16x8 pf[4];
#pragma unroll
    for (int s = 0; s < 2; ++s) {
        u32x4 a0, a1;
#pragma unroll
        for (int i = 0; i < 4; ++i) { a0[i] = cvtpk(p0[8 * s + 2 * i], p0[8 * s + 2 * i + 1]); a1[i] = cvtpk(p1[8 * s + 2 * i], p1[8 * s + 2 * i + 1]); }
        pf[s] = __builtin_bit_cast(bf16x8, a0); pf[2 + s] = __builtin_bit_cast(bf16x8, a1);
    }
    const LAS3 unsigned char* vp = (const LAS3 unsigned char*)(lds + A_VB) + cur * 8192 + ((lane >> 4) & 1) * 32 + (lane & 3) * 8 + (4 * x.hi + ((lane & 15) >> 2)) * 64;
#pragma unroll
    for (int dh = 0; dh < 2; ++dh)
#pragma unroll
        for (int ks = 0; ks < 4; ++ks) {
            const v4i16_t lo = vtr(vp + dh * 4096 + ks * 1024), hi4 = vtr(vp + dh * 4096 + ks * 1024 + 512);
            const bf16x8 vf = (bf16x8){lo[0], lo[1], lo[2], lo[3], hi4[0], hi4[1], hi4[2], hi4[3]};
            oT[dh] = __builtin_amdgcn_mfma_f32_32x32x16_bf16(vf, pf[ks], oT[dh], 0, 0, 0);
        }
}

template <int MODE, bool ONLINE>
DI void attn_branch(unsigned char* lds, const bf16_t* Kg, int kp, const bf16_t* Vg, int vp, const float* Cg, int kgofs, unsigned tiles,
                    const ACtx& x, unsigned selm, int cblk, int wtokmin, int wtokmax, float bref, float ctb, f32x16 (&oT)[2], float& m, float& l) {
    const int tid = x.tid, srow = tid >> 3, sc8 = tid & 7;
    bf16_t* KB = (bf16_t*)(lds + A_KB); unsigned char* VB = lds + A_VB; float* CB = (float*)(lds + A_CB);
    const int kofs = srow * 72 + sc8 * 8, vofs = ((sc8 >> 2) * 4 + (srow >> 4)) * 1024 + (srow & 15) * 64 + (sc8 & 3) * 16;
    unsigned rem = tiles; if (!rem) return;
    u32x4 krA, vrA, krB, vrB; f32x4 crA = {0.f, 0.f, 0.f, 0.f}, crB = {0.f, 0.f, 0.f, 0.f};
#define POP(jv) do { jv = -1; if (rem) { jv = __builtin_ctz(rem); rem &= rem - 1; } } while (0)
#define LOADT(jj, kr, vr, cr) do { kr = *(const u32x4*)(Kg + (size_t)(64 * (jj) + srow) * kp + sc8 * 8); vr = *(const u32x4*)(Vg + (size_t)(64 * (jj) + srow) * vp + sc8 * 8); \
        if (MODE == 3 && tid < 16) cr = *(const f32x4*)(Cg + 64 * (jj) + tid * 4); } while (0)
#define STORET(buf, kr, vr, cr) do { *(u32x4*)(KB + (buf) * 4608 + kofs) = kr; *(u32x4*)(VB + (buf) * 8192 + vofs) = vr; if (MODE == 3 && tid < 16) *(f32x4*)(CB + (buf) * 64 + tid * 4) = cr; } while (0)
#define ACTIVE(jj) ((MODE == 1) ? (__ballot((selm >> (jj)) & 1u) != 0ull) : ((MODE == 3) ? (64 * (jj) <= wtokmax) : true))
    int j0, j1, j2, j3;
    POP(j0); LOADT(j0, krA, vrA, crA); STORET(0, krA, vrA, crA);
    POP(j1); if (j1 >= 0) LOADT(j1, krA, vrA, crA);
    __syncthreads();
    int cur = 0;
    for (;;) {
        POP(j2); if (j2 >= 0) LOADT(j2, krB, vrB, crB);
        if (ACTIVE(j0)) attn_tile_compute<MODE, ONLINE>(lds, cur, j0, x, selm, cblk, wtokmin, bref, ctb, oT, m, l);
        if (j1 >= 0) STORET(cur ^ 1, krA, vrA, crA);
        __syncthreads();
        if (j1 < 0) break;
        cur ^= 1;
        POP(j3); if (j3 >= 0) LOADT(j3, krA, vrA, crA);
        if (ACTIVE(j1)) attn_tile_compute<MODE, ONLINE>(lds, cur, j1, x, selm, cblk, wtokmin, bref, ctb, oT, m, l);
        if (j2 >= 0) STORET(cur ^ 1, krB, vrB, crB);
        __syncthreads();
        if (j2 < 0) break;
        cur ^= 1; j0 = j2; j1 = j3;
    }
#undef POP
#undef ACTIVE
#undef LOADT
#undef STORET
}
DI void zero_o(f32x16 (&oT)[2]) {
#pragma unroll
    for (int r = 0; r < 16; ++r) { oT[0][r] = 0.f; oT[1][r] = 0.f; }
}

template <bool ONLINE> DI void nsa_unit(const Args& a, int l, unsigned char* lds, int b, int g, int c) {
    unsigned char* ws = a.ws;
    const bf16_t* P = (const bf16_t*)(ws + WS_P); bf16_t* Y = (bf16_t*)(ws + WS_HY); const float* GL = (const float*)(ws + WS_GL);
    ACtx x; x.tid = threadIdx.x; asm volatile("" : "+v"(x.tid));
    const int lane = x.tid & 63, wid = __builtin_amdgcn_readfirstlane(x.tid >> 6); x.r32 = lane & 31; x.hi = lane >> 5;
    const int hq = 4 * g + (wid & 3), tokl = 32 * (wid >> 2) + x.r32; x.tok = 64 * c + tokl;
    const size_t row = (size_t)(b * SEQ + x.tok);
    load_q(x, P + row * PP + C_NQ + hq * 64);
#define GATE(k) sigmoidf_(GL[row * 32 + hq * 3 + (k)] + a.in[I_GB][l * 24 + hq * 3 + (k)])
    float* IG = (float*)(lds + A_IG); float* IL = (float*)(lds + A_IL); unsigned* SELM = (unsigned*)(lds + A_SELM); unsigned* UN = (unsigned*)(lds + A_UN);
    if (x.tid == 0) UN[0] = 0u;
    f32x16 oT[2], tot[2]; zero_o(oT); zero_o(tot);
    float m = -1e30f, ls = 0.f;
    const float* bnd = (const float*)(ws + WS_BND) + l * 4;
    const float b_cmp = bnd[0], b_slc = bnd[1], b_win = bnd[2];
    constexpr bool online = ONLINE;
#define BRANCH(MODE, ...) do { attn_branch<MODE, ONLINE>(__VA_ARGS__); } while (0)
    const bf16_t* KC = (const bf16_t*)(ws + WS_KCMP) + (size_t)(b * 2 + g) * 128 * 64; const bf16_t* VC = (const bf16_t*)(ws + WS_VCMP) + (size_t)(b * 2 + g) * 128 * 64;
    const int ncmpt = c >= 16 ? 2 : 1;
    BRANCH(0, lds, KC, 64, VC, 64, nullptr, 0, c >= 16 ? 3u : 1u, x, 0u, c, 0, 0, b_cmp, 0.f, oT, m, ls);
    const float cref = online ? m : b_cmp;
    {   float lt = ls + __shfl_xor(ls, 32); const float inv = lt > 0.f ? 1.f / lt : 0.f; const float g0 = GATE(0);
#pragma unroll
        for (int r = 0; r < 16; ++r) { tot[0][r] = oT[0][r] * (inv * g0); tot[1][r] = oT[1][r] * (inv * g0); }
        for (int tt = 0; tt < ncmpt; ++tt) {
            const bf16_t* KB = (const bf16_t*)(lds + A_KB) + tt * 4608;
            f32x16 p0, p1;
#pragma unroll
            for (int i = 0; i < 16; ++i) { p0[i] = -cref; p1[i] = -cref; }
#pragma unroll
            for (int d0 = 0; d0 < 4; ++d0) {
                const bf16x8 k0 = *(const bf16x8*)(KB + x.r32 * 72 + d0 * 16 + x.hi * 8); const bf16x8 k1 = *(const bf16x8*)(KB + (32 + x.r32) * 72 + d0 * 16 + x.hi * 8);
                p0 = __builtin_amdgcn_mfma_f32_32x32x16_bf16(k0, x.qr[d0], p0, 0, 0, 0); p1 = __builtin_amdgcn_mfma_f32_32x32x16_bf16(k1, x.qr[d0], p1, 0, 0, 0);
            }
            const int kb = 64 * tt + 4 * x.hi;
#pragma unroll
            for (int r = 0; r < 16; ++r) { const int n = kb + (r & 3) + 8 * (r >> 2);
                p0[r] = (16 * n + 31 <= x.tok) ? __builtin_amdgcn_exp2f(p0[r]) * inv : 0.f; p1[r] = (16 * (n + 32) + 31 <= x.tok) ? __builtin_amdgcn_exp2f(p1[r]) * inv : 0.f; }
            float* ig = IG + ((wid & 3) * 64 + tokl) * 33; float* il = IL + ((wid & 3) * 64 + tokl) * 33;
#pragma unroll
            for (int q = 0; q < 4; ++q) { const int jj = 16 * tt + 2 * q + x.hi;
                ig[jj] = p0[4 * q] + p0[4 * q + 1] + p0[4 * q + 2] + p0[4 * q + 3]; il[jj] = p0[4 * q + 3];
                ig[jj + 8] = p1[4 * q] + p1[4 * q + 1] + p1[4 * q + 2] + p1[4 * q + 3]; il[jj + 8] = p1[4 * q + 3]; }
        }
    }
    __syncthreads();
    {   int j = lane & 31; asm volatile("" : "+v"(j));
        unsigned wor = 0u;
#pragma unroll
        for (int it = 0; it < 4; ++it) {
            const int tl = 8 * wid + 2 * it + (lane >> 5);
            float imp = 0.f;
#pragma unroll
            for (int h4 = 0; h4 < 4; ++h4) { imp += IG[(h4 * 64 + tl) * 33 + j]; if (j > 0) imp += IL[(h4 * 64 + tl) * 33 + j - 1]; }
            const bool valid = j <= c, forced = (j == 0) || (j == c) || (j == c - 1);
            const float score = !valid ? -1e30f : (forced ? 1e9f : imp);
            float* scw = (float*)(lds + A_SC) + wid * 64;
            scw[lane] = score;
            __builtin_amdgcn_s_waitcnt(0xc07f); __builtin_amdgcn_wave_barrier();
            int rank = 0;
#pragma unroll
            for (int k4 = 0; k4 < 8; ++k4) { const f32x4 sk = *(const f32x4*)(scw + (lane & 32) + 4 * k4);
#pragma unroll
                for (int i = 0; i < 4; ++i) rank += (sk[i] > score) || (sk[i] == score && 4 * k4 + i < j); }
            __builtin_amdgcn_wave_barrier();
            const unsigned long long bal = __ballot(valid && rank < 16);
            const unsigned mine = (lane >> 5) ? (unsigned)(bal >> 32) : (unsigned)bal;
            if (j == 0) SELM[tl] = mine;
            wor |= (unsigned)bal | (unsigned)(bal >> 32);
        }
        if (lane == 0) atomicOr(UN, wor);
    }
    __syncthreads();
    const unsigned selm = SELM[tokl]; const unsigned un = UN[0];
    float* TOT = (float*)(lds + A_IG) + wid * 2048 + lane;
#pragma unroll
    for (int r = 0; r < 16; ++r) { TOT[r * 64] = tot[0][r]; TOT[(16 + r) * 64] = tot[1][r]; }
    zero_o(oT); m = -1e30f; ls = 0.f;
    BRANCH(1, lds, P + (size_t)b * SEQ * PP + C_KS + g * 64, PP, P + (size_t)b * SEQ * PP + C_VS + g * 64, PP, nullptr, 0, un, x, selm, c, 0, 0, b_slc, 0.f, oT, m, ls);
    {   float lt = ls + __shfl_xor(ls, 32); const float inv = lt > 0.f ? GATE(1) / lt : 0.f;
#pragma unroll
        for (int r = 0; r < 16; ++r) { TOT[r * 64] += oT[0][r] * inv; TOT[(16 + r) * 64] += oT[1][r] * inv; } }
    zero_o(oT); m = -1e30f; ls = 0.f;
    {   const int jlo = c >= 8 ? c - 8 : 0; const unsigned wt = (c >= 31 ? 0xffffffffu : ((1u << (c + 1)) - 1u)) & ~((1u << jlo) - 1u);
        BRANCH(2, lds, P + (size_t)b * SEQ * PP + C_KW + g * 64, PP, P + (size_t)b * SEQ * PP + C_VW + g * 64, PP, nullptr, 64, wt, x, 0u, c, 0, 0, b_win, 0.f, oT, m, ls); }
    {   float lt = ls + __shfl_xor(ls, 32); const float inv = lt > 0.f ? GATE(2) / lt : 0.f;
#pragma unroll
        for (int r = 0; r < 16; ++r) { tot[0][r] = TOT[r * 64] + oT[0][r] * inv; tot[1][r] = TOT[(16 + r) * 64] + oT[1][r] * inv; } }
#pragma unroll
    for (int dh = 0; dh < 2; ++dh)
#pragma unroll
        for (int q = 0; q < 4; ++q) {
            const int d = 32 * dh + 8 * q + 4 * x.hi;
            const u32x2 zz = *(const u32x2*)(P + row * PP + C_NZ + hq * 64 + d);
            const float z0 = bf2f(zz[0] & 0xffffu), z1 = bf2f(zz[0] >> 16), z2 = bf2f(zz[1] & 0xffffu), z3 = bf2f(zz[1] >> 16);
            u32x2 o; o[0] = cvtpk(tot[dh][4 * q] * siluf_(z0), tot[dh][4 * q + 1] * siluf_(z1)); o[1] = cvtpk(tot[dh][4 * q + 2] * siluf_(z2), tot[dh][4 * q + 3] * siluf_(z3));
            *(u32x2*)(Y + row * DMIX + 512 + hq * 64 + d) = o;
        }
}

template <bool ONLINE> DI void fox_unit(const Args& a, int l, unsigned char* lds, int b, int h, int c) {
    unsigned char* ws = a.ws;
    const bf16_t* P = (const bf16_t*)(ws + WS_P); bf16_t* Y = (bf16_t*)(ws + WS_HY);
    ACtx x; x.tid = threadIdx.x; asm volatile("" : "+v"(x.tid));
    const int lane = x.tid & 63, wid = __builtin_amdgcn_readfirstlane(x.tid >> 6); x.r32 = lane & 31; x.hi = lane >> 5;
    x.tok = 256 * c + 32 * wid + x.r32;
    const size_t row = (size_t)(b * SEQ + x.tok);
    load_q(x, P + row * PP + C_FQ + h * 64);
    const float* c2 = (const float*)(ws + WS_C2) + (size_t)(b * 8 + h) * SEQ;
    f32x16 oT[2]; zero_o(oT); float m = -1e30f, ls = 0.f;
    const int ntile = 4 * c + 4; const unsigned tiles = ntile >= 32 ? 0xffffffffu : ((1u << ntile) - 1u);
    unsigned tiles_ = tiles;
    if (!ONLINE) {
        const float cj = c2[64 * (lane & 31) + 63], c0 = c2[256 * c];
        tiles_ &= ~(unsigned)__ballot((lane < 32) && (c0 - cj <= -152.f));
    }
    const float b_fox = ((const float*)(ws + WS_BND))[l * 4 + 3]; const float ctb = c2[x.tok] - b_fox;
    attn_branch<3, ONLINE>(lds, P + (size_t)b * SEQ * PP + C_FK + h * 64, PP, P + (size_t)b * SEQ * PP + C_FV + h * 64, PP, c2, 0, tiles_, x, 0u, 0, 256 * c + 32 * wid, 256 * c + 32 * wid + 31, b_fox, ctb, oT, m, ls);
    float lt = ls + __shfl_xor(ls, 32); const float inv = lt > 0.f ? 1.f / lt : 0.f;
#pragma unroll
    for (int dh = 0; dh < 2; ++dh)
#pragma unroll
        for (int q = 0; q < 4; ++q) {
            const int d = 32 * dh + 8 * q + 4 * x.hi;
            const u32x2 zz = *(const u32x2*)(P + row * PP + C_FZ + h * 64 + d);
            const float z0 = bf2f(zz[0] & 0xffffu), z1 = bf2f(zz[0] >> 16), z2 = bf2f(zz[1] & 0xffffu), z3 = bf2f(zz[1] >> 16);
            u32x2 o; o[0] = cvtpk(oT[dh][4 * q] * inv * siluf_(z0), oT[dh][4 * q + 1] * inv * siluf_(z1)); o[1] = cvtpk(oT[dh][4 * q + 2] * inv * siluf_(z2), oT[dh][4 * q + 3] * inv * siluf_(z3));
            *(u32x2*)(Y + row * DMIX + 1024 + h * 64 + d) = o;
        }
}


constexpr int L_WA = 0, L_WX = 9216, L_XB = 18432, L_XF = 27648, L_G = 44032, L_SA = L_G + 2 * 64 * 65 * 4, L_SB = L_SA + 2048, L_CY = L_SB + 2048, L_END = L_CY + 512;
static_assert(L_END <= LDS_BYTES, "LRU LDS map");
DI float fsig(float x) { return __builtin_amdgcn_rcpf(1.f + __expf(-x)); }
DI float neg_expm1(float x) {
    const float t = x * (1.f + x * (0.5f + x * (0.16666667f + x * (0.041666668f + x * (0.0083333338f + x * 0.0013888889f)))));
    const float e = __expf(x) - 1.f;
    return -((x > -0.25f) ? t : e);
}
DI void lru_unit(const Args& a, int l, unsigned char* lds, int b, int h) {
    unsigned char* ws = a.ws;
    const bf16_t* P = (const bf16_t*)(ws + WS_P); bf16_t* Y = (bf16_t*)(ws + WS_HY);
    int tid = threadIdx.x; asm volatile("" : "+v"(tid));
    const int lane = tid & 63, wid = __builtin_amdgcn_readfirstlane(tid >> 6);
    bf16_t* WAl = (bf16_t*)(lds + L_WA); bf16_t* WXl = (bf16_t*)(lds + L_WX); bf16_t* XB = (bf16_t*)(lds + L_XB);
    float* XF = (float*)(lds + L_XF); float* G = (float*)(lds + L_G); float* SA = (float*)(lds + L_SA); float* SB = (float*)(lds + L_SB); float* CY = (float*)(lds + L_CY);
    __syncthreads();
    {   const int r = tid >> 3, c8 = (tid & 7) * 8;
        *(u32x4*)(WAl + r * 72 + c8) = *(const u32x4*)((const bf16_t*)(ws + WS_WA) + (size_t)(l * 8 + h) * 4096 + r * 64 + c8);
        *(u32x4*)(WXl + r * 72 + c8) = *(const u32x4*)((const bf16_t*)(ws + WS_WX) + (size_t)(l * 8 + h) * 4096 + r * 64 + c8);
        if (tid < 128) CY[tid] = 0.f; }
    const int tk1 = tid >> 3, c8 = (tid & 7) * 8, chb = h * 64 + c8;
    float cw[4][8], cb8[8];
#pragma unroll
    for (int i = 0; i < 8; ++i) { cb8[i] = a.in[I_CB][l * 512 + chb + i];
#pragma unroll
        for (int k = 0; k < 4; ++k) cw[k][i] = a.in[I_CW][(l * 4 + k) * 512 + chb + i]; }
    const int ch = tid & 63, sg = tid >> 6, chg = h * 64 + ch;
    const float ba = a.in[I_BA][l * 512 + chg], bx = a.in[I_BX][l * 512 + chg], lam = a.in[I_LAM][l * 512 + chg];
    const float sp8 = -8.f * (fmaxf(-lam, 0.f) + log1pf(__expf(-fabsf(lam))));
    const int fr = lane & 15, fq = lane >> 4, mat = wid >> 2, strip = wid & 3;
    const bf16_t* pu = P + (size_t)b * SEQ * PP + C_U + chb;
    u32x4 ur[4];
#pragma unroll
    for (int k = 0; k < 4; ++k) { const int t = tk1 - 3 + k; ur[k] = (t >= 0) ? *(const u32x4*)(pu + (size_t)t * PP) : (u32x4){0u, 0u, 0u, 0u}; }
    for (int tile = 0; tile < SEQ / 64; ++tile) {
        const int t0 = tile * 64;
        {   float xc[8];
#pragma unroll
            for (int i = 0; i < 8; ++i) xc[i] = cb8[i];
#pragma unroll
            for (int k = 0; k < 4; ++k) { float uf[8]; unpack8(ur[k], uf);
#pragma unroll
                for (int i = 0; i < 8; ++i) xc[i] += cw[k][i] * uf[i]; }
            *(f32x4*)(XF + tk1 * 64 + c8) = (f32x4){xc[0], xc[1], xc[2], xc[3]}; *(f32x4*)(XF + tk1 * 64 + c8 + 4) = (f32x4){xc[4], xc[5], xc[6], xc[7]};
            u32x4 pk; pk[0] = pk2(xc[0], xc[1]); pk[1] = pk2(xc[2], xc[3]); pk[2] = pk2(xc[4], xc[5]); pk[3] = pk2(xc[6], xc[7]);
            *(u32x4*)(XB + tk1 * 72 + c8) = pk;
            if (tile + 1 < SEQ / 64) {
#pragma unroll
                for (int k = 0; k < 4; ++k) ur[k] = *(const u32x4*)(pu + (size_t)(t0 + 64 + tk1 - 3 + k) * PP);
            }
        }
        __syncthreads();
        {   const bf16_t* W = mat ? WXl : WAl;
            f32x4 acc[4];
#pragma unroll
            for (int nt = 0; nt < 4; ++nt) acc[nt] = (f32x4){0.f, 0.f, 0.f, 0.f};
#pragma unroll
            for (int ks = 0; ks < 2; ++ks) {
                const bf16x8 af = *(const bf16x8*)(XB + (16 * strip + fr) * 72 + ks * 32 + fq * 8);
#pragma unroll
                for (int nt = 0; nt < 4; ++nt) { const bf16x8 bw = *(const bf16x8*)(W + (16 * nt + fr) * 72 + ks * 32 + fq * 8); acc[nt] = __builtin_amdgcn_mfma_f32_16x16x32_bf16(af, bw, acc[nt], 0, 0, 0); }
            }
            float* Gm = G + mat * 64 * 65;
#pragma unroll
            for (int nt = 0; nt < 4; ++nt)
#pragma unroll
                for (int i = 0; i < 4; ++i) Gm[(16 * strip + 4 * fq + i) * 65 + 16 * nt + fr] = acc[nt][i];
        }
        __syncthreads();
        {   const bf16_t* pz = P + (size_t)(b * SEQ + t0 + sg * 8) * PP + C_Z + chg;
            bf16_t zr[8];
#pragma unroll
            for (int k = 0; k < 8; ++k) zr[k] = pz[(size_t)k * PP];
            float av[8], bv[8]; float A = 1.f, Bc = 0.f;
#pragma unroll
            for (int k = 0; k < 8; ++k) {
                const int tk = sg * 8 + k;
                const float r = fsig(G[tk * 65 + ch] + ba), ig = fsig(G[64 * 65 + tk * 65 + ch] + bx), xcv = XF[tk * 64 + ch];
                const float la = r * sp8;
                av[k] = __expf(la); bv[k] = sqrtf(neg_expm1(2.f * la)) * (ig * xcv);
                Bc = av[k] * Bc + bv[k]; A *= av[k];
            }
            SA[sg * 64 + ch] = A; SB[sg * 64 + ch] = Bc;
            __syncthreads();
            float hs = CY[(tile & 1) * 64 + ch];
            for (int s = 0; s < sg; ++s) hs = SA[s * 64 + ch] * hs + SB[s * 64 + ch];
            bf16_t* py = Y + (size_t)(b * SEQ + t0 + sg * 8) * DMIX + chg;
#pragma unroll
            for (int k = 0; k < 8; ++k) { hs = av[k] * hs + bv[k]; py[(size_t)k * DMIX] = (bf16_t)f2bf(hs * siluf_(bf2f(zr[k]))); }
            if (sg == 7) CY[((tile & 1) ^ 1) * 64 + ch] = hs;
        }
    }
    __syncthreads();
}


template <bool ONLINE> DI void phase_mix(const Args& a, int l, unsigned char* lds, int cofs = 0, bool only_lru = false) {
    unsigned* ctr = (unsigned*)(a.ws + WS_CTL) + l * 16 + cofs;
    volatile int* UNIT = (volatile int*)(lds + A_UNIT);
    if (blockIdx.x < 128) lru_unit(a, l, lds, blockIdx.x >> 3, blockIdx.x & 7);
    if (only_lru) return;
    __syncthreads();
    if (threadIdx.x == 0) UNIT[0] = (int)atomicAdd(ctr, 1u);
    __syncthreads();
    for (int u = UNIT[0]; u < 1024; ) {
        int nxt = 0; if (threadIdx.x == 0) nxt = (int)atomicAdd(ctr, 1u);
        nsa_unit<ONLINE>(a, l, lds, (u & 31) >> 1, u & 1, 31 - (u >> 5));
        if (threadIdx.x == 0) UNIT[0] = nxt;
        __syncthreads();
        u = UNIT[0];
    }
    __syncthreads();
    if (threadIdx.x == 0) UNIT[0] = (int)atomicAdd(ctr + 1, 1u);
    __syncthreads();
    for (int u = UNIT[0]; u < 1024; ) {
        int nxt = 0; if (threadIdx.x == 0) nxt = (int)atomicAdd(ctr + 1, 1u);
        fox_unit<ONLINE>(a, l, lds, (u & 127) >> 3, u & 7, 7 - (u >> 7));
        if (threadIdx.x == 0) UNIT[0] = nxt;
        __syncthreads();
        u = UNIT[0];
    }
}

#define XB_TMO      128
#define XB_XCNT(j)  (256  + 64 * (j))
#define XB_XSUB(j)  (1280 + 64 * (j))
#define XB_XGEN(j)  (2304 + 64 * (j))
#define XB_TOP      3328
#define XB_TOPGEN   3392
#define XCD_BAR_WORDS 3456
#define XB_SPIN_CAP (1u << 18)
DI unsigned xb_ld(unsigned* p)              { return __hip_atomic_load(p, __ATOMIC_RELAXED, __HIP_MEMORY_SCOPE_AGENT); }
DI unsigned xb_add(unsigned* p, unsigned v) { return __hip_atomic_fetch_add(p, v, __ATOMIC_RELAXED, __HIP_MEMORY_SCOPE_AGENT); }
DI unsigned xb_xcc_id() { return (unsigned)__builtin_amdgcn_s_getreg((3 << 11) | 20) & 0xFu; }
#define XB_SPIN(cond, bar) do { unsigned _sp = 0; while (cond) { __builtin_amdgcn_s_sleep(1); \
    if ((++_sp & 255u) == 0u) { if (xb_ld(&(bar)[XB_TMO])) break; if (_sp > XB_SPIN_CAP) { atomicAdd(&(bar)[XB_TMO], 1u); break; } } } } while (0)
struct XcdBarrier { unsigned* bar; unsigned x; volatile LAS3 unsigned* st; };
DI XcdBarrier xcd_barrier_post(unsigned* bar, volatile LAS3 unsigned* st) {
    XcdBarrier b; b.bar = bar; b.x = xb_xcc_id(); b.st = st;
    if (threadIdx.x == 0) (void)xb_add(&bar[XB_XCNT(b.x)], 1u);
    return b;
}
DI void xcd_barrier_complete(unsigned* bar, unsigned x, unsigned& nloc, unsigned& nx) {
    const unsigned G = gridDim.x * gridDim.y * gridDim.z;
    unsigned sum, cnt, mine, sp = 0u;
    for (;;) {
        sum = 0u; cnt = 0u; mine = 0u;
#pragma unroll
        for (unsigned j = 0; j < 16; ++j) { const unsigned c = xb_ld(&bar[XB_XCNT(j)]); sum += c; cnt += (c > 0u) ? 1u : 0u; mine = (j == x) ? c : mine; }
        if (sum == G) break;
        __builtin_amdgcn_s_sleep(1);
        if ((++sp & 255u) == 0u) { if (xb_ld(&bar[XB_TMO])) break; if (sp > XB_SPIN_CAP) { atomicAdd(&bar[XB_TMO], 1u); break; } }
    }
    nloc = mine > 0u ? mine : 1u; nx = cnt > 0u ? cnt : 1u;
}
DI void xcd_barrier(const XcdBarrier& b) {
    asm volatile("s_waitcnt vmcnt(0)" ::: "memory");
    __syncthreads();
    if (threadIdx.x == 0) {
        unsigned* bar = b.bar;
        __builtin_amdgcn_s_waitcnt(0);
        unsigned nloc = b.st[0], nx = b.st[1];
        if (nloc == 0u) { xcd_barrier_complete(bar, b.x, nloc, nx); b.st[0] = nloc; b.st[1] = nx; }
        const unsigned old = xb_add(&bar[XB_XSUB(b.x)], 1u);
        const unsigned gen = old / nloc;
        if (old + 1u == (gen + 1u) * nloc) {
            __builtin_amdgcn_fence(__ATOMIC_RELEASE, "agent");
            asm volatile("s_waitcnt vmcnt(0)" ::: "memory");
            const unsigned og = xb_add(&bar[XB_TOP], 1u);
            const unsigned tg = og / nx;
            if (og + 1u == (tg + 1u) * nx) xb_add(&bar[XB_TOPGEN], 1u);
            else XB_SPIN(xb_ld(&bar[XB_TOPGEN]) == tg, bar);
            __builtin_amdgcn_fence(__ATOMIC_ACQUIRE, "agent");
            xb_add(&bar[XB_XGEN(b.x)], 1u);
            asm volatile("s_waitcnt vmcnt(0)" ::: "memory");
        } else {
            XB_SPIN(xb_ld(&bar[XB_XGEN(b.x)]) == gen, bar);
            __builtin_amdgcn_fence(__ATOMIC_ACQUIRE, "agent");
            asm volatile("s_waitcnt vmcnt(0)" ::: "memory");
        }
    }
    __syncthreads();
}

#ifndef DUP
#define DUP 0
#endif
#define LP_PTRS unsigned char* ws = a.ws; bf16_t* P = (bf16_t*)(ws + WS_P); bf16_t* HY = (bf16_t*)(ws + WS_HY); bf16_t* H = (bf16_t*)(ws + WS_H); float* SS = (float*)(ws + WS_SS); float* GL = (float*)(ws + WS_GL); const float* xin = L ? a.out : a.in[I_X]; (void)P; (void)HY; (void)H; (void)SS; (void)GL; (void)xin
template <int L> DI void layer_phases(const Args& a, const XcdBarrier& bar, unsigned char* lds) {
    {   LP_PTRS; const bf16_t* W = (const bf16_t*)(ws + WS_WIN) + (size_t)L * NPAD * DM;
        pg8::Gemm g{H, W, NT, PP, DM}; pg8::StaticOrder S; S.init(NT, PP, (int)gridDim.x, (int)blockIdx.x);
        pg8::EpiProjF E{P, L ? SS : nullptr, (PG8_LAS float*)((PG8_LAS unsigned char*)lds + pg8::STAGE_BYTES), (const float*)(ws + WS_GAINS) + L * 320}; pg8::gemm_phase<pg8::EpiProjF, pg8::StaticOrder, true, true>((PG8_LAS unsigned char*)lds, g, S, E);
        gates_gemm(H, W + (size_t)PP * DM, GL, L ? SS : nullptr, L == 1);
        if (L == 0) { __syncthreads(); win1_late(a, (float*)lds); }
        if (DUP == 2 && L == 0) { xcd_barrier(bar); pg8::gemm_phase<pg8::EpiProjF, pg8::StaticOrder, true, true>((PG8_LAS unsigned char*)lds, g, S, E); gates_gemm(H, W + (size_t)PP * DM, GL, L ? SS : nullptr, false); } }
    xcd_barrier(bar);
    {   LP_PTRS; prep_cumsum(a, L, (float*)lds); prep_compress(a, L, P);
        if (DUP == 3 && L == 0) { xcd_barrier(bar); prep_cumsum(a, L, (float*)lds); prep_compress(a, L, P); } }
    xcd_barrier(bar);
    {   const float* bnd = (const float*)(a.ws + WS_BND) + L * 4;
        const bool online = fmaxf(fmaxf(bnd[0], bnd[1]), fmaxf(bnd[2], bnd[3])) > 60.f;
        if (online) phase_mix<true>(a, L, lds); else phase_mix<false>(a, L, lds);
        if (DUP == 4 && L == 0) { xcd_barrier(bar); phase_mix<false>(a, L, lds, 4); } }
    xcd_barrier(bar);
    {   LP_PTRS; pg8::Gemm g{HY, (const bf16_t*)(ws + WS_WOUT) + (size_t)L * DM * DMIX, NT, DM, DMIX}; pg8::StaticOrder S; S.init(NT, DM, (int)gridDim.x, (int)blockIdx.x);
        pg8::EpiOutF E{xin, a.out, L ? nullptr : H, a.in[I_NG] + DM, SS}; pg8::gemm_phase<pg8::EpiOutF, pg8::StaticOrder, true, true>((PG8_LAS unsigned char*)lds, g, S, E); }
}
__global__ void __launch_bounds__(512, 2) mk(Args a) {
    extern __shared__ __attribute__((aligned(16))) unsigned char lds[];
    __shared__ unsigned xb_st[2];
    cg::grid_group grid = cg::this_grid();
    if (threadIdx.x < 2) xb_st[threadIdx.x] = 0u;
    __syncthreads();
    const XcdBarrier bar = xcd_barrier_post((unsigned*)(a.ws + WS_CTL + 1024), (volatile LAS3 unsigned*)xb_st);
    phase_wprep(a, (float*)lds);
    phase_rms(a.in[I_X], a.in[I_NG], (bf16_t*)(a.ws + WS_H));
    for (int i = blockIdx.x * 512 + threadIdx.x; i < NT; i += gridDim.x * 512) ((float*)(a.ws + WS_SS))[i] = 0.f;
    if (DUP == 8) { grid.sync(); phase_wprep(a, (float*)lds); phase_rms(a.in[I_X], a.in[I_NG], (bf16_t*)(a.ws + WS_H)); }
    if (a.ph_lo < 0) grid.sync();
    xcd_barrier(bar);
    layer_phases<0>(a, bar, lds);
    xcd_barrier(bar);
    layer_phases<1>(a, bar, lds);
}

extern "C" void kernel_launch(void* const* d_in, const int* in_sizes, int n_in, void* d_out, int out_size, void* d_ws, size_t ws_size, hipStream_t stream) {
    static int grid = 0;
    if (grid == 0) {
        if (n_in != 21 || ws_size < WS_END) { fprintf(stderr, "kernel_launch: unexpected n_in %d / ws_size %zu (need %zu)\n", n_in, ws_size, (size_t)WS_END); grid = -1; return; }
        int dev = 0, cus = 0, per_cu = 0;
        (void)hipGetDevice(&dev); (void)hipDeviceGetAttribute(&cus, hipDeviceAttributeMultiprocessorCount, dev);
        (void)hipFuncSetAttribute((const void*)mk, hipFuncAttributeMaxDynamicSharedMemorySize, LDS_BYTES);
        (void)hipOccupancyMaxActiveBlocksPerMultiprocessor(&per_cu, (const void*)mk, 512, LDS_BYTES);
        if (per_cu < 1) { fprintf(stderr, "kernel_launch: occupancy query says %d blocks/CU\n", per_cu); per_cu = 1; }
        if (per_cu > 1) per_cu = 1;
        grid = cus * per_cu;
        (void)hipGetLastError();
    }
    if (grid < 0) return;
    if (hipMemsetAsync((char*)d_ws + WS_CTL, 0, WS_CTL_BYTES, stream) != hipSuccess) { fprintf(stderr, "kernel_launch: memset failed\n"); return; }
    Args a{};
    for (int i = 0; i < 21; ++i) a.in[i] = (const float*)d_in[i];
    a.out = (float*)d_out; a.ws = (unsigned char*)d_ws; a.ph_lo = 0; a.ph_hi = 13;
    void* args[] = {&a};
    hipError_t e = hipLaunchCooperativeKernel((const void*)mk, dim3(grid), dim3(512), args, LDS_BYTES, stream);
    if (e != hipSuccess) fprintf(stderr, "cooperative launch failed: %s (grid %d)\n", hipGetErrorString(e), grid);
}
```

```cpp
#define DUP 0
#include <hip/hip_runtime.h>
#include <hip/hip_cooperative_groups.h>
#include <stdint.h>
#include <stdio.h>
namespace cg = cooperative_groups;

#define DI __device__ __forceinline__
typedef unsigned short bf16_t;
typedef short bf16x8 __attribute__((ext_vector_type(8)));
typedef float f32x4 __attribute__((ext_vector_type(4)));
typedef float f32x16 __attribute__((ext_vector_type(16)));
typedef unsigned u32x4 __attribute__((ext_vector_type(4)));
typedef unsigned u32x2 __attribute__((ext_vector_type(2)));

constexpr int NB = 16, SEQ = 2048, DM = 1024, NT = NB * SEQ;
constexpr int DIN = 4896, DMIX = 1536, PP = 4864, NPAD = 5120;
constexpr int C_U = 0, C_Z = 512, C_NQ = 1024, C_KC = 1536, C_VC = 1664, C_KS = 1792, C_VS = 1920, C_KW = 2048, C_VW = 2176,
              C_NZ = 2304, C_FQ = 2816, C_FK = 3328, C_FV = 3840, C_FZ = 4352;
constexpr float LOG2E = 1.4426950408889634f, QS = 0.125f * LOG2E, EPS = 1e-6f;

constexpr size_t WS_P = 0;
constexpr size_t WS_HY = WS_P + (size_t)NT * PP * 2;
constexpr size_t WS_H = WS_HY + (size_t)NT * DMIX * 2;
constexpr size_t WS_SS = WS_H + (size_t)NT * DM * 2;
constexpr size_t WS_GL = WS_SS + (size_t)NT * 4;
constexpr size_t WS_WIN = WS_GL + (size_t)NT * 32 * 4;
constexpr size_t WS_WOUT = WS_WIN + (size_t)2 * NPAD * DM * 2;
constexpr size_t WS_WA = WS_WOUT + (size_t)2 * DM * DMIX * 2;
constexpr size_t WS_WX = WS_WA + 131072;
constexpr size_t WS_WCK = WS_WX + 131072;
constexpr size_t WS_WCV = WS_WCK + 524288;
constexpr size_t WS_BKV = WS_WCV + 524288;
constexpr size_t WS_BND = WS_BKV + 1024;
constexpr size_t WS_GAINS = WS_BKV + 2048;
constexpr size_t WS_C2 = WS_BKV + 8192;
constexpr size_t WS_KCMP = WS_C2 + (size_t)NB * 8 * SEQ * 4;
constexpr size_t WS_VCMP = WS_KCMP + 524288;
constexpr size_t WS_CTL = WS_VCMP + 524288;
constexpr size_t WS_CTL_BYTES = 16384;
constexpr size_t WS_END = WS_CTL + WS_CTL_BYTES;

constexpr int LDS_BYTES = 143360;

struct Args { const float* in[21]; float* out; unsigned char* ws; int ph_lo, ph_hi; };
enum { I_X = 0, I_NG, I_WIN, I_WOUT, I_CW, I_CB, I_WA, I_BA, I_WX, I_BX, I_LAM, I_NQG, I_NKG, I_PEK, I_PEV, I_WCK, I_WCV, I_GB, I_FQG, I_FKG, I_FFB };

DI int opaque_tid() { int t = threadIdx.x; asm volatile("" : "+v"(t)); return t; }
DI unsigned f2bf(float f) { unsigned u = __float_as_uint(f); return (u + 0x7fffu + ((u >> 16) & 1u)) >> 16; }
DI float bf2f(unsigned h) { return __uint_as_float(h << 16); }
DI unsigned pk2(float lo, float hi) { return f2bf(lo) | (f2bf(hi) << 16); }
DI float wave_sum(float v) { for (int o = 32; o; o >>= 1) v += __shfl_xor(v, o); return v; }
DI float sigmoidf_(float x) { return 1.f / (1.f + __expf(-x)); }
DI float siluf_(float x) { return x / (1.f + __expf(-x)); }
DI void unpack8(u32x4 r, float* f) {
#pragma unroll
    for (int i = 0; i < 4; ++i) { f[2 * i] = bf2f(r[i] & 0xffffu); f[2 * i + 1] = bf2f(r[i] >> 16); }
}

DI int win_col(int pc) {
    if (pc < 2304) return pc; if (pc < 4352) return pc + 24; if (pc < 4864) return pc + 32;
    if (pc < 4888) return 2304 + pc - 4864; if (pc < 4896) return 4376 + pc - 4888; return -1;
}
DI void wtile(const float* src, int ldsrc, bf16_t* dst, int K, int n0, int k0, int mode, float* t, const float* rowg = nullptr) {
    const int tid = opaque_tid();
#pragma unroll
    for (int i = 0; i < 8; ++i) {
        int kk = (tid >> 6) + 8 * i, nn = tid & 63, n = n0 + nn; int oc = mode ? win_col(n) : n;
        t[kk * 65 + nn] = oc >= 0 ? src[(size_t)(k0 + kk) * ldsrc + oc] * (rowg ? rowg[k0 + kk] : 1.f) : 0.f;
    }
    __syncthreads();
    {   const int nn = tid >> 3, k8 = (tid & 7) * 8; u32x4 w;
#pragma unroll
        for (int i = 0; i < 4; ++i) w[i] = pk2(t[(k8 + 2 * i) * 65 + nn], t[(k8 + 2 * i + 1) * 65 + nn]);
        *(u32x4*)(dst + (size_t)(n0 + nn) * K + k0 + k8) = w; }
    __syncthreads();
}
DI void phase_wprep(const Args& a, float* ldsf) {
    unsigned char* ws = a.ws;
    constexpr int PER = 1280 + 384 + 8 + 8 + 32 + 32 + 2;
    for (int u = blockIdx.x; u < 2 * PER; u += gridDim.x) {
        int l = u / PER, r = u % PER;
        if (r < 1280 && l == 1 && gridDim.x >= 256) continue;
        if (r < 1280) { wtile(a.in[I_WIN] + (size_t)l * DM * DIN, DIN, (bf16_t*)(ws + WS_WIN) + (size_t)l * NPAD * DM, DM, (r % 80) * 64, (r / 80) * 64, 1, ldsf, l ? a.in[I_NG] + DM : nullptr); continue; }
        r -= 1280;
        if (r < 384) { wtile(a.in[I_WOUT] + (size_t)l * DMIX * DM, DM, (bf16_t*)(ws + WS_WOUT) + (size_t)l * DM * DMIX, DMIX, (r % 16) * 64, (r / 16) * 64, 0, ldsf); continue; }
        r -= 384;
        if (r < 8) { wtile(a.in[I_WA] + (size_t)(l * 8 + r) * 4096, 64, (bf16_t*)(ws + WS_WA) + (size_t)(l * 8 + r) * 4096, 64, 0, 0, 0, ldsf); continue; }
        r -= 8;
        if (r < 8) { wtile(a.in[I_WX] + (size_t)(l * 8 + r) * 4096, 64, (bf16_t*)(ws + WS_WX) + (size_t)(l * 8 + r) * 4096, 64, 0, 0, 0, ldsf); continue; }
        r -= 8;
        if (r < 32) { wtile(a.in[I_WCK] + (size_t)l * 131072, 64, (bf16_t*)(ws + WS_WCK) + (size_t)l * 131072, 2048, 0, r * 64, 0, ldsf); continue; }
        r -= 32;
        if (r < 32) { wtile(a.in[I_WCV] + (size_t)l * 131072, 64, (bf16_t*)(ws + WS_WCV) + (size_t)l * 131072, 2048, 0, r * 64, 0, ldsf); continue; }
        r -= 32;
        {
            const float* pe = a.in[r ? I_PEV : I_PEK] + (size_t)l * 2048; const float* w = a.in[r ? I_WCV : I_WCK] + (size_t)l * 131072;
            const int e = threadIdx.x & 63, part = threadIdx.x >> 6; float s = 0.f;
#pragma unroll 16
            for (int k = part * 256; k < part * 256 + 256; ++k) s += pe[k] * w[(size_t)k * 64 + e];
            ldsf[part * 64 + e] = s; __syncthreads();
            if (threadIdx.x < 64) { float t = 0.f; for (int p = 0; p < 8; ++p) t += ldsf[p * 64 + e]; ((float*)(ws + WS_BKV))[(l * 2 + r) * 64 + e] = t; }
            if (r == 1 && threadIdx.x < 64) { float* gn = (float*)(ws + WS_GAINS) + l * 320;
                gn[e] = a.in[I_NQG][l * 64 + e] * QS; gn[64 + e] = a.in[I_NKG][(l * 3 + 1) * 64 + e]; gn[128 + e] = a.in[I_NKG][(l * 3 + 2) * 64 + e]; gn[192 + e] = a.in[I_FQG][l * 64 + e] * QS; gn[256 + e] = a.in[I_FKG][l * 64 + e]; }
            if (r == 0 && threadIdx.x < 64) {
                float gq = fabsf(a.in[I_NQG][l * 64 + e]), k0 = fabsf(a.in[I_NKG][(l * 3 + 0) * 64 + e]), k1 = fabsf(a.in[I_NKG][(l * 3 + 1) * 64 + e]), k2 = fabsf(a.in[I_NKG][(l * 3 + 2) * 64 + e]);
                float fq = fabsf(a.in[I_FQG][l * 64 + e]), fk = fabsf(a.in[I_FKG][l * 64 + e]);
                for (int o = 32; o; o >>= 1) { gq = fmaxf(gq, __shfl_xor(gq, o)); k0 = fmaxf(k0, __shfl_xor(k0, o)); k1 = fmaxf(k1, __shfl_xor(k1, o)); k2 = fmaxf(k2, __shfl_xor(k2, o)); fq = fmaxf(fq, __shfl_xor(fq, o)); fk = fmaxf(fk, __shfl_xor(fk, o)); }
                if (e == 0) { float* bnd = (float*)(ws + WS_BND) + l * 4; bnd[0] = QS * 64.f * gq * k0 * 1.01f + 0.5f; bnd[1] = QS * 64.f * gq * k1 * 1.01f + 0.5f; bnd[2] = QS * 64.f * gq * k2 * 1.01f + 0.5f; bnd[3] = QS * 64.f * fq * fk * 1.01f + 0.5f; }
            }
            __syncthreads();
        }
    }
}

DI void win1_late(const Args& a, float* ldsf) {
    if (gridDim.x < 256 || blockIdx.x < 128) return;
    for (int r = (int)blockIdx.x - 128; r < 1280; r += (int)gridDim.x - 128)
        wtile(a.in[I_WIN] + (size_t)DM * DIN, DIN, (bf16_t*)(a.ws + WS_WIN) + (size_t)NPAD * DM, DM, (r % 80) * 64, (r / 80) * 64, 1, ldsf, a.in[I_NG] + DM);
}

DI void phase_rms(const float* x, const float* g, bf16_t* H) {
    const int tid_ = opaque_tid(); const int lane = tid_ & 63, wid = tid_ >> 6;
    const int stride = gridDim.x * 8;
    int row = blockIdx.x * 8 + wid;
    f32x4 v[4], vn[4];
    if (row < NT) {
#pragma unroll
        for (int i = 0; i < 4; ++i) vn[i] = ((const f32x4*)(x + (size_t)row * DM))[lane + 64 * i];
    }
    for (; row < NT; row += stride) {
#pragma unroll
        for (int i = 0; i < 4; ++i) v[i] = vn[i];
        if (row + stride < NT) {
#pragma unroll
            for (int i = 0; i < 4; ++i) vn[i] = ((const f32x4*)(x + (size_t)(row + stride) * DM))[lane + 64 * i];
        }
        float ss = 0.f;
#pragma unroll
        for (int i = 0; i < 4; ++i) ss += v[i][0] * v[i][0] + v[i][1] * v[i][1] + v[i][2] * v[i][2] + v[i][3] * v[i][3];
        ss = wave_sum(ss);
        const float r = rsqrtf(ss * (1.f / DM) + EPS);
#pragma unroll
        for (int i = 0; i < 4; ++i) {
            const f32x4 gg = ((const f32x4*)g)[lane + 64 * i];
            u32x2 o; o[0] = pk2(v[i][0] * r * gg[0], v[i][1] * r * gg[1]); o[1] = pk2(v[i][2] * r * gg[2], v[i][3] * r * gg[3]);
            *(u32x2*)(H + (size_t)row * DM + (lane + 64 * i) * 4) = o;
        }
    }
}

namespace pg8 {
#define PG8_LAS __attribute__((address_space(3)))
typedef unsigned short bf16_t;
typedef short bf16x8 __attribute__((ext_vector_type(8)));
typedef float f32x4 __attribute__((ext_vector_type(4)));
typedef unsigned u32x4 __attribute__((ext_vector_type(4)));
constexpr int BM = 256, BK = 64, HALF = 128, HTB = HALF * BK * 2  , STAGE_BYTES = 8 * HTB, NXCD = 8, WGM = 8;

__host__ __device__ __forceinline__ int lds_byte(int r, int c) { const int st = (r >> 4) * 2 + (c >> 5), rr = r & 15, cc = c & 31, ob = rr * 64 + cc * 2; return st * 1024 + (ob ^ (((ob >> 9) & 1) << 5)); }
__host__ __device__ __forceinline__ void stage_rc(int b, int& R, int& C) { const int st = b / 1024, sb = b % 1024, swz = sb ^ (((sb >> 9) & 1) << 5); R = (st >> 1) * 16 + swz / 64; C = (st & 1) * 32 + (swz % 64) / 2; }
__host__ __device__ __forceinline__ int perm32(int rho) { const int n = rho >> 4, i = rho & 15; return 8 * (i >> 2) + 4 * n + (i & 3); }

struct Unit { int pm, pn; };
struct Gemm { const bf16_t* A; const bf16_t* Bt; int M, N, K; };

struct StaticOrder {
    int nM, nN, nwg, G, c;
    __host__ __device__ void init(int M, int N, int G_, int c_) { nM = M / BM; nN = N / BM; nwg = nM * nN; G = G_; c = c_; }
    __host__ __device__ bool next(int i, Unit& u) const {
        const long L = (long)i * G + c; if (L >= nwg) return false;
        int wgid = (int)L; { const int q = nwg / NXCD, r = nwg % NXCD, xcd = wgid % NXCD, off = wgid / NXCD; wgid = (xcd < r ? xcd * (q + 1) : r * (q + 1) + (xcd - r) * q) + off; }
        const int nig = WGM * nN, gid = wgid / nig, fm = gid * WGM, gsz = (nM - fm) < WGM ? (nM - fm) : WGM;
        u.pm = fm + ((wgid % nig) % gsz); u.pn = (wgid % nig) / gsz; return true;
    }
    __device__ __forceinline__ void a_ready(const Unit&) const {}
    __device__ __forceinline__ void done(const Unit&) const {}
};
__device__ __forceinline__ unsigned cvt_pk_bf16(float lo, float hi) { unsigned r; asm volatile("v_cvt_pk_bf16_f32 %0, %1, %2" : "=v"(r) : "v"(lo), "v"(hi)); return r; }

struct EpiProjF {
    static constexpr bool PERM = true, AFTER_DRAIN = false;
    bf16_t* P; const float* ss; PG8_LAS float* xs  ; const float* gains  ;
    __device__ __forceinline__ void operator()(const f32x4 (&acc)[2][2][4][2], const Unit& u, int wr, int wc, int fr, int fq) const {
        const int row0 = u.pm * BM + wr * 64 + fr;
        const int col0 = u.pn * BM + wc * 32 + 8 * fq;
        const int pn = u.pn, wid = wr * 4 + wc;
        const bool need = (pn == 4) | (pn == 5) | (pn == 7) | (pn == 8) | ((pn >= 11) & (pn <= 14));
        float hs[2][4][2];
        if (need) {
#pragma unroll
            for (int ai = 0; ai < 2; ++ai)
#pragma unroll
                for (int m = 0; m < 4; ++m)
#pragma unroll
                    for (int bj = 0; bj < 2; ++bj) { const f32x4 v0 = acc[ai][bj][m][0], v1 = acc[ai][bj][m][1];
                        float s = v0[0] * v0[0] + v0[1] * v0[1] + v0[2] * v0[2] + v0[3] * v0[3] + v1[0] * v1[0] + v1[1] * v1[1] + v1[2] * v1[2] + v1[3] * v1[3];
                        s += __shfl_xor(s, 16); s += __shfl_xor(s, 32);
                        hs[ai][m][bj] = s;
                        if (fq == 0) xs[(((wid * 2 + ai) * 4 + m) * 2 + bj) * 16 + fr] = s; }
            asm volatile("s_waitcnt lgkmcnt(0)" ::: "memory");
            __builtin_amdgcn_s_barrier();
        }
        const int kind = (pn <= 5) ? 0 : (pn == 7) ? 1 : (pn == 8) ? 2 : (pn <= 12) ? 3 : 4;
#pragma unroll
        for (int bj = 0; bj < 2; ++bj) {
            const bool hn = need && !((pn == 7 || pn == 8) && bj == 1);
            f32x4 g0 = (f32x4){1.f, 1.f, 1.f, 1.f}, g1 = g0;
            if (hn) { g0 = *(const f32x4*)(gains + kind * 64 + (wc & 1) * 32 + 8 * fq); g1 = *(const f32x4*)(gains + kind * 64 + (wc & 1) * 32 + 8 * fq + 4); }
#pragma unroll
            for (int ai = 0; ai < 2; ++ai)
#pragma unroll
                for (int m = 0; m < 4; ++m) { const int row = row0 + ai * HALF + m * 16;
                    const float rr = ss ? rsqrtf(ss[row] * (1.f / 1024) + 1e-6f) : 1.f;
                    float rs = rr;
                    if (hn) { const float tot = (hs[ai][m][bj] + xs[((((wid ^ 1) * 2 + ai) * 4 + m) * 2 + bj) * 16 + fr]) * rr * rr; rs = rr * rsqrtf(tot * (1.f / 64) + 1e-6f); }
                    const f32x4 v0 = acc[ai][bj][m][0] * rs * g0, v1 = acc[ai][bj][m][1] * rs * g1;
                    u32x4 w; w.x = cvt_pk_bf16(v0[0], v0[1]); w.y = cvt_pk_bf16(v0[2], v0[3]); w.z = cvt_pk_bf16(v1[0], v1[1]); w.w = cvt_pk_bf16(v1[2], v1[3]);
                    *(u32x4*)(P + (size_t)row * 4864 + col0 + bj * HALF) = w; }
        }
    }
};
struct EpiOutF {
    static constexpr bool PERM = true, AFTER_DRAIN = false;
    const float* res32; const bf16_t* res16; float* out32; bf16_t* out16; float* ss;
    __device__ __forceinline__ void operator()(const f32x4 (&acc)[2][2][4][2], const Unit& u, int wr, int wc, int fr, int fq) const {
        const int row0 = u.pm * BM + wr * 64 + fr, col0 = u.pn * BM + wc * 32 + 8 * fq;
#pragma unroll
        for (int ai = 0; ai < 2; ++ai)
#pragma unroll
            for (int m = 0; m < 4; ++m) { const int row = row0 + ai * HALF + m * 16; const size_t off = (size_t)row * 1024 + col0;
                float sq = 0.f;
#pragma unroll
                for (int bj = 0; bj < 2; ++bj) {
                    f32x4 r0, r1;
                    if (res16) { const u32x4 rb = *(const u32x4*)(res16 + off + bj * HALF);
                        r0 = (f32x4){__uint_as_float(rb[0] << 16), __uint_as_float(rb[0] & 0xffff0000u), __uint_as_float(rb[1] << 16), __uint_as_float(rb[1] & 0xffff0000u)};
                        r1 = (f32x4){__uint_as_float(rb[2] << 16), __uint_as_float(rb[2] & 0xffff0000u), __uint_as_float(rb[3] << 16), __uint_as_float(rb[3] & 0xffff0000u)}; }
                    else { r0 = *(const f32x4*)(res32 + off + bj * HALF); r1 = *(const f32x4*)(res32 + off + bj * HALF + 4); }
                    const f32x4 o0 = r0 + acc[ai][bj][m][0], o1 = r1 + acc[ai][bj][m][1];
                    if (out32) { *(f32x4*)(out32 + off + bj * HALF) = o0; *(f32x4*)(out32 + off + bj * HALF + 4) = o1; }
                    if (out16) { sq += o0[0] * o0[0] + o0[1] * o0[1] + o0[2] * o0[2] + o0[3] * o0[3] + o1[0] * o1[0] + o1[1] * o1[1] + o1[2] * o1[2] + o1[3] * o1[3];
                        u32x4 w; w.x = cvt_pk_bf16(o0[0], o0[1]); w.y = cvt_pk_bf16(o0[2], o0[3]); w.z = cvt_pk_bf16(o1[0], o1[1]); w.w = cvt_pk_bf16(o1[2], o1[3]);
                        *(u32x4*)(out16 + off + bj * HALF) = w; }
                    __builtin_amdgcn_sched_barrier(0); }
                if (out16) { sq += __shfl_xor(sq, 16); sq += __shfl_xor(sq, 32); if (fq == 0) atomicAdd(ss + row, sq); } }
    }
};

template <class Epi, class Sched, bool ALIGN_EPI = false, bool SP2 = false>
__device__ __forceinline__ void gemm_phase(PG8_LAS unsigned char* lds, const Gemm g, const Sched& S, const Epi& E) {
    int tid = threadIdx.x; asm volatile("" : "+v"(tid));
    const int wid = __builtin_amdgcn_readfirstlane(tid >> 6), lane = tid & 63, wr = wid >> 2, wc = wid & 3, fr = lane & 15, fq = lane >> 4;
    const int K = g.K, nt = K / BK;
    unsigned voffA[2], voffB[2];
#pragma unroll
    for (int i = 0; i < 2; ++i) { int R, C; stage_rc(tid * 16 + i * 8192, R, C); const int Rb = Epi::PERM ? ((R & ~31) + perm32(R & 31)) : R;
        voffA[i] = (unsigned)(R * K + C) * 2u; voffB[i] = (unsigned)(Rb * K + C) * 2u; }
    const size_t kstep = (size_t)(BK * 2);
    const size_t hstep = (size_t)HALF * K * 2;
    const size_t tstep = 2 * hstep;
    const unsigned ldsw = (unsigned)wid * 1024u;
    const int aoff = lds_byte(wr * 64 + fr, fq * 8), boff = lds_byte(wc * 32 + fr, fq * 8);
#define PG8_SA(b, h) (((b) * 2 + (h)) * HTB)
#define PG8_SB(b, h) ((4 + (b) * 2 + (h)) * HTB)
#define PG8_STAGE(bufoff, gbase, voff) do { _Pragma("unroll") for (int _i = 0; _i < 2; ++_i) \
        __builtin_amdgcn_global_load_lds((const unsigned*)((const char*)(gbase) + (voff)[_i]), (PG8_LAS unsigned*)(lds + (bufoff) + ldsw + _i * 8192), 16, 0, 0); } while (0)
#define PG8_LDA(dst, b, h) do { _Pragma("unroll") for (int m = 0; m < 4; ++m) _Pragma("unroll") for (int k = 0; k < 2; ++k) dst[m][k] = *(const PG8_LAS bf16x8*)(lds + PG8_SA(b, h) + aoff + m * 2048 + k * 1024); } while (0)
#define PG8_LDB(dst, b, h) do { _Pragma("unroll") for (int n = 0; n < 2; ++n) _Pragma("unroll") for (int k = 0; k < 2; ++k) dst[n][k] = *(const PG8_LAS bf16x8*)(lds + PG8_SB(b, h) + boff + n * 2048 + k * 1024); } while (0)
#define PG8_MMA(ai, bj, At, Bt) do { __builtin_amdgcn_s_setprio(1); _Pragma("unroll") for (int m = 0; m < 4; ++m) _Pragma("unroll") for (int n = 0; n < 2; ++n) _Pragma("unroll") for (int k = 0; k < 2; ++k) \
        acc[ai][bj][m][n] = __builtin_amdgcn_mfma_f32_16x16x32_bf16(Bt[n][k], At[m][k], acc[ai][bj][m][n], 0, 0, 0); __builtin_amdgcn_s_setprio(0); } while (0)
#define PG8_WAIT_V(n) asm volatile("s_waitcnt vmcnt(" #n ")" ::: "memory")
#define PG8_WAIT_L(n) asm volatile("s_waitcnt lgkmcnt(" #n ")" ::: "memory")
#define PG8_BAR __builtin_amdgcn_s_barrier()
#define PG8_SCHED __builtin_amdgcn_sched_barrier(0)
    Unit cur, nxt; int ui = 0;
    if (!S.next(0, cur)) return;
    f32x4 acc[2][2][4][2];
#pragma unroll
    for (int a = 0; a < 2; ++a)
#pragma unroll
        for (int b = 0; b < 2; ++b)
#pragma unroll
            for (int m = 0; m < 4; ++m)
#pragma unroll
                for (int n = 0; n < 2; ++n) acc[a][b][m][n] = (f32x4){0.f, 0.f, 0.f, 0.f};
    bf16x8 At[4][2], B0[2][2], B1[2][2];
    const char* cA = (const char*)g.A + (size_t)cur.pm * tstep; const char* cB = (const char*)g.Bt + (size_t)cur.pn * tstep;
    S.a_ready(cur);
    if constexpr (SP2) {
        PG8_STAGE(PG8_SB(0, 0), cB, voffB); PG8_STAGE(PG8_SB(0, 1), cB + hstep, voffB); PG8_STAGE(PG8_SA(0, 0), cA, voffA); PG8_STAGE(PG8_SA(0, 1), cA + hstep, voffA);
        if (wr == 1) PG8_BAR;
        PG8_WAIT_V(2); PG8_BAR;
        PG8_STAGE(PG8_SB(1, 0), cB + kstep, voffB); PG8_STAGE(PG8_SA(1, 0), cA + kstep, voffA); PG8_STAGE(PG8_SB(1, 1), cB + hstep + kstep, voffB);
        PG8_WAIT_V(6); PG8_BAR;
    } else {
        PG8_STAGE(PG8_SB(0, 0), cB, voffB); PG8_STAGE(PG8_SA(0, 0), cA, voffA); PG8_STAGE(PG8_SB(0, 1), cB + hstep, voffB); PG8_STAGE(PG8_SA(0, 1), cA + hstep, voffA);
        if (wr == 1) PG8_BAR;
        PG8_WAIT_V(4); PG8_BAR;
        PG8_STAGE(PG8_SB(1, 0), cB + kstep, voffB); PG8_STAGE(PG8_SA(1, 0), cA + kstep, voffA); PG8_STAGE(PG8_SB(1, 1), cB + hstep + kstep, voffB);
        PG8_WAIT_V(6); PG8_BAR;
    }
    for (;;) {
        const bool has_next = S.next(ui + 1, nxt);
        const char* nA = has_next ? (const char*)g.A + (size_t)nxt.pm * tstep : cA; const char* nB = has_next ? (const char*)g.Bt + (size_t)nxt.pn * tstep : cB;
        for (int t = 0; t < nt; t += 2) {
            const bool last = (t == nt - 2);
            const char* a1 = cA + (size_t)(t + 1) * kstep;
            const char* a2 = last ? nA : cA + (size_t)(t + 2) * kstep; const char* b2 = last ? nB : cB + (size_t)(t + 2) * kstep;
            const char* a3 = a2 + kstep; const char* b3 = b2 + kstep;
            if (last && has_next) S.a_ready(nxt);
            if constexpr (SP2) {
            PG8_LDB(B0, 0, 0); PG8_LDB(B1, 0, 1); PG8_SCHED; PG8_LDA(At, 0, 0); PG8_STAGE(PG8_SA(1, 1), a1 + hstep, voffA);
            PG8_WAIT_V(8); PG8_WAIT_L(0); PG8_BAR; PG8_MMA(0, 0, At, B0); PG8_MMA(0, 1, At, B1); PG8_BAR; PG8_SCHED;
            PG8_LDA(At, 0, 1); PG8_STAGE(PG8_SB(0, 0), b2, voffB); PG8_STAGE(PG8_SB(0, 1), b2 + hstep, voffB); PG8_STAGE(PG8_SA(0, 0), a2, voffA);
            PG8_WAIT_V(8); PG8_WAIT_L(0); PG8_BAR; PG8_MMA(1, 0, At, B0); PG8_MMA(1, 1, At, B1); PG8_BAR; PG8_SCHED;
            PG8_LDB(B0, 1, 0); PG8_LDB(B1, 1, 1); PG8_SCHED; PG8_LDA(At, 1, 0); PG8_STAGE(PG8_SA(0, 1), a2 + hstep, voffA);
            PG8_WAIT_V(8); PG8_WAIT_L(0); PG8_BAR; PG8_MMA(0, 0, At, B0); PG8_MMA(0, 1, At, B1); PG8_BAR; PG8_SCHED;
            PG8_LDA(At, 1, 1); PG8_STAGE(PG8_SB(1, 0), b3, voffB); PG8_STAGE(PG8_SB(1, 1), b3 + hstep, voffB); PG8_STAGE(PG8_SA(1, 0), a3, voffA);
            PG8_WAIT_V(8); PG8_WAIT_L(0); PG8_BAR; PG8_MMA(1, 0, At, B0); PG8_MMA(1, 1, At, B1); PG8_BAR; PG8_SCHED;
            } else {
            PG8_LDB(B0, 0, 0); PG8_SCHED; PG8_LDA(At, 0, 0); PG8_STAGE(PG8_SA(1, 1), a1 + hstep, voffA);
            PG8_WAIT_L(8); PG8_BAR; PG8_WAIT_L(0); PG8_MMA(0, 0, At, B0); PG8_BAR; PG8_SCHED;
            PG8_LDB(B1, 0, 1); PG8_STAGE(PG8_SB(0, 0), b2, voffB);
            PG8_BAR; PG8_WAIT_L(0); PG8_MMA(0, 1, At, B1); PG8_BAR;
            PG8_LDA(At, 0, 1); PG8_STAGE(PG8_SA(0, 0), a2, voffA);
            PG8_BAR; PG8_WAIT_L(0); PG8_MMA(1, 0, At, B0); PG8_BAR; PG8_SCHED;
            PG8_STAGE(PG8_SB(0, 1), b2 + hstep, voffB);
            PG8_WAIT_V(6); PG8_BAR; PG8_MMA(1, 1, At, B1); PG8_BAR;
            PG8_LDB(B0, 1, 0); PG8_SCHED; PG8_LDA(At, 1, 0); PG8_STAGE(PG8_SA(0, 1), a2 + hstep, voffA);
            PG8_WAIT_L(8); PG8_BAR; PG8_WAIT_L(0); PG8_MMA(0, 0, At, B0); PG8_BAR; PG8_SCHED;
            PG8_LDB(B1, 1, 1); PG8_STAGE(PG8_SB(1, 0), b3, voffB);
            PG8_BAR; PG8_WAIT_L(0); PG8_MMA(0, 1, At, B1); PG8_BAR;
            PG8_LDA(At, 1, 1); PG8_STAGE(PG8_SA(1, 0), a3, voffA);
            PG8_BAR; PG8_WAIT_L(0); PG8_MMA(1, 0, At, B0); PG8_BAR; PG8_SCHED;
            PG8_STAGE(PG8_SB(1, 1), b3 + hstep, voffB);
            PG8_WAIT_V(6); PG8_BAR; PG8_MMA(1, 1, At, B1); PG8_BAR;
            }
        }
        if constexpr (ALIGN_EPI) { if (wr == 0) PG8_BAR; }
        if constexpr (!Epi::AFTER_DRAIN) { E(acc, cur, wr, wc, fr, fq); S.done(cur); }
        if (!has_next) break;
#pragma unroll
        for (int a = 0; a < 2; ++a)
#pragma unroll
            for (int b = 0; b < 2; ++b)
#pragma unroll
                for (int m = 0; m < 4; ++m)
#pragma unroll
                    for (int n = 0; n < 2; ++n) acc[a][b][m][n] = (f32x4){0.f, 0.f, 0.f, 0.f};
        cur = nxt; cA = nA; cB = nB; ++ui;
        if constexpr (ALIGN_EPI) { if (wr == 1) PG8_BAR; }
    }
    PG8_WAIT_V(0);
    if constexpr (!ALIGN_EPI) { if (wr == 0) PG8_BAR; }
    PG8_BAR;
    if constexpr (Epi::AFTER_DRAIN) { E.fused(acc, cur, wr, wc, fr, fq, lds, wid, lane); S.done(cur); }
#undef PG8_SA
#undef PG8_SB
#undef PG8_STAGE
#undef PG8_LDA
#undef PG8_LDB
#undef PG8_MMA
#undef PG8_WAIT_V
#undef PG8_WAIT_L
#undef PG8_BAR
#undef PG8_SCHED
}
}


DI void gates_gemm(const bf16_t* H, const bf16_t* WgT  , float* GL, const float* ss, bool upper_half_only) {
    const int tid_ = opaque_tid(); const int lane = tid_ & 63, wid = tid_ >> 6, r32 = lane & 31, hi = lane >> 5;
    const int nb = (upper_half_only && gridDim.x >= 256) ? (int)gridDim.x - 128 : (int)gridDim.x, b0 = (int)gridDim.x - nb;
    if ((int)blockIdx.x < b0) return;
    for (int u = ((int)blockIdx.x - b0) + nb * wid; u < NT / 32; u += nb * 8) {
        const bf16_t* ap = H + (size_t)(u * 32 + r32) * DM + hi * 8; const bf16_t* bp = WgT + (size_t)r32 * DM + hi * 8;
        f32x16 acc;
#pragma unroll
        for (int i = 0; i < 16; ++i) acc[i] = 0.f;
#pragma unroll 8
        for (int k = 0; k < DM; k += 16) acc = __builtin_amdgcn_mfma_f32_32x32x16_bf16(*(const bf16x8*)(ap + k), *(const bf16x8*)(bp + k), acc, 0, 0, 0);
#pragma unroll
        for (int i = 0; i < 16; ++i) { const int row = u * 32 + (i & 3) + 8 * (i >> 2) + 4 * hi; const float rs = ss ? rsqrtf(ss[row] * (1.f / 1024) + EPS) : 1.f; GL[(size_t)row * 32 + r32] = acc[i] * rs; }
    }
}

DI float log_sigmoid_(float x) { return fminf(x, 0.f) - log1pf(__expf(-fabsf(x))); }
DI void prep_cumsum(const Args& a, int l, float* LS) {
    const float* GL = (const float*)(a.ws + WS_GL); float* C2 = (float*)(a.ws + WS_C2);
    const int tid = opaque_tid(), lane = tid & 63, wid = tid >> 6;
    for (int b = blockIdx.x; b < NB; b += gridDim.x) {
        __syncthreads();
#pragma unroll
        for (int i = 0; i < 4; ++i) {
            const int t = tid + 512 * i;
            const f32x4 v0 = *(const f32x4*)(GL + (size_t)(b * SEQ + t) * 32 + 24), v1 = *(const f32x4*)(GL + (size_t)(b * SEQ + t) * 32 + 28);
#pragma unroll
            for (int h = 0; h < 4; ++h) { LS[h * 2112 + (t >> 5) * 33 + (t & 31)] = log_sigmoid_(v0[h] + a.in[I_FFB][l * 8 + h]); LS[(h + 4) * 2112 + (t >> 5) * 33 + (t & 31)] = log_sigmoid_(v1[h] + a.in[I_FFB][l * 8 + 4 + h]); }
        }
        __syncthreads();
        {   float* row = LS + wid * 2112 + lane * 33;
            float tot = 0.f;
            for (int k = 0; k < 32; ++k) tot += row[k];
            float inc = tot;
#pragma unroll
            for (int o = 1; o < 64; o <<= 1) { const float n = __shfl_up(inc, o); if (lane >= o) inc += n; }
            float run = inc - tot;
            for (int k = 0; k < 32; ++k) { run += row[k]; row[k] = run * LOG2E; }
        }
        __syncthreads();
#pragma unroll
        for (int i = 0; i < 4; ++i) { const int t = tid + 512 * i;
#pragma unroll
            for (int h = 0; h < 8; ++h) C2[(size_t)(b * 8 + h) * SEQ + t] = LS[h * 2112 + (t >> 5) * 33 + (t & 31)]; }
    }
    __syncthreads();
}
DI void prep_compress(const Args& a, int l, const bf16_t* P) {
    unsigned char* ws = a.ws;
    const int tid_ = opaque_tid(); const int lane = tid_ & 63, wid = tid_ >> 6, fr = lane & 15, fq = lane >> 4;
    const int nbk = gridDim.x > 32 ? (int)gridDim.x - 16 : (int)gridDim.x, bk0 = (int)gridDim.x - nbk;
    if ((int)blockIdx.x < bk0) return;
    for (int it = ((int)blockIdx.x - bk0) + nbk * wid; it < NB * 2 * 2 * 8; it += nbk * 8) {
        const int nq = it & 7, kv = (it >> 3) & 1, g = (it >> 4) & 1, b = it >> 5;
        const int n = 16 * nq + fr; const bool ok = n < 127;
        const bf16_t* src = P + (size_t)(b * SEQ + (ok ? 16 * n : 0)) * PP + (kv ? C_VC : C_KC) + g * 64 + fq * 8;
        const bf16_t* W = (const bf16_t*)(ws + (kv ? WS_WCV : WS_WCK)) + (size_t)l * 131072 + (size_t)fr * 2048 + fq * 8;
        f32x4 acc[4];
#pragma unroll
        for (int nt = 0; nt < 4; ++nt) acc[nt] = (f32x4){0.f, 0.f, 0.f, 0.f};
#pragma unroll 4
        for (int ks = 0; ks < 64; ++ks) {
            bf16x8 af = *(const bf16x8*)(src + (size_t)(ks >> 1) * PP + (ks & 1) * 32);
            if (!ok) af = (bf16x8){0, 0, 0, 0, 0, 0, 0, 0};
#pragma unroll
            for (int nt = 0; nt < 4; ++nt) { const bf16x8 bw = *(const bf16x8*)(W + (size_t)nt * 16 * 2048 + ks * 32); acc[nt] = __builtin_amdgcn_mfma_f32_16x16x32_bf16(af, bw, acc[nt], 0, 0, 0); }
        }
        const float* bias = (const float*)(ws + WS_BKV) + (l * 2 + kv) * 64;
        float v[4][4];
#pragma unroll
        for (int nt = 0; nt < 4; ++nt)
#pragma unroll
            for (int i = 0; i < 4; ++i) v[nt][i] = acc[nt][i] + bias[16 * nt + fr];
        bf16_t* out = (bf16_t*)(ws + (kv ? WS_VCMP : WS_KCMP)) + (size_t)(b * 2 + g) * 128 * 64;
#pragma unroll
        for (int i = 0; i < 4; ++i) {
            const int row = 16 * nq + 4 * fq + i;
            float sc = 1.f;
            if (kv == 0) { float ss = v[0][i] * v[0][i] + v[1][i] * v[1][i] + v[2][i] * v[2][i] + v[3][i] * v[3][i];
                ss += __shfl_xor(ss, 1); ss += __shfl_xor(ss, 2); ss += __shfl_xor(ss, 4); ss += __shfl_xor(ss, 8); sc = rsqrtf(ss * (1.f / 64) + EPS); }
#pragma unroll
            for (int nt = 0; nt < 4; ++nt) { const int e = 16 * nt + fr; float o = v[nt][i] * sc; if (kv == 0) o *= a.in[I_NKG][(l * 3 + 0) * 64 + e]; if (row >= 127) o = 0.f;
                out[(size_t)row * 64 + e] = (bf16_t)f2bf(o); }
        }
    }
}


constexpr int A_KB = 0, A_VB = 18432, A_CB = A_VB + 16384, A_IG = A_CB + 512, A_IL = A_IG + 33792, A_SELM = A_IL + 33792, A_UN = A_SELM + 256, A_UNIT = A_UN + 16, A_SC = A_UNIT + 16, A_KG = A_SC + 2048, A_END = A_KG + 512;
static_assert(A_END <= LDS_BYTES, "attention LDS map");
struct ACtx { int r32, hi, tid, tok; bf16x8 qr[4]; };
typedef float f32x2_t __attribute__((ext_vector_type(2))); typedef __bf16 bf16x2_t __attribute__((ext_vector_type(2)));
typedef short v4i16_t __attribute__((ext_vector_type(4)));
#define LAS3 __attribute__((address_space(3)))
DI unsigned cvtpk(float lo, float hi) { f32x2_t v = {lo, hi}; bf16x2_t bb = __builtin_convertvector(v, bf16x2_t); return __builtin_bit_cast(unsigned, bb); }
DI v4i16_t vtr(const LAS3 unsigned char* p) { return __builtin_amdgcn_ds_read_tr16_b64_v4i16((LAS3 v4i16_t*)p); }

DI void load_q(ACtx& x, const bf16_t* qrow) {
#pragma unroll
    for (int d0 = 0; d0 < 4; ++d0) x.qr[d0] = *(const bf16x8*)(qrow + d0 * 16 + x.hi * 8);
}

template <int MODE, bool ONLINE>
DI void attn_tile_compute(const unsigned char* lds, int cur, int j, const ACtx& x, unsigned selm, int cblk, int wtokmin, float bref, float ctb, f32x16 (&oT)[2], float& m, float& l) {
    const bf16_t* KB = (const bf16_t*)(lds + A_KB) + cur * 4608;
    const int lane = x.tid & 63;
    f32x16 p0, p1;
    if (MODE == 3) {
        const float* CB = (const float*)(lds + A_CB) + cur * 64 + 4 * x.hi;
#pragma unroll
        for (int q = 0; q < 4; ++q) { const f32x4 c0 = *(const f32x4*)(CB + 8 * q), c1 = *(const f32x4*)(CB + 32 + 8 * q);
#pragma unroll
            for (int i = 0; i < 4; ++i) { p0[4 * q + i] = (ONLINE ? 0.f : ctb) - c0[i]; p1[4 * q + i] = (ONLINE ? 0.f : ctb) - c1[i]; } }
    } else {
#pragma unroll
        for (int i = 0; i < 16; ++i) { p0[i] = ONLINE ? 0.f : -bref; p1[i] = ONLINE ? 0.f : -bref; }
    }
#pragma unroll
    for (int d0 = 0; d0 < 4; ++d0) {
        const bf16x8 k0 = *(const bf16x8*)(KB + x.r32 * 72 + d0 * 16 + x.hi * 8);
        const bf16x8 k1 = *(const bf16x8*)(KB + (32 + x.r32) * 72 + d0 * 16 + x.hi * 8);
        p0 = __builtin_amdgcn_mfma_f32_32x32x16_bf16(k0, x.qr[d0], p0, 0, 0, 0);
        p1 = __builtin_amdgcn_mfma_f32_32x32x16_bf16(k1, x.qr[d0], p1, 0, 0, 0);
    }
    const float NEG = -INFINITY;
    const int kb = 64 * j + 4 * x.hi;
#define KK(r) (kb + ((r) & 3) + 8 * ((r) >> 2))
    if (MODE == 3) {
        if (64 * j + 63 > wtokmin) {
#pragma unroll
            for (int r = 0; r < 16; ++r) { const int kk = KK(r); if (kk > x.tok) p0[r] = NEG; if (kk + 32 > x.tok) p1[r] = NEG; }
        }
    } else if (MODE == 0) {
#pragma unroll
        for (int r = 0; r < 16; ++r) { const int n = KK(r); if (16 * n + 31 > x.tok) p0[r] = NEG; if (16 * (n + 32) + 31 > x.tok) p1[r] = NEG; }
    } else if (MODE == 1) {
        const bool on = (selm >> j) & 1u;
        const bool allon = __ballot(on) == ~0ull;
        if (j == cblk) {
#pragma unroll
            for (int r = 0; r < 16; ++r) { const int kk = KK(r); if (!on || kk > x.tok) p0[r] = NEG; if (!on || kk + 32 > x.tok) p1[r] = NEG; }
        } else if (!allon) {
#pragma unroll
            for (int r = 0; r < 16; ++r) { if (!on) { p0[r] = NEG; p1[r] = NEG; } }
        }
    } else {
        if (j == cblk) {
#pragma unroll
            for (int r = 0; r < 16; ++r) { const int kk = KK(r); if (kk > x.tok) p0[r] = NEG; if (kk + 32 > x.tok) p1[r] = NEG; }
        } else if (j == cblk - 8) {
#pragma unroll
            for (int r = 0; r < 16; ++r) { const int kk = KK(r); if (x.tok - kk >= 512) p0[r] = NEG; if (x.tok - kk - 32 >= 512) p1[r] = NEG; }
        }
    }
#undef KK
    if (ONLINE) {
        float mx = fmaxf(p0[0], p1[0]);
#pragma unroll
        for (int r = 1; r < 16; ++r) mx = fmaxf(mx, fmaxf(p0[r], p1[r]));
        mx = fmaxf(mx, __shfl_xor(mx, 32));
        const float mn = fmaxf(m, mx);
        if (__any(mn > m)) {
            const float sc = __builtin_amdgcn_exp2f(m - mn); l *= sc;
#pragma unroll
            for (int r = 0; r < 16; ++r) { oT[0][r] *= sc; oT[1][r] *= sc; }
        }
        m = mn;
#pragma unroll
        for (int r = 0; r < 16; ++r) { p0[r] -= mn; p1[r] -= mn; }
    }
    f32x2_t ls2 = {0.f, 0.f};
#pragma unroll
    for (int r = 0; r < 16; r += 2) { p0[r] = __builtin_amdgcn_exp2f(p0[r]); p0[r + 1] = __builtin_amdgcn_exp2f(p0[r + 1]); p1[r] = __builtin_amdgcn_exp2f(p1[r]); p1[r + 1] = __builtin_amdgcn_exp2f(p1[r + 1]);
        ls2 += (f32x2_t){p0[r], p0[r + 1]}; ls2 += (f32x2_t){p1[r], p1[r + 1]}; }
    l += ls2[0] + ls2[1];
    bf16x8 pf[4];
#pragma unroll
    for (int s = 0; s < 2; ++s) {
        u32x4 a0, a1;
#pragma unroll
        for (int i = 0; i < 4; ++i) { a0[i] = cvtpk(p0[8 * s + 2 * i], p0[8 * s + 2 * i + 1]); a1[i] = cvtpk(p1[8 * s + 2 * i], p1[8 * s + 2 * i + 1]); }
        pf[s] = __builtin_bit_cast(bf16x8, a0); pf[2 + s] = __builtin_bit_cast(bf16x8, a1);
    }
    const LAS3 unsigned char* vp = (const LAS3 unsigned char*)(lds + A_VB) + cur * 8192 + ((lane >> 4) & 1) * 32 + (lane & 3) * 8 + (4 * x.hi + ((lane & 15) >> 2)) * 64;
#pragma unroll
    for (int dh = 0; dh < 2; ++dh)
#pragma unroll
        for (int ks = 0; ks < 4; ++ks) {
            const v4i16_t lo = vtr(vp + dh * 4096 + ks * 1024), hi4 = vtr(vp + dh * 4096 + ks * 1024 + 512);
            const bf16x8 vf = (bf16x8){lo[0], lo[1], lo[2], lo[3], hi4[0], hi4[1], hi4[2], hi4[3]};
            oT[dh] = __builtin_amdgcn_mfma_f32_32x32x16_bf16(vf, pf[ks], oT[dh], 0, 0, 0);
        }
}

template <int MODE, bool ONLINE>
DI void attn_branch(unsigned char* lds, const bf16_t* Kg, int kp, const bf16_t* Vg, int vp, const float* Cg, int kgofs, unsigned tiles,
                    const ACtx& x, unsigned selm, int cblk, int wtokmin, int wtokmax, float bref, float ctb, f32x16 (&oT)[2], float& m, float& l) {
    const int tid = x.tid, srow = tid >> 3, sc8 = tid & 7;
    bf16_t* KB = (bf16_t*)(lds + A_KB); unsigned char* VB = lds + A_VB; float* CB = (float*)(lds + A_CB);
    const int kofs = srow * 72 + sc8 * 8, vofs = ((sc8 >> 2) * 4 + (srow >> 4)) * 1024 + (srow & 15) * 64 + (sc8 & 3) * 16;
    unsigned rem = tiles; if (!rem) return;
    u32x4 krA, vrA, krB, vrB; f32x4 crA = {0.f, 0.f, 0.f, 0.f}, crB = {0.f, 0.f, 0.f, 0.f};
#define POP(jv) do { jv = -1; if (rem) { jv = __builtin_ctz(rem); rem &= rem - 1; } } while (0)
#define LOADT(jj, kr, vr, cr) do { kr = *(const u32x4*)(Kg + (size_t)(64 * (jj) + srow) * kp + sc8 * 8); vr = *(const u32x4*)(Vg + (size_t)(64 * (jj) + srow) * vp + sc8 * 8); \
        if (MODE == 3 && tid < 16) cr = *(const f32x4*)(Cg + 64 * (jj) + tid * 4); } while (0)
#define STORET(buf, kr, vr, cr) do { *(u32x4*)(KB + (buf) * 4608 + kofs) = kr; *(u32x4*)(VB + (buf) * 8192 + vofs) = vr; if (MODE == 3 && tid < 16) *(f32x4*)(CB + (buf) * 64 + tid * 4) = cr; } while (0)
#define ACTIVE(jj) ((MODE == 1) ? (__ballot((selm >> (jj)) & 1u) != 0ull) : ((MODE == 3) ? (64 * (jj) <= wtokmax) : true))
    int j0, j1, j2, j3;
    POP(j0); LOADT(j0, krA, vrA, crA); STORET(0, krA, vrA, crA);
    POP(j1); if (j1 >= 0) LOADT(j1, krA, vrA, crA);
    __syncthreads();
    int cur = 0;
    for (;;) {
        POP(j2); if (j2 >= 0) LOADT(j2, krB, vrB, crB);
        if (ACTIVE(j0)) attn_tile_compute<MODE, ONLINE>(lds, cur, j0, x, selm, cblk, wtokmin, bref, ctb, oT, m, l);
        if (j1 >= 0) STORET(cur ^ 1, krA, vrA, crA);
        __syncthreads();
        if (j1 < 0) break;
        cur ^= 1;
        POP(j3); if (j3 >= 0) LOADT(j3, krA, vrA, crA);
        if (ACTIVE(j1)) attn_tile_compute<MODE, ONLINE>(lds, cur, j1, x, selm, cblk, wtokmin, bref, ctb, oT, m, l);
        if (j2 >= 0) STORET(cur ^ 1, krB, vrB, crB);
        __syncthreads();
        if (j2 < 0) break;
        cur ^= 1; j0 = j2; j1 = j3;
    }
#undef POP
#undef ACTIVE
#undef LOADT
#undef STORET
}
DI void zero_o(f32x16 (&oT)[2]) {
#pragma unroll
    for (int r = 0; r < 16; ++r) { oT[0][r] = 0.f; oT[1][r] = 0.f; }
}

template <bool ONLINE> DI void nsa_unit(const Args& a, int l, unsigned char* lds, int b, int g, int c) {
    unsigned char* ws = a.ws;
    const bf16_t* P = (const bf16_t*)(ws + WS_P); bf16_t* Y = (bf16_t*)(ws + WS_HY); const float* GL = (const float*)(ws + WS_GL);
    ACtx x; x.tid = threadIdx.x; asm volatile("" : "+v"(x.tid));
    const int lane = x.tid & 63, wid = __builtin_amdgcn_readfirstlane(x.tid >> 6); x.r32 = lane & 31; x.hi = lane >> 5;
    const int hq = 4 * g + (wid & 3), tokl = 32 * (wid >> 2) + x.r32; x.tok = 64 * c + tokl;
    const size_t row = (size_t)(b * SEQ + x.tok);
    load_q(x, P + row * PP + C_NQ + hq * 64);
#define GATE(k) sigmoidf_(GL[row * 32 + hq * 3 + (k)] + a.in[I_GB][l * 24 + hq * 3 + (k)])
    float* IG = (float*)(lds + A_IG); float* IL = (float*)(lds + A_IL); unsigned* SELM = (unsigned*)(lds + A_SELM); unsigned* UN = (unsigned*)(lds + A_UN);
    if (x.tid == 0) UN[0] = 0u;
    f32x16 oT[2], tot[2]; zero_o(oT); zero_o(tot);
    float m = -1e30f, ls = 0.f;
    const float* bnd = (const float*)(ws + WS_BND) + l * 4;
    const float b_cmp = bnd[0], b_slc = bnd[1], b_win = bnd[2];
    constexpr bool online = ONLINE;
#define BRANCH(MODE, ...) do { attn_branch<MODE, ONLINE>(__VA_ARGS__); } while (0)
    const bf16_t* KC = (const bf16_t*)(ws + WS_KCMP) + (size_t)(b * 2 + g) * 128 * 64; const bf16_t* VC = (const bf16_t*)(ws + WS_VCMP) + (size_t)(b * 2 + g) * 128 * 64;
    const int ncmpt = c >= 16 ? 2 : 1;
    BRANCH(0, lds, KC, 64, VC, 64, nullptr, 0, c >= 16 ? 3u : 1u, x, 0u, c, 0, 0, b_cmp, 0.f, oT, m, ls);
    const float cref = online ? m : b_cmp;
    {   float lt = ls + __shfl_xor(ls, 32); const float inv = lt > 0.f ? 1.f / lt : 0.f; const float g0 = GATE(0);
#pragma unroll
        for (int r = 0; r < 16; ++r) { tot[0][r] = oT[0][r] * (inv * g0); tot[1][r] = oT[1][r] * (inv * g0); }
        for (int tt = 0; tt < ncmpt; ++tt) {
            const bf16_t* KB = (const bf16_t*)(lds + A_KB) + tt * 4608;
            f32x16 p0, p1;
#pragma unroll
            for (int i = 0; i < 16; ++i) { p0[i] = -cref; p1[i] = -cref; }
#pragma unroll
            for (int d0 = 0; d0 < 4; ++d0) {
                const bf16x8 k0 = *(const bf16x8*)(KB + x.r32 * 72 + d0 * 16 + x.hi * 8); const bf16x8 k1 = *(const bf16x8*)(KB + (32 + x.r32) * 72 + d0 * 16 + x.hi * 8);
                p0 = __builtin_amdgcn_mfma_f32_32x32x16_bf16(k0, x.qr[d0], p0, 0, 0, 0); p1 = __builtin_amdgcn_mfma_f32_32x32x16_bf16(k1, x.qr[d0], p1, 0, 0, 0);
            }
            const int kb = 64 * tt + 4 * x.hi;
#pragma unroll
            for (int r = 0; r < 16; ++r) { const int n = kb + (r & 3) + 8 * (r >> 2);
                p0[r] = (16 * n + 31 <= x.tok) ? __builtin_amdgcn_exp2f(p0[r]) * inv : 0.f; p1[r] = (16 * (n + 32) + 31 <= x.tok) ? __builtin_amdgcn_exp2f(p1[r]) * inv : 0.f; }
            float* ig = IG + ((wid & 3) * 64 + tokl) * 33; float* il = IL + ((wid & 3) * 64 + tokl) * 33;
#pragma unroll
            for (int q = 0; q < 4; ++q) { const int jj = 16 * tt + 2 * q + x.hi;
                ig[jj] = p0[4 * q] + p0[4 * q + 1] + p0[4 * q + 2] + p0[4 * q + 3]; il[jj] = p0[4 * q + 3];
                ig[jj + 8] = p1[4 * q] + p1[4 * q + 1] + p1[4 * q + 2] + p1[4 * q + 3]; il[jj + 8] = p1[4 * q + 3]; }
        }
    }
    __syncthreads();
    {   int j = lane & 31; asm volatile("" : "+v"(j));
        unsigned wor = 0u;
#pragma unroll
        for (int it = 0; it < 4; ++it) {
            const int tl = 8 * wid + 2 * it + (lane >> 5);
            float imp = 0.f;
#pragma unroll
            for (int h4 = 0; h4 < 4; ++h4) { imp += IG[(h4 * 64 + tl) * 33 + j]; if (j > 0) imp += IL[(h4 * 64 + tl) * 33 + j - 1]; }
            const bool valid = j <= c, forced = (j == 0) || (j == c) || (j == c - 1);
            const float score = !valid ? -1e30f : (forced ? 1e9f : imp);
            float* scw = (float*)(lds + A_SC) + wid * 64;
            scw[lane] = score;
            __builtin_amdgcn_s_waitcnt(0xc07f); __builtin_amdgcn_wave_barrier();
            int rank = 0;
#pragma unroll
            for (int k4 = 0; k4 < 8; ++k4) { const f32x4 sk = *(const f32x4*)(scw + (lane & 32) + 4 * k4);
#pragma unroll
                for (int i = 0; i < 4; ++i) rank += (sk[i] > score) || (sk[i] == score && 4 * k4 + i < j); }
            __builtin_amdgcn_wave_barrier();
            const unsigned long long bal = __ballot(valid && rank < 16);
            const unsigned mine = (lane >> 5) ? (unsigned)(bal >> 32) : (unsigned)bal;
            if (j == 0) SELM[tl] = mine;
            wor |= (unsigned)bal | (unsigned)(bal >> 32);
        }
        if (lane == 0) atomicOr(UN, wor);
    }
    __syncthreads();
    const unsigned selm = SELM[tokl]; const unsigned un = UN[0];
    float* TOT = (float*)(lds + A_IG) + wid * 2048 + lane;
#pragma unroll
    for (int r = 0; r < 16; ++r) { TOT[r * 64] = tot[0][r]; TOT[(16 + r) * 64] = tot[1][r]; }
    zero_o(oT); m = -1e30f; ls = 0.f;
    BRANCH(1, lds, P + (size_t)b * SEQ * PP + C_KS + g * 64, PP, P + (size_t)b * SEQ * PP + C_VS + g * 64, PP, nullptr, 0, un, x, selm, c, 0, 0, b_slc, 0.f, oT, m, ls);
    {   float lt = ls + __shfl_xor(ls, 32); const float inv = lt > 0.f ? GATE(1) / lt : 0.f;
#pragma unroll
        for (int r = 0; r < 16; ++r) { TOT[r * 64] += oT[0][r] * inv; TOT[(16 + r) * 64] += oT[1][r] * inv; } }
    zero_o(oT); m = -1e30f; ls = 0.f;
    {   const int jlo = c >= 8 ? c - 8 : 0; const unsigned wt = (c >= 31 ? 0xffffffffu : ((1u << (c + 1)) - 1u)) & ~((1u << jlo) - 1u);
        BRANCH(2, lds, P + (size_t)b * SEQ * PP + C_KW + g * 64, PP, P + (size_t)b * SEQ * PP + C_VW + g * 64, PP, nullptr, 64, wt, x, 0u, c, 0, 0, b_win, 0.f, oT, m, ls); }
    {   float lt = ls + __shfl_xor(ls, 32); const float inv = lt > 0.f ? GATE(2) / lt : 0.f;
#pragma unroll
        for (int r = 0; r < 16; ++r) { tot[0][r] = TOT[r * 64] + oT[0][r] * inv; tot[1][r] = TOT[(16 + r) * 64] + oT[1][r] * inv; } }
#pragma unroll
    for (int dh = 0; dh < 2; ++dh)
#pragma unroll
        for (int q = 0; q < 4; ++q) {
            const int d = 32 * dh + 8 * q + 4 * x.hi;
            const u32x2 zz = *(const u32x2*)(P + row * PP + C_NZ + hq * 64 + d);
            const float z0 = bf2f(zz[0] & 0xffffu), z1 = bf2f(zz[0] >> 16), z2 = bf2f(zz[1] & 0xffffu), z3 = bf2f(zz[1] >> 16);
            u32x2 o; o[0] = cvtpk(tot[dh][4 * q] * siluf_(z0), tot[dh][4 * q + 1] * siluf_(z1)); o[1] = cvtpk(tot[dh][4 * q + 2] * siluf_(z2), tot[dh][4 * q + 3] * siluf_(z3));
            *(u32x2*)(Y + row * DMIX + 512 + hq * 64 + d) = o;
        }
}

template <bool ONLINE> DI void fox_unit(const Args& a, int l, unsigned char* lds, int b, int h, int c) {
    unsigned char* ws = a.ws;
    const bf16_t* P = (const bf16_t*)(ws + WS_P); bf16_t* Y = (bf16_t*)(ws + WS_HY);
    ACtx x; x.tid = threadIdx.x; asm volatile("" : "+v"(x.tid));
    const int lane = x.tid & 63, wid = __builtin_amdgcn_readfirstlane(x.tid >> 6); x.r32 = lane & 31; x.hi = lane >> 5;
    x.tok = 256 * c + 32 * wid + x.r32;
    const size_t row = (size_t)(b * SEQ + x.tok);
    load_q(x, P + row * PP + C_FQ + h * 64);
    const float* c2 = (const float*)(ws + WS_C2) + (size_t)(b * 8 + h) * SEQ;
    f32x16 oT[2]; zero_o(oT); float m = -1e30f, ls = 0.f;
    const int ntile = 4 * c + 4; const unsigned tiles = ntile >= 32 ? 0xffffffffu : ((1u << ntile) - 1u);
    unsigned tiles_ = tiles;
    if (!ONLINE) {
        const float cj = c2[64 * (lane & 31) + 63], c0 = c2[256 * c];
        tiles_ &= ~(unsigned)__ballot((lane < 32) && (c0 - cj <= -152.f));
    }
    const float b_fox = ((const float*)(ws + WS_BND))[l * 4 + 3]; const float ctb = c2[x.tok] - b_fox;
    attn_branch<3, ONLINE>(lds, P + (size_t)b * SEQ * PP + C_FK + h * 64, PP, P + (size_t)b * SEQ * PP + C_FV + h * 64, PP, c2, 0, tiles_, x, 0u, 0, 256 * c + 32 * wid, 256 * c + 32 * wid + 31, b_fox, ctb, oT, m, ls);
    float lt = ls + __shfl_xor(ls, 32); const float inv = lt > 0.f ? 1.f / lt : 0.f;
#pragma unroll
    for (int dh = 0; dh < 2; ++dh)
#pragma unroll
        for (int q = 0; q < 4; ++q) {
            const int d = 32 * dh + 8 * q + 4 * x.hi;
            const u32x2 zz = *(const u32x2*)(P + row * PP + C_FZ + h * 64 + d);
            const float z0 = bf2f(zz[0] & 0xffffu), z1 = bf2f(zz[0] >> 16), z2 = bf2f(zz[1] & 0xffffu), z3 = bf2f(zz[1] >> 16);
            u32x2 o; o[0] = cvtpk(oT[dh][4 * q] * inv * siluf_(z0), oT[dh][4 * q + 1] * inv * siluf_(z1)); o[1] = cvtpk(oT[dh][4 * q + 2] * inv * siluf_(z2), oT[dh][4 * q + 3] * inv * siluf_(z3));
            *(u32x2*)(Y + row * DMIX + 1024 + h * 64 + d) = o;
        }
}


constexpr int L_WA = 0, L_WX = 9216, L_XB = 18432, L_XF = 27648, L_G = 44032, L_SA = L_G + 2 * 64 * 65 * 4, L_SB = L_SA + 2048, L_CY = L_SB + 2048, L_END = L_CY + 512;
static_assert(L_END <= LDS_BYTES, "LRU LDS map");
DI float fsig(float x) { return __builtin_amdgcn_rcpf(1.f + __expf(-x)); }
DI float neg_expm1(float x) {
    const float t = x * (1.f + x * (0.5f + x * (0.16666667f + x * (0.041666668f + x * (0.0083333338f + x * 0.0013888889f)))));
    const float e = __expf(x) - 1.f;
    return -((x > -0.25f) ? t : e);
}
DI void lru_unit(const Args& a, int l, unsigned char* lds, int b, int h) {
    unsigned char* ws = a.ws;
    const bf16_t* P = (const bf16_t*)(ws + WS_P); bf16_t* Y = (bf16_t*)(ws + WS_HY);
    int tid = threadIdx.x; asm volatile("" : "+v"(tid));
    const int lane = tid & 63, wid = __builtin_amdgcn_readfirstlane(tid >> 6);
    bf16_t* WAl = (bf16_t*)(lds + L_WA); bf16_t* WXl = (bf16_t*)(lds + L_WX); bf16_t* XB = (bf16_t*)(lds + L_XB);
    float* XF = (float*)(lds + L_XF); float* G = (float*)(lds + L_G); float* SA = (float*)(lds + L_SA); float* SB = (float*)(lds + L_SB); float* CY = (float*)(lds + L_CY);
    __syncthreads();
    {   const int r = tid >> 3, c8 = (tid & 7) * 8;
        *(u32x4*)(WAl + r * 72 + c8) = *(const u32x4*)((const bf16_t*)(ws + WS_WA) + (size_t)(l * 8 + h) * 4096 + r * 64 + c8);
        *(u32x4*)(WXl + r * 72 + c8) = *(const u32x4*)((const bf16_t*)(ws + WS_WX) + (size_t)(l * 8 + h) * 4096 + r * 64 + c8);
        if (tid < 128) CY[tid] = 0.f; }
    const int tk1 = tid >> 3, c8 = (tid & 7) * 8, chb = h * 64 + c8;
    float cw[4][8], cb8[8];
#pragma unroll
    for (int i = 0; i < 8; ++i) { cb8[i] = a.in[I_CB][l * 512 + chb + i];
#pragma unroll
        for (int k = 0; k < 4; ++k) cw[k][i] = a.in[I_CW][(l * 4 + k) * 512 + chb + i]; }
    const int ch = tid & 63, sg = tid >> 6, chg = h * 64 + ch;
    const float ba = a.in[I_BA][l * 512 + chg], bx = a.in[I_BX][l * 512 + chg], lam = a.in[I_LAM][l * 512 + chg];
    const float sp8 = -8.f * (fmaxf(-lam, 0.f) + log1pf(__expf(-fabsf(lam))));
    const int fr = lane & 15, fq = lane >> 4, mat = wid >> 2, strip = wid & 3;
    const bf16_t* pu = P + (size_t)b * SEQ * PP + C_U + chb;
    u32x4 ur[4];
#pragma unroll
    for (int k = 0; k < 4; ++k) { const int t = tk1 - 3 + k; ur[k] = (t >= 0) ? *(const u32x4*)(pu + (size_t)t * PP) : (u32x4){0u, 0u, 0u, 0u}; }
    for (int tile = 0; tile < SEQ / 64; ++tile) {
        const int t0 = tile * 64;
        {   float xc[8];
#pragma unroll
            for (int i = 0; i < 8; ++i) xc[i] = cb8[i];
#pragma unroll
            for (int k = 0; k < 4; ++k) { float uf[8]; unpack8(ur[k], uf);
#pragma unroll
                for (int i = 0; i < 8; ++i) xc[i] += cw[k][i] * uf[i]; }
            *(f32x4*)(XF + tk1 * 64 + c8) = (f32x4){xc[0], xc[1], xc[2], xc[3]}; *(f32x4*)(XF + tk1 * 64 + c8 + 4) = (f32x4){xc[4], xc[5], xc[6], xc[7]};
            u32x4 pk; pk[0] = pk2(xc[0], xc[1]); pk[1] = pk2(xc[2], xc[3]); pk[2] = pk2(xc[4], xc[5]); pk[3] = pk2(xc[6], xc[7]);
            *(u32x4*)(XB + tk1 * 72 + c8) = pk;
            if (tile + 1 < SEQ / 64) {
#pragma unroll
                for (int k = 0; k < 4; ++k) ur[k] = *(const u32x4*)(pu + (size_t)(t0 + 64 + tk1 - 3 + k) * PP);
            }
        }
        __syncthreads();
        {   const bf16_t* W = mat ? WXl : WAl;
            f32x4 acc[4];
#pragma unroll
            for (int nt = 0; nt < 4; ++nt) acc[nt] = (f32x4){0.f, 0.f, 0.f, 0.f};
#pragma unroll
            for (int ks = 0; ks < 2; ++ks) {
                const bf16x8 af = *(const bf16x8*)(XB + (16 * strip + fr) * 72 + ks * 32 + fq * 8);
#pragma unroll
                for (int nt = 0; nt < 4; ++nt) { const bf16x8 bw = *(const bf16x8*)(W + (16 * nt + fr) * 72 + ks * 32 + fq * 8); acc[nt] = __builtin_amdgcn_mfma_f32_16x16x32_bf16(af, bw, acc[nt], 0, 0, 0); }
            }
            float* Gm = G + mat * 64 * 65;
#pragma unroll
            for (int nt = 0; nt < 4; ++nt)
#pragma unroll
                for (int i = 0; i < 4; ++i) Gm[(16 * strip + 4 * fq + i) * 65 + 16 * nt + fr] = acc[nt][i];
        }
        __syncthreads();
        {   const bf16_t* pz = P + (size_t)(b * SEQ + t0 + sg * 8) * PP + C_Z + chg;
            bf16_t zr[8];
#pragma unroll
            for (int k = 0; k < 8; ++k) zr[k] = pz[(size_t)k * PP];
            float av[8], bv[8]; float A = 1.f, Bc = 0.f;
#pragma unroll
            for (int k = 0; k < 8; ++k) {
                const int tk = sg * 8 + k;
                const float r = fsig(G[tk * 65 + ch] + ba), ig = fsig(G[64 * 65 + tk * 65 + ch] + bx), xcv = XF[tk * 64 + ch];
                const float la = r * sp8;
                av[k] = __expf(la); bv[k] = sqrtf(neg_expm1(2.f * la)) * (ig * xcv);
                Bc = av[k] * Bc + bv[k]; A *= av[k];
            }
            SA[sg * 64 + ch] = A; SB[sg * 64 + ch] = Bc;
            __syncthreads();
            float hs = CY[(tile & 1) * 64 + ch];
            for (int s = 0; s < sg; ++s) hs = SA[s * 64 + ch] * hs + SB[s * 64 + ch];
            bf16_t* py = Y + (size_t)(b * SEQ + t0 + sg * 8) * DMIX + chg;
#pragma unroll
            for (int k = 0; k < 8; ++k) { hs = av[k] * hs + bv[k]; py[(size_t)k * DMIX] = (bf16_t)f2bf(hs * siluf_(bf2f(zr[k]))); }
            if (sg == 7) CY[((tile & 1) ^ 1) * 64 + ch] = hs;
        }
    }
    __syncthreads();
}


template <bool ONLINE> DI void phase_mix(const Args& a, int l, unsigned char* lds, int cofs = 0, bool only_lru = false) {
    unsigned* ctr = (unsigned*)(a.ws + WS_CTL) + l * 16 + cofs;
    volatile int* UNIT = (volatile int*)(lds + A_UNIT);
    if (blockIdx.x < 128) lru_unit(a, l, lds, blockIdx.x >> 3, blockIdx.x & 7);
    if (only_lru) return;
    __syncthreads();
    if (threadIdx.x == 0) UNIT[0] = (int)atomicAdd(ctr, 1u);
    __syncthreads();
    for (int u = UNIT[0]; u < 1024; ) {
        int nxt = 0; if (threadIdx.x == 0) nxt = (int)atomicAdd(ctr, 1u);
        nsa_unit<ONLINE>(a, l, lds, (u & 31) >> 1, u & 1, 31 - (u >> 5));
        if (threadIdx.x == 0) UNIT[0] = nxt;
        __syncthreads();
        u = UNIT[0];
    }
    __syncthreads();
    if (threadIdx.x == 0) UNIT[0] = (int)atomicAdd(ctr + 1, 1u);
    __syncthreads();
    for (int u = UNIT[0]; u < 1024; ) {
        int nxt = 0; if (threadIdx.x == 0) nxt = (int)atomicAdd(ctr + 1, 1u);
        fox_unit<ONLINE>(a, l, lds, (u & 127) >> 3, u & 7, 7 - (u >> 7));
        if (threadIdx.x == 0) UNIT[0] = nxt;
        __syncthreads();
        u = UNIT[0];
    }
}

#define XB_TMO      128
#define XB_XCNT(j)  (256  + 64 * (j))
#define XB_XSUB(j)  (1280 + 64 * (j))
#define XB_XGEN(j)  (2304 + 64 * (j))
#define XB_TOP      3328
#define XB_TOPGEN   3392
#define XCD_BAR_WORDS 3456
#define XB_SPIN_CAP (1u << 18)
DI unsigned xb_ld(unsigned* p)              { return __hip_atomic_load(p, __ATOMIC_RELAXED, __HIP_MEMORY_SCOPE_AGENT); }
DI unsigned xb_add(unsigned* p, unsigned v) { return __hip_atomic_fetch_add(p, v, __ATOMIC_RELAXED, __HIP_MEMORY_SCOPE_AGENT); }
DI unsigned xb_xcc_id() { return (unsigned)__builtin_amdgcn_s_getreg((3 << 11) | 20) & 0xFu; }
#define XB_SPIN(cond, bar) do { unsigned _sp = 0; while (cond) { __builtin_amdgcn_s_sleep(1); \
    if ((++_sp & 255u) == 0u) { if (xb_ld(&(bar)[XB_TMO])) break; if (_sp > XB_SPIN_CAP) { atomicAdd(&(bar)[XB_TMO], 1u); break; } } } } while (0)
struct XcdBarrier { unsigned* bar; unsigned x; volatile LAS3 unsigned* st; };
DI XcdBarrier xcd_barrier_post(unsigned* bar, volatile LAS3 unsigned* st) {
    XcdBarrier b; b.bar = bar; b.x = xb_xcc_id(); b.st = st;
    if (threadIdx.x == 0) (void)xb_add(&bar[XB_XCNT(b.x)], 1u);
    return b;
}
DI void xcd_barrier_complete(unsigned* bar, unsigned x, unsigned& nloc, unsigned& nx) {
    const unsigned G = gridDim.x * gridDim.y * gridDim.z;
    unsigned sum, cnt, mine, sp = 0u;
    for (;;) {
        sum = 0u; cnt = 0u; mine = 0u;
#pragma unroll
        for (unsigned j = 0; j < 16; ++j) { const unsigned c = xb_ld(&bar[XB_XCNT(j)]); sum += c; cnt += (c > 0u) ? 1u : 0u; mine = (j == x) ? c : mine; }
        if (sum == G) break;
        __builtin_amdgcn_s_sleep(1);
        if ((++sp & 255u) == 0u) { if (xb_ld(&bar[XB_TMO])) break; if (sp > XB_SPIN_CAP) { atomicAdd(&bar[XB_TMO], 1u); break; } }
    }
    nloc = mine > 0u ? mine : 1u; nx = cnt > 0u ? cnt : 1u;
}
DI void xcd_barrier(const XcdBarrier& b) {
    asm volatile("s_waitcnt vmcnt(0)" ::: "memory");
    __syncthreads();
    if (threadIdx.x == 0) {
        unsigned* bar = b.bar;
        __builtin_amdgcn_s_waitcnt(0);
        unsigned nloc = b.st[0], nx = b.st[1];
        if (nloc == 0u) { xcd_barrier_complete(bar, b.x, nloc, nx); b.st[0] = nloc; b.st[1] = nx; }
        const unsigned old = xb_add(&bar[XB_XSUB(b.x)], 1u);
        const unsigned gen = old / nloc;
        if (old + 1u == (gen + 1u) * nloc) {
            __builtin_amdgcn_fence(__ATOMIC_RELEASE, "agent");
            asm volatile("s_waitcnt vmcnt(0)" ::: "memory");
            const unsigned og = xb_add(&bar[XB_TOP], 1u);
            const unsigned tg = og / nx;
            if (og + 1u == (tg + 1u) * nx) xb_add(&bar[XB_TOPGEN], 1u);
            else XB_SPIN(xb_ld(&bar[XB_TOPGEN]) == tg, bar);
            __builtin_amdgcn_fence(__ATOMIC_ACQUIRE, "agent");
            xb_add(&bar[XB_XGEN(b.x)], 1u);
            asm volatile("s_waitcnt vmcnt(0)" ::: "memory");
        } else {
            XB_SPIN(xb_ld(&bar[XB_XGEN(b.x)]) == gen, bar);
            __builtin_amdgcn_fence(__ATOMIC_ACQUIRE, "agent");
            asm volatile("s_waitcnt vmcnt(0)" ::: "memory");
        }
    }
    __syncthreads();
}

#ifndef DUP
#define DUP 0
#endif
#define LP_PTRS unsigned char* ws = a.ws; bf16_t* P = (bf16_t*)(ws + WS_P); bf16_t* HY = (bf16_t*)(ws + WS_HY); bf16_t* H = (bf16_t*)(ws + WS_H); float* SS = (float*)(ws + WS_SS); float* GL = (float*)(ws + WS_GL); const float* xin = L ? a.out : a.in[I_X]; (void)P; (void)HY; (void)H; (void)SS; (void)GL; (void)xin
template <int L> DI void layer_phases(const Args& a, const XcdBarrier& bar, unsigned char* lds) {
    {   LP_PTRS; const bf16_t* W = (const bf16_t*)(ws + WS_WIN) + (size_t)L * NPAD * DM;
        pg8::Gemm g{H, W, NT, PP, DM}; pg8::StaticOrder S; S.init(NT, PP, (int)gridDim.x, (int)blockIdx.x);
        pg8::EpiProjF E{P, L ? SS : nullptr, (PG8_LAS float*)((PG8_LAS unsigned char*)lds + pg8::STAGE_BYTES), (const float*)(ws + WS_GAINS) + L * 320}; pg8::gemm_phase<pg8::EpiProjF, pg8::StaticOrder, true, true>((PG8_LAS unsigned char*)lds, g, S, E);
        gates_gemm(H, W + (size_t)PP * DM, GL, L ? SS : nullptr, L == 1);
        if (L == 0) { __syncthreads(); win1_late(a, (float*)lds); }
        if (DUP == 2 && L == 0) { xcd_barrier(bar); pg8::gemm_phase<pg8::EpiProjF, pg8::StaticOrder, true, true>((PG8_LAS unsigned char*)lds, g, S, E); gates_gemm(H, W + (size_t)PP * DM, GL, L ? SS : nullptr, false); } }
    xcd_barrier(bar);
    {   LP_PTRS; prep_cumsum(a, L, (float*)lds); prep_compress(a, L, P);
        if (DUP == 3 && L == 0) { xcd_barrier(bar); prep_cumsum(a, L, (float*)lds); prep_compress(a, L, P); } }
    xcd_barrier(bar);
    {   const float* bnd = (const float*)(a.ws + WS_BND) + L * 4;
        const bool online = fmaxf(fmaxf(bnd[0], bnd[1]), fmaxf(bnd[2], bnd[3])) > 60.f;
        if (online) phase_mix<true>(a, L, lds); else phase_mix<false>(a, L, lds);
        if (DUP == 4 && L == 0) { xcd_barrier(bar); phase_mix<false>(a, L, lds, 4); } }
    xcd_barrier(bar);
    {   LP_PTRS; pg8::Gemm g{HY, (const bf16_t*)(ws + WS_WOUT) + (size_t)L * DM * DMIX, NT, DM, DMIX}; pg8::StaticOrder S; S.init(NT, DM, (int)gridDim.x, (int)blockIdx.x);
        pg8::EpiOutF E{L ? nullptr : a.in[I_X], L ? H : nullptr, L ? a.out : nullptr, L ? nullptr : H, SS}; pg8::gemm_phase<pg8::EpiOutF, pg8::StaticOrder, true, true>((PG8_LAS unsigned char*)lds, g, S, E); }
}
__global__ void __launch_bounds__(512, 2) mk(Args a) {
    extern __shared__ __attribute__((aligned(16))) unsigned char lds[];
    __shared__ unsigned xb_st[2];
    cg::grid_group grid = cg::this_grid();
    if (threadIdx.x < 2) xb_st[threadIdx.x] = 0u;
    __syncthreads();
    const XcdBarrier bar = xcd_barrier_post((unsigned*)(a.ws + WS_CTL + 1024), (volatile LAS3 unsigned*)xb_st);
    phase_wprep(a, (float*)lds);
    phase_rms(a.in[I_X], a.in[I_NG], (bf16_t*)(a.ws + WS_H));
    for (int i = blockIdx.x * 512 + threadIdx.x; i < NT; i += gridDim.x * 512) ((float*)(a.ws + WS_SS))[i] = 0.f;
    if (DUP == 8) { grid.sync(); phase_wprep(a, (float*)lds); phase_rms(a.in[I_X], a.in[I_NG], (bf16_t*)(a.ws + WS_H)); }
    if (a.ph_lo < 0) grid.sync();
    xcd_barrier(bar);
    layer_phases<0>(a, bar, lds);
    xcd_barrier(bar);
    layer_phases<1>(a, bar, lds);
}

extern "C" void kernel_launch(void* const* d_in, const int* in_sizes, int n_in, void* d_out, int out_size, void* d_ws, size_t ws_size, hipStream_t stream) {
    static int grid = 0;
    if (grid == 0) {
        if (n_in != 21 || ws_size < WS_END) { fprintf(stderr, "kernel_launch: unexpected n_in %d / ws_size %zu (need %zu)\n", n_in, ws_size, (size_t)WS_END); grid = -1; return; }
        int dev = 0, cus = 0, per_cu = 0;
        (void)hipGetDevice(&dev); (void)hipDeviceGetAttribute(&cus, hipDeviceAttributeMultiprocessorCount, dev);
        (void)hipFuncSetAttribute((const void*)mk, hipFuncAttributeMaxDynamicSharedMemorySize, LDS_BYTES);
        (void)hipOccupancyMaxActiveBlocksPerMultiprocessor(&per_cu, (const void*)mk, 512, LDS_BYTES);
        if (per_cu < 1) { fprintf(stderr, "kernel_launch: occupancy query says %d blocks/CU\n", per_cu); per_cu = 1; }
        if (per_cu > 1) per_cu = 1;
        grid = cus * per_cu;
        (void)hipGetLastError();
    }
    if (grid < 0) return;
    if (hipMemsetAsync((char*)d_ws + WS_CTL, 0, WS_CTL_BYTES, stream) != hipSuccess) { fprintf(stderr, "kernel_launch: memset failed\n"); return; }
    Args a{};
    for (int i = 0; i < 21; ++i) a.in[i] = (const float*)d_in[i];
    a.out = (float*)d_out; a.ws = (unsigned char*)d_ws; a.ph_lo = 0; a.ph_hi = 13;
    void* args[] = {&a};
    hipError_t e = hipLaunchCooperativeKernel((const void*)mk, dim3(grid), dim3(512), args, LDS_BYTES, stream);
    if (e != hipSuccess) fprintf(stderr, "cooperative launch failed: %s (grid %d)\n", hipGetErrorString(e), grid);
}
```

```cpp
#define DUP 0
#include <hip/hip_runtime.h>
#include <hip/hip_cooperative_groups.h>
#include <stdint.h>
#include <stdio.h>
namespace cg = cooperative_groups;

#define DI __device__ __forceinline__
typedef unsigned short bf16_t;
typedef short bf16x8 __attribute__((ext_vector_type(8)));
typedef float f32x4 __attribute__((ext_vector_type(4)));
typedef float f32x16 __attribute__((ext_vector_type(16)));
typedef unsigned u32x4 __attribute__((ext_vector_type(4)));
typedef unsigned u32x2 __attribute__((ext_vector_type(2)));

constexpr int NB = 16, SEQ = 2048, DM = 1024, NT = NB * SEQ;
constexpr int DIN = 4896, DMIX = 1536, PP = 4864, NPAD = 5120;
constexpr int C_U = 0, C_Z = 512, C_NQ = 1024, C_KC = 1536, C_VC = 1664, C_KS = 1792, C_VS = 1920, C_KW = 2048, C_VW = 2176,
              C_NZ = 2304, C_FQ = 2816, C_FK = 3328, C_FV = 3840, C_FZ = 4352;
constexpr float LOG2E = 1.4426950408889634f, QS = 0.125f * LOG2E, EPS = 1e-6f;

constexpr size_t WS_P = 0;
constexpr size_t WS_HY = WS_P + (size_t)NT * PP * 2;
constexpr size_t WS_H = WS_HY + (size_t)NT * DMIX * 2;
constexpr size_t WS_SS = WS_H + (size_t)NT * DM * 2;
constexpr size_t WS_GL = WS_SS + (size_t)NT * 4;
constexpr size_t WS_WIN = WS_GL + (size_t)NT * 32 * 4;
constexpr size_t WS_WOUT = WS_WIN + (size_t)2 * NPAD * DM * 2;
constexpr size_t WS_WA = WS_WOUT + (size_t)2 * DM * DMIX * 2;
constexpr size_t WS_WX = WS_WA + 131072;
constexpr size_t WS_WCK = WS_WX + 131072;
constexpr size_t WS_WCV = WS_WCK + 524288;
constexpr size_t WS_BKV = WS_WCV + 524288;
constexpr size_t WS_BND = WS_BKV + 1024;
constexpr size_t WS_GAINS = WS_BKV + 2048;
constexpr size_t WS_C2 = WS_BKV + 8192;
constexpr size_t WS_KCMP = WS_C2 + (size_t)NB * 8 * SEQ * 4;
constexpr size_t WS_VCMP = WS_KCMP + 524288;
constexpr size_t WS_CTL = WS_VCMP + 524288;
constexpr size_t WS_CTL_BYTES = 16384;
constexpr size_t WS_END = WS_CTL + WS_CTL_BYTES;

constexpr int LDS_BYTES = 143360;

struct Args { const float* in[21]; float* out; unsigned char* ws; int ph_lo, ph_hi; };
enum { I_X = 0, I_NG, I_WIN, I_WOUT, I_CW, I_CB, I_WA, I_BA, I_WX, I_BX, I_LAM, I_NQG, I_NKG, I_PEK, I_PEV, I_WCK, I_WCV, I_GB, I_FQG, I_FKG, I_FFB };

DI int opaque_tid() { int t = threadIdx.x; asm volatile("" : "+v"(t)); return t; }
DI unsigned f2bf(float f) { unsigned u = __float_as_uint(f); return (u + 0x7fffu + ((u >> 16) & 1u)) >> 16; }
DI float bf2f(unsigned h) { return __uint_as_float(h << 16); }
DI unsigned pk2(float lo, float hi) { return f2bf(lo) | (f2bf(hi) << 16); }
DI float wave_sum(float v) { for (int o = 32; o; o >>= 1) v += __shfl_xor(v, o); return v; }
DI float sigmoidf_(float x) { return 1.f / (1.f + __expf(-x)); }
DI float siluf_(float x) { return x / (1.f + __expf(-x)); }
DI void unpack8(u32x4 r, float* f) {
#pragma unroll
    for (int i = 0; i < 4; ++i) { f[2 * i] = bf2f(r[i] & 0xffffu); f[2 * i + 1] = bf2f(r[i] >> 16); }
}

DI int win_col(int pc) {
    if (pc < 2304) return pc; if (pc < 4352) return pc + 24; if (pc < 4864) return pc + 32;
    if (pc < 4888) return 2304 + pc - 4864; if (pc < 4896) return 4376 + pc - 4888; return -1;
}
DI void wtile(const float* src, int ldsrc, bf16_t* dst, int K, int n0, int k0, int mode, float* t, const float* rowg = nullptr) {
    const int tid = opaque_tid();
#pragma unroll
    for (int i = 0; i < 8; ++i) {
        int kk = (tid >> 6) + 8 * i, nn = tid & 63, n = n0 + nn; int oc = mode ? win_col(n) : n;
        t[kk * 65 + nn] = oc >= 0 ? src[(size_t)(k0 + kk) * ldsrc + oc] * (rowg ? rowg[k0 + kk] : 1.f) : 0.f;
    }
    __syncthreads();
    {   const int nn = tid >> 3, k8 = (tid & 7) * 8; u32x4 w;
#pragma unroll
        for (int i = 0; i < 4; ++i) w[i] = pk2(t[(k8 + 2 * i) * 65 + nn], t[(k8 + 2 * i + 1) * 65 + nn]);
        *(u32x4*)(dst + (size_t)(n0 + nn) * K + k0 + k8) = w; }
    __syncthreads();
}
DI void phase_wprep(const Args& a, float* ldsf, int stage) {
    unsigned char* ws = a.ws;
    constexpr int PER = 1280 + 384 + 8 + 8 + 32 + 32 + 2;
    const bool split = gridDim.x >= 256;
    if (stage == 1 && (!split || blockIdx.x < 16)) return;
    const int ub = stage == 1 ? (int)blockIdx.x - 16 : (int)blockIdx.x, us = stage == 1 ? (int)gridDim.x - 16 : (int)gridDim.x;
    for (int u = ub; u < 2 * PER; u += us) {
        int l = u / PER, r = u % PER;
        if (split) {
            const bool early = (l == 0 && r < 1280) || (l == 0 && r >= 1280 + 384 + 16 && r < PER - 2) || (r >= PER - 2);
            const bool late1 = (r >= 1280 && r < 1280 + 384 + 16) || (l == 1 && r >= 1280 + 384 + 16 && r < PER - 2);
            if (stage == 0 ? !early : !late1) continue;
        }
        if (r < 1280) { wtile(a.in[I_WIN] + (size_t)l * DM * DIN, DIN, (bf16_t*)(ws + WS_WIN) + (size_t)l * NPAD * DM, DM, (r % 80) * 64, (r / 80) * 64, 1, ldsf, l ? a.in[I_NG] + DM : nullptr); continue; }
        r -= 1280;
        if (r < 384) { wtile(a.in[I_WOUT] + (size_t)l * DMIX * DM, DM, (bf16_t*)(ws + WS_WOUT) + (size_t)l * DM * DMIX, DMIX, (r % 16) * 64, (r / 16) * 64, 0, ldsf); continue; }
        r -= 384;
        if (r < 8) { wtile(a.in[I_WA] + (size_t)(l * 8 + r) * 4096, 64, (bf16_t*)(ws + WS_WA) + (size_t)(l * 8 + r) * 4096, 64, 0, 0, 0, ldsf); continue; }
        r -= 8;
        if (r < 8) { wtile(a.in[I_WX] + (size_t)(l * 8 + r) * 4096, 64, (bf16_t*)(ws + WS_WX) + (size_t)(l * 8 + r) * 4096, 64, 0, 0, 0, ldsf); continue; }
        r -= 8;
        if (r < 32) { wtile(a.in[I_WCK] + (size_t)l * 131072, 64, (bf16_t*)(ws + WS_WCK) + (size_t)l * 131072, 2048, 0, r * 64, 0, ldsf); continue; }
        r -= 32;
        if (r < 32) { wtile(a.in[I_WCV] + (size_t)l * 131072, 64, (bf16_t*)(ws + WS_WCV) + (size_t)l * 131072, 2048, 0, r * 64, 0, ldsf); continue; }
        r -= 32;
        {
            const float* pe = a.in[r ? I_PEV : I_PEK] + (size_t)l * 2048; const float* w = a.in[r ? I_WCV : I_WCK] + (size_t)l * 131072;
            const int e = threadIdx.x & 63, part = threadIdx.x >> 6; float s = 0.f;
#pragma unroll 16
            for (int k = part * 256; k < part * 256 + 256; ++k) s += pe[k] * w[(size_t)k * 64 + e];
            ldsf[part * 64 + e] = s; __syncthreads();
            if (threadIdx.x < 64) { float t = 0.f; for (int p = 0; p < 8; ++p) t += ldsf[p * 64 + e]; ((float*)(ws + WS_BKV))[(l * 2 + r) * 64 + e] = t; }
            if (r == 1 && threadIdx.x < 64) { float* gn = (float*)(ws + WS_GAINS) + l * 320;
                gn[e] = a.in[I_NQG][l * 64 + e] * QS; gn[64 + e] = a.in[I_NKG][(l * 3 + 1) * 64 + e]; gn[128 + e] = a.in[I_NKG][(l * 3 + 2) * 64 + e]; gn[192 + e] = a.in[I_FQG][l * 64 + e] * QS; gn[256 + e] = a.in[I_FKG][l * 64 + e]; }
            if (r == 0 && threadIdx.x < 64) {
                float gq = fabsf(a.in[I_NQG][l * 64 + e]), k0 = fabsf(a.in[I_NKG][(l * 3 + 0) * 64 + e]), k1 = fabsf(a.in[I_NKG][(l * 3 + 1) * 64 + e]), k2 = fabsf(a.in[I_NKG][(l * 3 + 2) * 64 + e]);
                float fq = fabsf(a.in[I_FQG][l * 64 + e]), fk = fabsf(a.in[I_FKG][l * 64 + e]);
                for (int o = 32; o; o >>= 1) { gq = fmaxf(gq, __shfl_xor(gq, o)); k0 = fmaxf(k0, __shfl_xor(k0, o)); k1 = fmaxf(k1, __shfl_xor(k1, o)); k2 = fmaxf(k2, __shfl_xor(k2, o)); fq = fmaxf(fq, __shfl_xor(fq, o)); fk = fmaxf(fk, __shfl_xor(fk, o)); }
                if (e == 0) { float* bnd = (float*)(ws + WS_BND) + l * 4; bnd[0] = QS * 64.f * gq * k0 * 1.01f + 0.5f; bnd[1] = QS * 64.f * gq * k1 * 1.01f + 0.5f; bnd[2] = QS * 64.f * gq * k2 * 1.01f + 0.5f; bnd[3] = QS * 64.f * fq * fk * 1.01f + 0.5f; }
            }
            __syncthreads();
        }
    }
}

DI void win1_late(const Args& a, float* ldsf) {
    if (gridDim.x < 256 || blockIdx.x < 128) return;
    for (int r = (int)blockIdx.x - 128; r < 1280; r += (int)gridDim.x - 128)
        wtile(a.in[I_WIN] + (size_t)DM * DIN, DIN, (bf16_t*)(a.ws + WS_WIN) + (size_t)NPAD * DM, DM, (r % 80) * 64, (r / 80) * 64, 1, ldsf, a.in[I_NG] + DM);
}

DI void phase_rms(const float* x, const float* g, bf16_t* H) {
    const int tid_ = opaque_tid(); const int lane = tid_ & 63, wid = tid_ >> 6;
    const int stride = gridDim.x * 8;
    int row = blockIdx.x * 8 + wid;
    f32x4 v[4], vn[4];
    if (row < NT) {
#pragma unroll
        for (int i = 0; i < 4; ++i) vn[i] = ((const f32x4*)(x + (size_t)row * DM))[lane + 64 * i];
    }
    for (; row < NT; row += stride) {
#pragma unroll
        for (int i = 0; i < 4; ++i) v[i] = vn[i];
        if (row + stride < NT) {
#pragma unroll
            for (int i = 0; i < 4; ++i) vn[i] = ((const f32x4*)(x + (size_t)(row + stride) * DM))[lane + 64 * i];
        }
        float ss = 0.f;
#pragma unroll
        for (int i = 0; i < 4; ++i) ss += v[i][0] * v[i][0] + v[i][1] * v[i][1] + v[i][2] * v[i][2] + v[i][3] * v[i][3];
        ss = wave_sum(ss);
        const float r = rsqrtf(ss * (1.f / DM) + EPS);
#pragma unroll
        for (int i = 0; i < 4; ++i) {
            const f32x4 gg = ((const f32x4*)g)[lane + 64 * i];
            u32x2 o; o[0] = pk2(v[i][0] * r * gg[0], v[i][1] * r * gg[1]); o[1] = pk2(v[i][2] * r * gg[2], v[i][3] * r * gg[3]);
            *(u32x2*)(H + (size_t)row * DM + (lane + 64 * i) * 4) = o;
        }
    }
}

namespace pg8 {
#define PG8_LAS __attribute__((address_space(3)))
typedef unsigned short bf16_t;
typedef short bf16x8 __attribute__((ext_vector_type(8)));
typedef float f32x4 __attribute__((ext_vector_type(4)));
typedef unsigned u32x4 __attribute__((ext_vector_type(4)));
constexpr int BM = 256, BK = 64, HALF = 128, HTB = HALF * BK * 2  , STAGE_BYTES = 8 * HTB, NXCD = 8, WGM = 8;

__host__ __device__ __forceinline__ int lds_byte(int r, int c) { const int st = (r >> 4) * 2 + (c >> 5), rr = r & 15, cc = c & 31, ob = rr * 64 + cc * 2; return st * 1024 + (ob ^ (((ob >> 9) & 1) << 5)); }
__host__ __device__ __forceinline__ void stage_rc(int b, int& R, int& C) { const int st = b / 1024, sb = b % 1024, swz = sb ^ (((sb >> 9) & 1) << 5); R = (st >> 1) * 16 + swz / 64; C = (st & 1) * 32 + (swz % 64) / 2; }
__host__ __device__ __forceinline__ int perm32(int rho) { const int n = rho >> 4, i = rho & 15; return 8 * (i >> 2) + 4 * n + (i & 3); }

struct Unit { int pm, pn; };
struct Gemm { const bf16_t* A; const bf16_t* Bt; int M, N, K; };

struct StaticOrder {
    int nM, nN, nwg, G, c;
    __host__ __device__ void init(int M, int N, int G_, int c_) { nM = M / BM; nN = N / BM; nwg = nM * nN; G = G_; c = c_; }
    __host__ __device__ bool next(int i, Unit& u) const {
        const long L = (long)i * G + c; if (L >= nwg) return false;
        int wgid = (int)L; { const int q = nwg / NXCD, r = nwg % NXCD, xcd = wgid % NXCD, off = wgid / NXCD; wgid = (xcd < r ? xcd * (q + 1) : r * (q + 1) + (xcd - r) * q) + off; }
        const int nig = WGM * nN, gid = wgid / nig, fm = gid * WGM, gsz = (nM - fm) < WGM ? (nM - fm) : WGM;
        u.pm = fm + ((wgid % nig) % gsz); u.pn = (wgid % nig) / gsz; return true;
    }
    __device__ __forceinline__ void a_ready(const Unit&) const {}
    __device__ __forceinline__ void done(const Unit&) const {}
};
__device__ __forceinline__ unsigned cvt_pk_bf16(float lo, float hi) { unsigned r; asm volatile("v_cvt_pk_bf16_f32 %0, %1, %2" : "=v"(r) : "v"(lo), "v"(hi)); return r; }

struct EpiProjF {
    static constexpr bool PERM = true, AFTER_DRAIN = false;
    bf16_t* P; const float* ss; PG8_LAS float* xs  ; const float* gains  ;
    __device__ __forceinline__ void operator()(const f32x4 (&acc)[2][2][4][2], const Unit& u, int wr, int wc, int fr, int fq) const {
        const int row0 = u.pm * BM + wr * 64 + fr;
        const int col0 = u.pn * BM + wc * 32 + 8 * fq;
        const int pn = u.pn, wid = wr * 4 + wc;
        const bool need = (pn == 4) | (pn == 5) | (pn == 7) | (pn == 8) | ((pn >= 11) & (pn <= 14));
        float hs[2][4][2];
        if (need) {
#pragma unroll
            for (int ai = 0; ai < 2; ++ai)
#pragma unroll
                for (int m = 0; m < 4; ++m)
#pragma unroll
                    for (int bj = 0; bj < 2; ++bj) { const f32x4 v0 = acc[ai][bj][m][0], v1 = acc[ai][bj][m][1];
                        float s = v0[0] * v0[0] + v0[1] * v0[1] + v0[2] * v0[2] + v0[3] * v0[3] + v1[0] * v1[0] + v1[1] * v1[1] + v1[2] * v1[2] + v1[3] * v1[3];
                        s += __shfl_xor(s, 16); s += __shfl_xor(s, 32);
                        hs[ai][m][bj] = s;
                        if (fq == 0) xs[(((wid * 2 + ai) * 4 + m) * 2 + bj) * 16 + fr] = s; }
            asm volatile("s_waitcnt lgkmcnt(0)" ::: "memory");
            __builtin_amdgcn_s_barrier();
        }
        const int kind = (pn <= 5) ? 0 : (pn == 7) ? 1 : (pn == 8) ? 2 : (pn <= 12) ? 3 : 4;
#pragma unroll
        for (int bj = 0; bj < 2; ++bj) {
            const bool hn = need && !((pn == 7 || pn == 8) && bj == 1);
            f32x4 g0 = (f32x4){1.f, 1.f, 1.f, 1.f}, g1 = g0;
            if (hn) { g0 = *(const f32x4*)(gains + kind * 64 + (wc & 1) * 32 + 8 * fq); g1 = *(const f32x4*)(gains + kind * 64 + (wc & 1) * 32 + 8 * fq + 4); }
#pragma unroll
            for (int ai = 0; ai < 2; ++ai)
#pragma unroll
                for (int m = 0; m < 4; ++m) { const int row = row0 + ai * HALF + m * 16;
                    const float rr = ss ? rsqrtf(ss[row] * (1.f / 1024) + 1e-6f) : 1.f;
                    float rs = rr;
                    if (hn) { const float tot = (hs[ai][m][bj] + xs[((((wid ^ 1) * 2 + ai) * 4 + m) * 2 + bj) * 16 + fr]) * rr * rr; rs = rr * rsqrtf(tot * (1.f / 64) + 1e-6f); }
                    const f32x4 v0 = acc[ai][bj][m][0] * rs * g0, v1 = acc[ai][bj][m][1] * rs * g1;
                    u32x4 w; w.x = cvt_pk_bf16(v0[0], v0[1]); w.y = cvt_pk_bf16(v0[2], v0[3]); w.z = cvt_pk_bf16(v1[0], v1[1]); w.w = cvt_pk_bf16(v1[2], v1[3]);
                    *(u32x4*)(P + (size_t)row * 4864 + col0 + bj * HALF) = w; }
        }
    }
};
struct EpiOutF {
    static constexpr bool PERM = true, AFTER_DRAIN = false;
    const float* res32; const bf16_t* res16; float* out32; bf16_t* out16; float* ss;
    __device__ __forceinline__ void operator()(const f32x4 (&acc)[2][2][4][2], const Unit& u, int wr, int wc, int fr, int fq) const {
        const int row0 = u.pm * BM + wr * 64 + fr, col0 = u.pn * BM + wc * 32 + 8 * fq;
#pragma unroll
        for (int ai = 0; ai < 2; ++ai)
#pragma unroll
            for (int m = 0; m < 4; ++m) { const int row = row0 + ai * HALF + m * 16; const size_t off = (size_t)row * 1024 + col0;
                float sq = 0.f;
#pragma unroll
                for (int bj = 0; bj < 2; ++bj) {
                    f32x4 r0, r1;
                    if (res16) { const u32x4 rb = *(const u32x4*)(res16 + off + bj * HALF);
                        r0 = (f32x4){__uint_as_float(rb[0] << 16), __uint_as_float(rb[0] & 0xffff0000u), __uint_as_float(rb[1] << 16), __uint_as_float(rb[1] & 0xffff0000u)};
                        r1 = (f32x4){__uint_as_float(rb[2] << 16), __uint_as_float(rb[2] & 0xffff0000u), __uint_as_float(rb[3] << 16), __uint_as_float(rb[3] & 0xffff0000u)}; }
                    else { r0 = *(const f32x4*)(res32 + off + bj * HALF); r1 = *(const f32x4*)(res32 + off + bj * HALF + 4); }
                    const f32x4 o0 = r0 + acc[ai][bj][m][0], o1 = r1 + acc[ai][bj][m][1];
                    if (out32) { *(f32x4*)(out32 + off + bj * HALF) = o0; *(f32x4*)(out32 + off + bj * HALF + 4) = o1; }
                    if (out16) { sq += o0[0] * o0[0] + o0[1] * o0[1] + o0[2] * o0[2] + o0[3] * o0[3] + o1[0] * o1[0] + o1[1] * o1[1] + o1[2] * o1[2] + o1[3] * o1[3];
                        u32x4 w; w.x = cvt_pk_bf16(o0[0], o0[1]); w.y = cvt_pk_bf16(o0[2], o0[3]); w.z = cvt_pk_bf16(o1[0], o1[1]); w.w = cvt_pk_bf16(o1[2], o1[3]);
                        *(u32x4*)(out16 + off + bj * HALF) = w; }
                    __builtin_amdgcn_sched_barrier(0); }
                if (out16) { sq += __shfl_xor(sq, 16); sq += __shfl_xor(sq, 32); if (fq == 0) atomicAdd(ss + row, sq); } }
    }
};

template <class Epi, class Sched, bool ALIGN_EPI = false, bool SP2 = false>
__device__ __forceinline__ void gemm_phase(PG8_LAS unsigned char* lds, const Gemm g, const Sched& S, const Epi& E) {
    int tid = threadIdx.x; asm volatile("" : "+v"(tid));
    const int wid = __builtin_amdgcn_readfirstlane(tid >> 6), lane = tid & 63, wr = wid >> 2, wc = wid & 3, fr = lane & 15, fq = lane >> 4;
    const int K = g.K, nt = K / BK;
    unsigned voffA[2], voffB[2];
#pragma unroll
    for (int i = 0; i < 2; ++i) { int R, C; stage_rc(tid * 16 + i * 8192, R, C); const int Rb = Epi::PERM ? ((R & ~31) + perm32(R & 31)) : R;
        voffA[i] = (unsigned)(R * K + C) * 2u; voffB[i] = (unsigned)(Rb * K + C) * 2u; }
    const size_t kstep = (size_t)(BK * 2);
    const size_t hstep = (size_t)HALF * K * 2;
    const size_t tstep = 2 * hstep;
    const unsigned ldsw = (unsigned)wid * 1024u;
    const int aoff = lds_byte(wr * 64 + fr, fq * 8), boff = lds_byte(wc * 32 + fr, fq * 8);
#define PG8_SA(b, h) (((b) * 2 + (h)) * HTB)
#define PG8_SB(b, h) ((4 + (b) * 2 + (h)) * HTB)
#define PG8_STAGE(bufoff, gbase, voff) do { _Pragma("unroll") for (int _i = 0; _i < 2; ++_i) \
        __builtin_amdgcn_global_load_lds((const unsigned*)((const char*)(gbase) + (voff)[_i]), (PG8_LAS unsigned*)(lds + (bufoff) + ldsw + _i * 8192), 16, 0, 0); } while (0)
#define PG8_LDA(dst, b, h) do { _Pragma("unroll") for (int m = 0; m < 4; ++m) _Pragma("unroll") for (int k = 0; k < 2; ++k) dst[m][k] = *(const PG8_LAS bf16x8*)(lds + PG8_SA(b, h) + aoff + m * 2048 + k * 1024); } while (0)
#define PG8_LDB(dst, b, h) do { _Pragma("unroll") for (int n = 0; n < 2; ++n) _Pragma("unroll") for (int k = 0; k < 2; ++k) dst[n][k] = *(const PG8_LAS bf16x8*)(lds + PG8_SB(b, h) + boff + n * 2048 + k * 1024); } while (0)
#define PG8_MMA(ai, bj, At, Bt) do { __builtin_amdgcn_s_setprio(1); _Pragma("unroll") for (int m = 0; m < 4; ++m) _Pragma("unroll") for (int n = 0; n < 2; ++n) _Pragma("unroll") for (int k = 0; k < 2; ++k) \
        acc[ai][bj][m][n] = __builtin_amdgcn_mfma_f32_16x16x32_bf16(Bt[n][k], At[m][k], acc[ai][bj][m][n], 0, 0, 0); __builtin_amdgcn_s_setprio(0); } while (0)
#define PG8_WAIT_V(n) asm volatile("s_waitcnt vmcnt(" #n ")" ::: "memory")
#define PG8_WAIT_L(n) asm volatile("s_waitcnt lgkmcnt(" #n ")" ::: "memory")
#define PG8_BAR __builtin_amdgcn_s_barrier()
#define PG8_SCHED __builtin_amdgcn_sched_barrier(0)
    Unit cur, nxt; int ui = 0;
    if (!S.next(0, cur)) return;
    f32x4 acc[2][2][4][2];
#pragma unroll
    for (int a = 0; a < 2; ++a)
#pragma unroll
        for (int b = 0; b < 2; ++b)
#pragma unroll
            for (int m = 0; m < 4; ++m)
#pragma unroll
                for (int n = 0; n < 2; ++n) acc[a][b][m][n] = (f32x4){0.f, 0.f, 0.f, 0.f};
    bf16x8 At[4][2], B0[2][2], B1[2][2];
    const char* cA = (const char*)g.A + (size_t)cur.pm * tstep; const char* cB = (const char*)g.Bt + (size_t)cur.pn * tstep;
    S.a_ready(cur);
    if constexpr (SP2) {
        PG8_STAGE(PG8_SB(0, 0), cB, voffB); PG8_STAGE(PG8_SB(0, 1), cB + hstep, voffB); PG8_STAGE(PG8_SA(0, 0), cA, voffA); PG8_STAGE(PG8_SA(0, 1), cA + hstep, voffA);
        if (wr == 1) PG8_BAR;
        PG8_WAIT_V(2); PG8_BAR;
        PG8_STAGE(PG8_SB(1, 0), cB + kstep, voffB); PG8_STAGE(PG8_SA(1, 0), cA + kstep, voffA); PG8_STAGE(PG8_SB(1, 1), cB + hstep + kstep, voffB);
        PG8_WAIT_V(6); PG8_BAR;
    } else {
        PG8_STAGE(PG8_SB(0, 0), cB, voffB); PG8_STAGE(PG8_SA(0, 0), cA, voffA); PG8_STAGE(PG8_SB(0, 1), cB + hstep, voffB); PG8_STAGE(PG8_SA(0, 1), cA + hstep, voffA);
        if (wr == 1) PG8_BAR;
        PG8_WAIT_V(4); PG8_BAR;
        PG8_STAGE(PG8_SB(1, 0), cB + kstep, voffB); PG8_STAGE(PG8_SA(1, 0), cA + kstep, voffA); PG8_STAGE(PG8_SB(1, 1), cB + hstep + kstep, voffB);
        PG8_WAIT_V(6); PG8_BAR;
    }
    for (;;) {
        const bool has_next = S.next(ui + 1, nxt);
        const char* nA = has_next ? (const char*)g.A + (size_t)nxt.pm * tstep : cA; const char* nB = has_next ? (const char*)g.Bt + (size_t)nxt.pn * tstep : cB;
        for (int t = 0; t < nt; t += 2) {
            const bool last = (t == nt - 2);
            const char* a1 = cA + (size_t)(t + 1) * kstep;
            const char* a2 = last ? nA : cA + (size_t)(t + 2) * kstep; const char* b2 = last ? nB : cB + (size_t)(t + 2) * kstep;
            const char* a3 = a2 + kstep; const char* b3 = b2 + kstep;
            if (last && has_next) S.a_ready(nxt);
            if constexpr (SP2) {
            PG8_LDB(B0, 0, 0); PG8_LDB(B1, 0, 1); PG8_SCHED; PG8_LDA(At, 0, 0); PG8_STAGE(PG8_SA(1, 1), a1 + hstep, voffA);
            PG8_WAIT_V(8); PG8_WAIT_L(0); PG8_BAR; PG8_MMA(0, 0, At, B0); PG8_MMA(0, 1, At, B1); PG8_BAR; PG8_SCHED;
            PG8_LDA(At, 0, 1); PG8_STAGE(PG8_SB(0, 0), b2, voffB); PG8_STAGE(PG8_SB(0, 1), b2 + hstep, voffB); PG8_STAGE(PG8_SA(0, 0), a2, voffA);
            PG8_WAIT_V(8); PG8_WAIT_L(0); PG8_BAR; PG8_MMA(1, 0, At, B0); PG8_MMA(1, 1, At, B1); PG8_BAR; PG8_SCHED;
            PG8_LDB(B0, 1, 0); PG8_LDB(B1, 1, 1); PG8_SCHED; PG8_LDA(At, 1, 0); PG8_STAGE(PG8_SA(0, 1), a2 + hstep, voffA);
            PG8_WAIT_V(8); PG8_WAIT_L(0); PG8_BAR; PG8_MMA(0, 0, At, B0); PG8_MMA(0, 1, At, B1); PG8_BAR; PG8_SCHED;
            PG8_LDA(At, 1, 1); PG8_STAGE(PG8_SB(1, 0), b3, voffB); PG8_STAGE(PG8_SB(1, 1), b3 + hstep, voffB); PG8_STAGE(PG8_SA(1, 0), a3, voffA);
            PG8_WAIT_V(8); PG8_WAIT_L(0); PG8_BAR; PG8_MMA(1, 0, At, B0); PG8_MMA(1, 1, At, B1); PG8_BAR; PG8_SCHED;
            } else {
            PG8_LDB(B0, 0, 0); PG8_SCHED; PG8_LDA(At, 0, 0); PG8_STAGE(PG8_SA(1, 1), a1 + hstep, voffA);
            PG8_WAIT_L(8); PG8_BAR; PG8_WAIT_L(0); PG8_MMA(0, 0, At, B0); PG8_BAR; PG8_SCHED;
            PG8_LDB(B1, 0, 1); PG8_STAGE(PG8_SB(0, 0), b2, voffB);
            PG8_BAR; PG8_WAIT_L(0); PG8_MMA(0, 1, At, B1); PG8_BAR;
            PG8_LDA(At, 0, 1); PG8_STAGE(PG8_SA(0, 0), a2, voffA);
            PG8_BAR; PG8_WAIT_L(0); PG8_MMA(1, 0, At, B0); PG8_BAR; PG8_SCHED;
            PG8_STAGE(PG8_SB(0, 1), b2 + hstep, voffB);
            PG8_WAIT_V(6); PG8_BAR; PG8_MMA(1, 1, At, B1); PG8_BAR;
            PG8_LDB(B0, 1, 0); PG8_SCHED; PG8_LDA(At, 1, 0); PG8_STAGE(PG8_SA(0, 1), a2 + hstep, voffA);
            PG8_WAIT_L(8); PG8_BAR; PG8_WAIT_L(0); PG8_MMA(0, 0, At, B0); PG8_BAR; PG8_SCHED;
            PG8_LDB(B1, 1, 1); PG8_STAGE(PG8_SB(1, 0), b3, voffB);
            PG8_BAR; PG8_WAIT_L(0); PG8_MMA(0, 1, At, B1); PG8_BAR;
            PG8_LDA(At, 1, 1); PG8_STAGE(PG8_SA(1, 0), a3, voffA);
            PG8_BAR; PG8_WAIT_L(0); PG8_MMA(1, 0, At, B0); PG8_BAR; PG8_SCHED;
            PG8_STAGE(PG8_SB(1, 1), b3 + hstep, voffB);
            PG8_WAIT_V(6); PG8_BAR; PG8_MMA(1, 1, At, B1); PG8_BAR;
            }
        }
        if constexpr (ALIGN_EPI) { if (wr == 0) PG8_BAR; }
        if constexpr (!Epi::AFTER_DRAIN) { E(acc, cur, wr, wc, fr, fq); S.done(cur); }
        if (!has_next) break;
#pragma unroll
        for (int a = 0; a < 2; ++a)
#pragma unroll
            for (int b = 0; b < 2; ++b)
#pragma unroll
                for (int m = 0; m < 4; ++m)
#pragma unroll
                    for (int n = 0; n < 2; ++n) acc[a][b][m][n] = (f32x4){0.f, 0.f, 0.f, 0.f};
        cur = nxt; cA = nA; cB = nB; ++ui;
        if constexpr (ALIGN_EPI) { if (wr == 1) PG8_BAR; }
    }
    PG8_WAIT_V(0);
    if constexpr (!ALIGN_EPI) { if (wr == 0) PG8_BAR; }
    PG8_BAR;
    if constexpr (Epi::AFTER_DRAIN) { E.fused(acc, cur, wr, wc, fr, fq, lds, wid, lane); S.done(cur); }
#undef PG8_SA
#undef PG8_SB
#undef PG8_STAGE
#undef PG8_LDA
#undef PG8_LDB
#undef PG8_MMA
#undef PG8_WAIT_V
#undef PG8_WAIT_L
#undef PG8_BAR
#undef PG8_SCHED
}
}


DI void gates_gemm(const bf16_t* H, const bf16_t* WgT  , float* GL, const float* ss, bool upper_half_only) {
    const int tid_ = opaque_tid(); const int lane = tid_ & 63, wid = tid_ >> 6, r32 = lane & 31, hi = lane >> 5;
    const int nb = (upper_half_only && gridDim.x >= 256) ? (int)gridDim.x - 128 : (int)gridDim.x, b0 = (int)gridDim.x - nb;
    if ((int)blockIdx.x < b0) return;
    for (int u = ((int)blockIdx.x - b0) + nb * wid; u < NT / 32; u += nb * 8) {
        const bf16_t* ap = H + (size_t)(u * 32 + r32) * DM + hi * 8; const bf16_t* bp = WgT + (size_t)r32 * DM + hi * 8;
        f32x16 acc;
#pragma unroll
        for (int i = 0; i < 16; ++i) acc[i] = 0.f;
#pragma unroll 8
        for (int k = 0; k < DM; k += 16) acc = __builtin_amdgcn_mfma_f32_32x32x16_bf16(*(const bf16x8*)(ap + k), *(const bf16x8*)(bp + k), acc, 0, 0, 0);
#pragma unroll
        for (int i = 0; i < 16; ++i) { const int row = u * 32 + (i & 3) + 8 * (i >> 2) + 4 * hi; const float rs = ss ? rsqrtf(ss[row] * (1.f / 1024) + EPS) : 1.f; GL[(size_t)row * 32 + r32] = acc[i] * rs; }
    }
}

DI float log_sigmoid_(float x) { return fminf(x, 0.f) - log1pf(__expf(-fabsf(x))); }
DI void prep_cumsum(const Args& a, int l, float* LS) {
    const float* GL = (const float*)(a.ws + WS_GL); float* C2 = (float*)(a.ws + WS_C2);
    const int tid = opaque_tid(), lane = tid & 63, wid = tid >> 6;
    for (int b = blockIdx.x; b < NB; b += gridDim.x) {
        __syncthreads();
#pragma unroll
        for (int i = 0; i < 4; ++i) {
            const int t = tid + 512 * i;
            const f32x4 v0 = *(const f32x4*)(GL + (size_t)(b * SEQ + t) * 32 + 24), v1 = *(const f32x4*)(GL + (size_t)(b * SEQ + t) * 32 + 28);
#pragma unroll
            for (int h = 0; h < 4; ++h) { LS[h * 2112 + (t >> 5) * 33 + (t & 31)] = log_sigmoid_(v0[h] + a.in[I_FFB][l * 8 + h]); LS[(h + 4) * 2112 + (t >> 5) * 33 + (t & 31)] = log_sigmoid_(v1[h] + a.in[I_FFB][l * 8 + 4 + h]); }
        }
        __syncthreads();
        {   float* row = LS + wid * 2112 + lane * 33;
            float tot = 0.f;
            for (int k = 0; k < 32; ++k) tot += row[k];
            float inc = tot;
#pragma unroll
            for (int o = 1; o < 64; o <<= 1) { const float n = __shfl_up(inc, o); if (lane >= o) inc += n; }
            float run = inc - tot;
            for (int k = 0; k < 32; ++k) { run += row[k]; row[k] = run * LOG2E; }
        }
        __syncthreads();
#pragma unroll
        for (int i = 0; i < 4; ++i) { const int t = tid + 512 * i;
#pragma unroll
            for (int h = 0; h < 8; ++h) C2[(size_t)(b * 8 + h) * SEQ + t] = LS[h * 2112 + (t >> 5) * 33 + (t & 31)]; }
    }
    __syncthreads();
}
DI void prep_compress(const Args& a, int l, const bf16_t* P) {
    unsigned char* ws = a.ws;
    const int tid_ = opaque_tid(); const int lane = tid_ & 63, wid = tid_ >> 6, fr = lane & 15, fq = lane >> 4;
    const int nbk = gridDim.x > 32 ? (int)gridDim.x - 16 : (int)gridDim.x, bk0 = (int)gridDim.x - nbk;
    if ((int)blockIdx.x < bk0) return;
    for (int it = ((int)blockIdx.x - bk0) + nbk * wid; it < NB * 2 * 2 * 8; it += nbk * 8) {
        const int nq = it & 7, kv = (it >> 3) & 1, g = (it >> 4) & 1, b = it >> 5;
        const int n = 16 * nq + fr; const bool ok = n < 127;
        const bf16_t* src = P + (size_t)(b * SEQ + (ok ? 16 * n : 0)) * PP + (kv ? C_VC : C_KC) + g * 64 + fq * 8;
        const bf16_t* W = (const bf16_t*)(ws + (kv ? WS_WCV : WS_WCK)) + (size_t)l * 131072 + (size_t)fr * 2048 + fq * 8;
        f32x4 acc[4];
#pragma unroll
        for (int nt = 0; nt < 4; ++nt) acc[nt] = (f32x4){0.f, 0.f, 0.f, 0.f};
#pragma unroll 4
        for (int ks = 0; ks < 64; ++ks) {
            bf16x8 af = *(const bf16x8*)(src + (size_t)(ks >> 1) * PP + (ks & 1) * 32);
            if (!ok) af = (bf16x8){0, 0, 0, 0, 0, 0, 0, 0};
#pragma unroll
            for (int nt = 0; nt < 4; ++nt) { const bf16x8 bw = *(const bf16x8*)(W + (size_t)nt * 16 * 2048 + ks * 32); acc[nt] = __builtin_amdgcn_mfma_f32_16x16x32_bf16(af, bw, acc[nt], 0, 0, 0); }
        }
        const float* bias = (const float*)(ws + WS_BKV) + (l * 2 + kv) * 64;
        float v[4][4];
#pragma unroll
        for (int nt = 0; nt < 4; ++nt)
#pragma unroll
            for (int i = 0; i < 4; ++i) v[nt][i] = acc[nt][i] + bias[16 * nt + fr];
        bf16_t* out = (bf16_t*)(ws + (kv ? WS_VCMP : WS_KCMP)) + (size_t)(b * 2 + g) * 128 * 64;
#pragma unroll
        for (int i = 0; i < 4; ++i) {
            const int row = 16 * nq + 4 * fq + i;
            float sc = 1.f;
            if (kv == 0) { float ss = v[0][i] * v[0][i] + v[1][i] * v[1][i] + v[2][i] * v[2][i] + v[3][i] * v[3][i];
                ss += __shfl_xor(ss, 1); ss += __shfl_xor(ss, 2); ss += __shfl_xor(ss, 4); ss += __shfl_xor(ss, 8); sc = rsqrtf(ss * (1.f / 64) + EPS); }
#pragma unroll
            for (int nt = 0; nt < 4; ++nt) { const int e = 16 * nt + fr; float o = v[nt][i] * sc; if (kv == 0) o *= a.in[I_NKG][(l * 3 + 0) * 64 + e]; if (row >= 127) o = 0.f;
                out[(size_t)row * 64 + e] = (bf16_t)f2bf(o); }
        }
    }
}


constexpr int A_KB = 0, A_VB = 18432, A_CB = A_VB + 16384, A_IG = A_CB + 512, A_IL = A_IG + 33792, A_SELM = A_IL + 33792, A_UN = A_SELM + 256, A_UNIT = A_UN + 16, A_SC = A_UNIT + 16, A_KG = A_SC + 2048, A_END = A_KG + 512;
static_assert(A_END <= LDS_BYTES, "attention LDS map");
struct ACtx { int r32, hi, tid, tok; bf16x8 qr[4]; };
typedef float f32x2_t __attribute__((ext_vector_type(2))); typedef __bf16 bf16x2_t __attribute__((ext_vector_type(2)));
typedef short v4i16_t __attribute__((ext_vector_type(4)));
#define LAS3 __attribute__((address_space(3)))
DI unsigned cvtpk(float lo, float hi) { f32x2_t v = {lo, hi}; bf16x2_t bb = __builtin_convertvector(v, bf16x2_t); return __builtin_bit_cast(unsigned, bb); }
DI v4i16_t vtr(const LAS3 unsigned char* p) { return __builtin_amdgcn_ds_read_tr16_b64_v4i16((LAS3 v4i16_t*)p); }

DI void load_q(ACtx& x, const bf16_t* qrow) {
#pragma unroll
    for (int d0 = 0; d0 < 4; ++d0) x.qr[d0] = *(const bf16x8*)(qrow + d0 * 16 + x.hi * 8);
}

template <int MODE, bool ONLINE>
DI void attn_tile_compute(const unsigned char* lds, int cur, int j, const ACtx& x, unsigned selm, int cblk, int wtokmin, float bref, float ctb, f32x16 (&oT)[2], float& m, float& l) {
    const bf16_t* KB = (const bf16_t*)(lds + A_KB) + cur * 4608;
    const int lane = x.tid & 63;
    f32x16 p0, p1;
    if (MODE == 3) {
        const float* CB = (const float*)(lds + A_CB) + cur * 64 + 4 * x.hi;
#pragma unroll
        for (int q = 0; q < 4; ++q) { const f32x4 c0 = *(const f32x4*)(CB + 8 * q), c1 = *(const f32x4*)(CB + 32 + 8 * q);
#pragma unroll
            for (int i = 0; i < 4; ++i) { p0[4 * q + i] = (ONLINE ? 0.f : ctb) - c0[i]; p1[4 * q + i] = (ONLINE ? 0.f : ctb) - c1[i]; } }
    } else {
#pragma unroll
        for (int i = 0; i < 16; ++i) { p0[i] = ONLINE ? 0.f : -bref; p1[i] = ONLINE ? 0.f : -bref; }
    }
#pragma unroll
    for (int d0 = 0; d0 < 4; ++d0) {
        const bf16x8 k0 = *(const bf16x8*)(KB + x.r32 * 72 + d0 * 16 + x.hi * 8);
        const bf16x8 k1 = *(const bf16x8*)(KB + (32 + x.r32) * 72 + d0 * 16 + x.hi * 8);
        p0 = __builtin_amdgcn_mfma_f32_32x32x16_bf16(k0, x.qr[d0], p0, 0, 0, 0);
        p1 = __builtin_amdgcn_mfma_f32_32x32x16_bf16(k1, x.qr[d0], p1, 0, 0, 0);
    }
    const float NEG = -INFINITY;
    const int kb = 64 * j + 4 * x.hi;
#define KK(r) (kb + ((r) & 3) + 8 * ((r) >> 2))
    if (MODE == 3) {
        if (64 * j + 63 > wtokmin) {
#pragma unroll
            for (int r = 0; r < 16; ++r) { const int kk = KK(r); if (kk > x.tok) p0[r] = NEG; if (kk + 32 > x.tok) p1[r] = NEG; }
        }
    } else if (MODE == 0) {
#pragma unroll
        for (int r = 0; r < 16; ++r) { const int n = KK(r); if (16 * n + 31 > x.tok) p0[r] = NEG; if (16 * (n + 32) + 31 > x.tok) p1[r] = NEG; }
    } else if (MODE == 1) {
        const bool on = (selm >> j) & 1u;
        const bool allon = __ballot(on) == ~0ull;
        if (j == cblk) {
#pragma unroll
            for (int r = 0; r < 16; ++r) { const int kk = KK(r); if (!on || kk > x.tok) p0[r] = NEG; if (!on || kk + 32 > x.tok) p1[r] = NEG; }
        } else if (!allon) {
#pragma unroll
            for (int r = 0; r < 16; ++r) { if (!on) { p0[r] = NEG; p1[r] = NEG; } }
        }
    } else {
        if (j == cblk) {
#pragma unroll
            for (int r = 0; r < 16; ++r) { const int kk = KK(r); if (kk > x.tok) p0[r] = NEG; if (kk + 32 > x.tok) p1[r] = NEG; }
        } else if (j == cblk - 8) {
#pragma unroll
            for (int r = 0; r < 16; ++r) { const int kk = KK(r); if (x.tok - kk >= 512) p0[r] = NEG; if (x.tok - kk - 32 >= 512) p1[r] = NEG; }
        }
    }
#undef KK
    if (ONLINE) {
        float mx = fmaxf(p0[0], p1[0]);
#pragma unroll
        for (int r = 1; r < 16; ++r) mx = fmaxf(mx, fmaxf(p0[r], p1[r]));
        mx = fmaxf(mx, __shfl_xor(mx, 32));
        const float mn = fmaxf(m, mx);
        if (__any(mn > m)) {
            const float sc = __builtin_amdgcn_exp2f(m - mn); l *= sc;
#pragma unroll
            for (int r = 0; r < 16; ++r) { oT[0][r] *= sc; oT[1][r] *= sc; }
        }
        m = mn;
#pragma unroll
        for (int r = 0; r < 16; ++r) { p0[r] -= mn; p1[r] -= mn; }
    }
    f32x2_t ls2 = {0.f, 0.f};
#pragma unroll
    for (int r = 0; r < 16; r += 2) { p0[r] = __builtin_amdgcn_exp2f(p0[r]); p0[r + 1] = __builtin_amdgcn_exp2f(p0[r + 1]); p1[r] = __builtin_amdgcn_exp2f(p1[r]); p1[r + 1] = __builtin_amdgcn_exp2f(p1[r + 1]);
        ls2 += (f32x2_t){p0[r], p0[r + 1]}; ls2 += (f32x2_t){p1[r], p1[r + 1]}; }
    l += ls2[0] + ls2[1];
    bf16x8 pf[4];
#pragma unroll
    for (int s = 0; s < 2; ++s) {
        u32x4 a0, a1;
#pragma unroll
        for (int i = 0; i < 4; ++i) { a0[i] = cvtpk(p0[8 * s + 2 * i], p0[8 * s + 2 * i + 1]); a1[i] = cvtpk(p1[8 * s + 2 * i], p1[8 * s + 2 * i + 1]); }
        pf[s] = __builtin_bit_cast(bf16x8, a0); pf[2 + s] = __builtin_bit_cast(bf16x8, a1);
    }
    const LAS3 unsigned char* vp = (const LAS3 unsigned char*)(lds + A_VB) + cur * 8192 + ((lane >> 4) & 1) * 32 + (lane & 3) * 8 + (4 * x.hi + ((lane & 15) >> 2)) * 64;
#pragma unroll
    for (int dh = 0; dh < 2; ++dh)
#pragma unroll
        for (int ks = 0; ks < 4; ++ks) {
            const v4i16_t lo = vtr(vp + dh * 4096 + ks * 1024), hi4 = vtr(vp + dh * 4096 + ks * 1024 + 512);
            const bf16x8 vf = (bf16x8){lo[0], lo[1], lo[2], lo[3], hi4[0], hi4[1], hi4[2], hi4[3]};
            oT[dh] = __builtin_amdgcn_mfma_f32_32x32x16_bf16(vf, pf[ks], oT[dh], 0, 0, 0);
        }
}

template <int MODE, bool ONLINE>
DI void attn_branch(unsigned char* lds, const bf16_t* Kg, int kp, const bf16_t* Vg, int vp, const float* Cg, int kgofs, unsigned tiles,
                    const ACtx& x, unsigned selm, int cblk, int wtokmin, int wtokmax, float bref, float ctb, f32x16 (&oT)[2], float& m, float& l) {
    const int tid = x.tid, srow = tid >> 3, sc8 = tid & 7;
    bf16_t* KB = (bf16_t*)(lds + A_KB); unsigned char* VB = lds + A_VB; float* CB = (float*)(lds + A_CB);
    const int kofs = srow * 72 + sc8 * 8, vofs = ((sc8 >> 2) * 4 + (srow >> 4)) * 1024 + (srow & 15) * 64 + (sc8 & 3) * 16;
    unsigned rem = tiles; if (!rem) return;
    u32x4 krA, vrA, krB, vrB; f32x4 crA = {0.f, 0.f, 0.f, 0.f}, crB = {0.f, 0.f, 0.f, 0.f};
#define POP(jv) do { jv = -1; if (rem) { jv = __builtin_ctz(rem); rem &= rem - 1; } } while (0)
#define LOADT(jj, kr, vr, cr) do { kr = *(const u32x4*)(Kg + (size_t)(64 * (jj) + srow) * kp + sc8 * 8); vr = *(const u32x4*)(Vg + (size_t)(64 * (jj) + srow) * vp + sc8 * 8); \
        if (MODE == 3 && tid < 16) cr = *(const f32x4*)(Cg + 64 * (jj) + tid * 4); } while (0)
#define STORET(buf, kr, vr, cr) do { *(u32x4*)(KB + (buf) * 4608 + kofs) = kr; *(u32x4*)(VB + (buf) * 8192 + vofs) = vr; if (MODE == 3 && tid < 16) *(f32x4*)(CB + (buf) * 64 + tid * 4) = cr; } while (0)
#define ACTIVE(jj) ((MODE == 1) ? (__ballot((selm >> (jj)) & 1u) != 0ull) : ((MODE == 3) ? (64 * (jj) <= wtokmax) : true))
    int j0, j1, j2, j3;
    POP(j0); LOADT(j0, krA, vrA, crA); STORET(0, krA, vrA, crA);
    POP(j1); if (j1 >= 0) LOADT(j1, krA, vrA, crA);
    __syncthreads();
    int cur = 0;
    for (;;) {
        POP(j2); if (j2 >= 0) LOADT(j2, krB, vrB, crB);
        if (ACTIVE(j0)) attn_tile_compute<MODE, ONLINE>(lds, cur, j0, x, selm, cblk, wtokmin, bref, ctb, oT, m, l);
        if (j1 >= 0) STORET(cur ^ 1, krA, vrA, crA);
        __syncthreads();
        if (j1 < 0) break;
        cur ^= 1;
        POP(j3); if (j3 >= 0) LOADT(j3, krA, vrA, crA);
        if (ACTIVE(j1)) attn_tile_compute<MODE, ONLINE>(lds, cur, j1, x, selm, cblk, wtokmin, bref, ctb, oT, m, l);
        if (j2 >= 0) STORET(cur ^ 1, krB, vrB, crB);
        __syncthreads();
        if (j2 < 0) break;
        cur ^= 1; j0 = j2; j1 = j3;
    }
#undef POP
#undef ACTIVE
#undef LOADT
#undef STORET
}
DI void zero_o(f32x16 (&oT)[2]) {
#pragma unroll
    for (int r = 0; r < 16; ++r) { oT[0][r] = 0.f; oT[1][r] = 0.f; }
}

template <bool ONLINE> DI void nsa_unit(const Args& a, int l, unsigned char* lds, int b, int g, int c) {
    unsigned char* ws = a.ws;
    const bf16_t* P = (const bf16_t*)(ws + WS_P); bf16_t* Y = (bf16_t*)(ws + WS_HY); const float* GL = (const float*)(ws + WS_GL);
    ACtx x; x.tid = threadIdx.x; asm volatile("" : "+v"(x.tid));
    const int lane = x.tid & 63, wid = __builtin_amdgcn_readfirstlane(x.tid >> 6); x.r32 = lane & 31; x.hi = lane >> 5;
    const int hq = 4 * g + (wid & 3), tokl = 32 * (wid >> 2) + x.r32; x.tok = 64 * c + tokl;
    const size_t row = (size_t)(b * SEQ + x.tok);
    load_q(x, P + row * PP + C_NQ + hq * 64);
#define GATE(k) sigmoidf_(GL[row * 32 + hq * 3 + (k)] + a.in[I_GB][l * 24 + hq * 3 + (k)])
    float* IG = (float*)(lds + A_IG); float* IL = (float*)(lds + A_IL); unsigned* SELM = (unsigned*)(lds + A_SELM); unsigned* UN = (unsigned*)(lds + A_UN);
    if (x.tid == 0) UN[0] = 0u;
    f32x16 oT[2], tot[2]; zero_o(oT); zero_o(tot);
    float m = -1e30f, ls = 0.f;
    const float* bnd = (const float*)(ws + WS_BND) + l * 4;
    const float b_cmp = bnd[0], b_slc = bnd[1], b_win = bnd[2];
    constexpr bool online = ONLINE;
#define BRANCH(MODE, ...) do { attn_branch<MODE, ONLINE>(__VA_ARGS__); } while (0)
    const bf16_t* KC = (const bf16_t*)(ws + WS_KCMP) + (size_t)(b * 2 + g) * 128 * 64; const bf16_t* VC = (const bf16_t*)(ws + WS_VCMP) + (size_t)(b * 2 + g) * 128 * 64;
    const int ncmpt = c >= 16 ? 2 : 1;
    BRANCH(0, lds, KC, 64, VC, 64, nullptr, 0, c >= 16 ? 3u : 1u, x, 0u, c, 0, 0, b_cmp, 0.f, oT, m, ls);
    const float cref = online ? m : b_cmp;
    {   float lt = ls + __shfl_xor(ls, 32); const float inv = lt > 0.f ? 1.f / lt : 0.f; const float g0 = GATE(0);
#pragma unroll
        for (int r = 0; r < 16; ++r) { tot[0][r] = oT[0][r] * (inv * g0); tot[1][r] = oT[1][r] * (inv * g0); }
        for (int tt = 0; tt < ncmpt; ++tt) {
            const bf16_t* KB = (const bf16_t*)(lds + A_KB) + tt * 4608;
            f32x16 p0, p1;
#pragma unroll
            for (int i = 0; i < 16; ++i) { p0[i] = -cref; p1[i] = -cref; }
#pragma unroll
            for (int d0 = 0; d0 < 4; ++d0) {
                const bf16x8 k0 = *(const bf16x8*)(KB + x.r32 * 72 + d0 * 16 + x.hi * 8); const bf16x8 k1 = *(const bf16x8*)(KB + (32 + x.r32) * 72 + d0 * 16 + x.hi * 8);
                p0 = __builtin_amdgcn_mfma_f32_32x32x16_bf16(k0, x.qr[d0], p0, 0, 0, 0); p1 = __builtin_amdgcn_mfma_f32_32x32x16_bf16(k1, x.qr[d0], p1, 0, 0, 0);
            }
            const int kb = 64 * tt + 4 * x.hi;
#pragma unroll
            for (int r = 0; r < 16; ++r) { const int n = kb + (r & 3) + 8 * (r >> 2);
                p0[r] = (16 * n + 31 <= x.tok) ? __builtin_amdgcn_exp2f(p0[r]) * inv : 0.f; p1[r] = (16 * (n + 32) + 31 <= x.tok) ? __builtin_amdgcn_exp2f(p1[r]) * inv : 0.f; }
            float* ig = IG + ((wid & 3) * 64 + tokl) * 33; float* il = IL + ((wid & 3) * 64 + tokl) * 33;
#pragma unroll
            for (int q = 0; q < 4; ++q) { const int jj = 16 * tt + 2 * q + x.hi;
                ig[jj] = p0[4 * q] + p0[4 * q + 1] + p0[4 * q + 2] + p0[4 * q + 3]; il[jj] = p0[4 * q + 3];
                ig[jj + 8] = p1[4 * q] + p1[4 * q + 1] + p1[4 * q + 2] + p1[4 * q + 3]; il[jj + 8] = p1[4 * q + 3]; }
        }
    }
    __syncthreads();
    {   int j = lane & 31; asm volatile("" : "+v"(j));
        unsigned wor = 0u;
#pragma unroll
        for (int it = 0; it < 4; ++it) {
            const int tl = 8 * wid + 2 * it + (lane >> 5);
            float imp = 0.f;
#pragma unroll
            for (int h4 = 0; h4 < 4; ++h4) { imp += IG[(h4 * 64 + tl) * 33 + j]; if (j > 0) imp += IL[(h4 * 64 + tl) * 33 + j - 1]; }
            const bool valid = j <= c, forced = (j == 0) || (j == c) || (j == c - 1);
            const float score = !valid ? -1e30f : (forced ? 1e9f : imp);
            float* scw = (float*)(lds + A_SC) + wid * 64;
            scw[lane] = score;
            __builtin_amdgcn_s_waitcnt(0xc07f); __builtin_amdgcn_wave_barrier();
            int rank = 0;
#pragma unroll
            for (int k4 = 0; k4 < 8; ++k4) { const f32x4 sk = *(const f32x4*)(scw + (lane & 32) + 4 * k4);
#pragma unroll
                for (int i = 0; i < 4; ++i) rank += (sk[i] > score) || (sk[i] == score && 4 * k4 + i < j); }
            __builtin_amdgcn_wave_barrier();
            const unsigned long long bal = __ballot(valid && rank < 16);
            const unsigned mine = (lane >> 5) ? (unsigned)(bal >> 32) : (unsigned)bal;
            if (j == 0) SELM[tl] = mine;
            wor |= (unsigned)bal | (unsigned)(bal >> 32);
        }
        if (lane == 0) atomicOr(UN, wor);
    }
    __syncthreads();
    const unsigned selm = SELM[tokl]; const unsigned un = UN[0];
    float* TOT = (float*)(lds + A_IG) + wid * 2048 + lane;
#pragma unroll
    for (int r = 0; r < 16; ++r) { TOT[r * 64] = tot[0][r]; TOT[(16 + r) * 64] = tot[1][r]; }
    zero_o(oT); m = -1e30f; ls = 0.f;
    BRANCH(1, lds, P + (size_t)b * SEQ * PP + C_KS + g * 64, PP, P + (size_t)b * SEQ * PP + C_VS + g * 64, PP, nullptr, 0, un, x, selm, c, 0, 0, b_slc, 0.f, oT, m, ls);
    {   float lt = ls + __shfl_xor(ls, 32); const float inv = lt > 0.f ? GATE(1) / lt : 0.f;
#pragma unroll
        for (int r = 0; r < 16; ++r) { TOT[r * 64] += oT[0][r] * inv; TOT[(16 + r) * 64] += oT[1][r] * inv; } }
    zero_o(oT); m = -1e30f; ls = 0.f;
    {   const int jlo = c >= 8 ? c - 8 : 0; const unsigned wt = (c >= 31 ? 0xffffffffu : ((1u << (c + 1)) - 1u)) & ~((1u << jlo) - 1u);
        BRANCH(2, lds, P + (size_t)b * SEQ * PP + C_KW + g * 64, PP, P + (size_t)b * SEQ * PP + C_VW + g * 64, PP, nullptr, 64, wt, x, 0u, c, 0, 0, b_win, 0.f, oT, m, ls); }
    {   float lt = ls + __shfl_xor(ls, 32); const float inv = lt > 0.f ? GATE(2) / lt : 0.f;
#pragma unroll
        for (int r = 0; r < 16; ++r) { tot[0][r] = TOT[r * 64] + oT[0][r] * inv; tot[1][r] = TOT[(16 + r) * 64] + oT[1][r] * inv; } }
#pragma unroll
    for (int dh = 0; dh < 2; ++dh)
#pragma unroll
        for (int q = 0; q < 4; ++q) {
            const int d = 32 * dh + 8 * q + 4 * x.hi;
            const u32x2 zz = *(const u32x2*)(P + row * PP + C_NZ + hq * 64 + d);
            const float z0 = bf2f(zz[0] & 0xffffu), z1 = bf2f(zz[0] >> 16), z2 = bf2f(zz[1] & 0xffffu), z3 = bf2f(zz[1] >> 16);
            u32x2 o; o[0] = cvtpk(tot[dh][4 * q] * siluf_(z0), tot[dh][4 * q + 1] * siluf_(z1)); o[1] = cvtpk(tot[dh][4 * q + 2] * siluf_(z2), tot[dh][4 * q + 3] * siluf_(z3));
            *(u32x2*)(Y + row * DMIX + 512 + hq * 64 + d) = o;
        }
}

template <bool ONLINE> DI void fox_unit(const Args& a, int l, unsigned char* lds, int b, int h, int c) {
    unsigned char* ws = a.ws;
    const bf16_t* P = (const bf16_t*)(ws + WS_P); bf16_t* Y = (bf16_t*)(ws + WS_HY);
    ACtx x; x.tid = threadIdx.x; asm volatile("" : "+v"(x.tid));
    const int lane = x.tid & 63, wid = __builtin_amdgcn_readfirstlane(x.tid >> 6); x.r32 = lane & 31; x.hi = lane >> 5;
    x.tok = 256 * c + 32 * wid + x.r32;
    const size_t row = (size_t)(b * SEQ + x.tok);
    load_q(x, P + row * PP + C_FQ + h * 64);
    const float* c2 = (const float*)(ws + WS_C2) + (size_t)(b * 8 + h) * SEQ;
    f32x16 oT[2]; zero_o(oT); float m = -1e30f, ls = 0.f;
    const int ntile = 4 * c + 4; const unsigned tiles = ntile >= 32 ? 0xffffffffu : ((1u << ntile) - 1u);
    unsigned tiles_ = tiles;
    if (!ONLINE) {
        const float cj = c2[64 * (lane & 31) + 63], c0 = c2[256 * c];
        tiles_ &= ~(unsigned)__ballot((lane < 32) && (c0 - cj <= -152.f));
    }
    const float b_fox = ((const float*)(ws + WS_BND))[l * 4 + 3]; const float ctb = c2[x.tok] - b_fox;
    attn_branch<3, ONLINE>(lds, P + (size_t)b * SEQ * PP + C_FK + h * 64, PP, P + (size_t)b * SEQ * PP + C_FV + h * 64, PP, c2, 0, tiles_, x, 0u, 0, 256 * c + 32 * wid, 256 * c + 32 * wid + 31, b_fox, ctb, oT, m, ls);
    float lt = ls + __shfl_xor(ls, 32); const float inv = lt > 0.f ? 1.f / lt : 0.f;
#pragma unroll
    for (int dh = 0; dh < 2; ++dh)
#pragma unroll
        for (int q = 0; q < 4; ++q) {
            const int d = 32 * dh + 8 * q + 4 * x.hi;
            const u32x2 zz = *(const u32x2*)(P + row * PP + C_FZ + h * 64 + d);
            const float z0 = bf2f(zz[0] & 0xffffu), z1 = bf2f(zz[0] >> 16), z2 = bf2f(zz[1] & 0xffffu), z3 = bf2f(zz[1] >> 16);
            u32x2 o; o[0] = cvtpk(oT[dh][4 * q] * inv * siluf_(z0), oT[dh][4 * q + 1] * inv * siluf_(z1)); o[1] = cvtpk(oT[dh][4 * q + 2] * inv * siluf_(z2), oT[dh][4 * q + 3] * inv * siluf_(z3));
            *(u32x2*)(Y + row * DMIX + 1024 + h * 64 + d) = o;
        }
}


constexpr int L_WA = 0, L_WX = 9216, L_XB = 18432, L_XF = 27648, L_G = 44032, L_SA = L_G + 2 * 64 * 65 * 4, L_SB = L_SA + 2048, L_CY = L_SB + 2048, L_END = L_CY + 512;
static_assert(L_END <= LDS_BYTES, "LRU LDS map");
DI float fsig(float x) { return __builtin_amdgcn_rcpf(1.f + __expf(-x)); }
DI float neg_expm1(float x) {
    const float t = x * (1.f + x * (0.5f + x * (0.16666667f + x * (0.041666668f + x * (0.0083333338f + x * 0.0013888889f)))));
    const float e = __expf(x) - 1.f;
    return -((x > -0.25f) ? t : e);
}
DI void lru_unit(const Args& a, int l, unsigned char* lds, int b, int h) {
    unsigned char* ws = a.ws;
    const bf16_t* P = (const bf16_t*)(ws + WS_P); bf16_t* Y = (bf16_t*)(ws + WS_HY);
    int tid = threadIdx.x; asm volatile("" : "+v"(tid));
    const int lane = tid & 63, wid = __builtin_amdgcn_readfirstlane(tid >> 6);
    bf16_t* WAl = (bf16_t*)(lds + L_WA); bf16_t* WXl = (bf16_t*)(lds + L_WX); bf16_t* XB = (bf16_t*)(lds + L_XB);
    float* XF = (float*)(lds + L_XF); float* G = (float*)(lds + L_G); float* SA = (float*)(lds + L_SA); float* SB = (float*)(lds + L_SB); float* CY = (float*)(lds + L_CY);
    __syncthreads();
    {   const int r = tid >> 3, c8 = (tid & 7) * 8;
        *(u32x4*)(WAl + r * 72 + c8) = *(const u32x4*)((const bf16_t*)(ws + WS_WA) + (size_t)(l * 8 + h) * 4096 + r * 64 + c8);
        *(u32x4*)(WXl + r * 72 + c8) = *(const u32x4*)((const bf16_t*)(ws + WS_WX) + (size_t)(l * 8 + h) * 4096 + r * 64 + c8);
        if (tid < 128) CY[tid] = 0.f; }
    const int tk1 = tid >> 3, c8 = (tid & 7) * 8, chb = h * 64 + c8;
    float cw[4][8], cb8[8];
#pragma unroll
    for (int i = 0; i < 8; ++i) { cb8[i] = a.in[I_CB][l * 512 + chb + i];
#pragma unroll
        for (int k = 0; k < 4; ++k) cw[k][i] = a.in[I_CW][(l * 4 + k) * 512 + chb + i]; }
    const int ch = tid & 63, sg = tid >> 6, chg = h * 64 + ch;
    const float ba = a.in[I_BA][l * 512 + chg], bx = a.in[I_BX][l * 512 + chg], lam = a.in[I_LAM][l * 512 + chg];
    const float sp8 = -8.f * (fmaxf(-lam, 0.f) + log1pf(__expf(-fabsf(lam))));
    const int fr = lane & 15, fq = lane >> 4, mat = wid >> 2, strip = wid & 3;
    const bf16_t* pu = P + (size_t)b * SEQ * PP + C_U + chb;
    u32x4 ur[4];
#pragma unroll
    for (int k = 0; k < 4; ++k) { const int t = tk1 - 3 + k; ur[k] = (t >= 0) ? *(const u32x4*)(pu + (size_t)t * PP) : (u32x4){0u, 0u, 0u, 0u}; }
    for (int tile = 0; tile < SEQ / 64; ++tile) {
        const int t0 = tile * 64;
        {   float xc[8];
#pragma unroll
            for (int i = 0; i < 8; ++i) xc[i] = cb8[i];
#pragma unroll
            for (int k = 0; k < 4; ++k) { float uf[8]; unpack8(ur[k], uf);
#pragma unroll
                for (int i = 0; i < 8; ++i) xc[i] += cw[k][i] * uf[i]; }
            *(f32x4*)(XF + tk1 * 64 + c8) = (f32x4){xc[0], xc[1], xc[2], xc[3]}; *(f32x4*)(XF + tk1 * 64 + c8 + 4) = (f32x4){xc[4], xc[5], xc[6], xc[7]};
            u32x4 pk; pk[0] = pk2(xc[0], xc[1]); pk[1] = pk2(xc[2], xc[3]); pk[2] = pk2(xc[4], xc[5]); pk[3] = pk2(xc[6], xc[7]);
            *(u32x4*)(XB + tk1 * 72 + c8) = pk;
            if (tile + 1 < SEQ / 64) {
#pragma unroll
                for (int k = 0; k < 4; ++k) ur[k] = *(const u32x4*)(pu + (size_t)(t0 + 64 + tk1 - 3 + k) * PP);
            }
        }
        __syncthreads();
        {   const bf16_t* W = mat ? WXl : WAl;
            f32x4 acc[4];
#pragma unroll
            for (int nt = 0; nt < 4; ++nt) acc[nt] = (f32x4){0.f, 0.f, 0.f, 0.f};
#pragma unroll
            for (int ks = 0; ks < 2; ++ks) {
                const bf16x8 af = *(const bf16x8*)(XB + (16 * strip + fr) * 72 + ks * 32 + fq * 8);
#pragma unroll
                for (int nt = 0; nt < 4; ++nt) { const bf16x8 bw = *(const bf16x8*)(W + (16 * nt + fr) * 72 + ks * 32 + fq * 8); acc[nt] = __builtin_amdgcn_mfma_f32_16x16x32_bf16(af, bw, acc[nt], 0, 0, 0); }
            }
            float* Gm = G + mat * 64 * 65;
#pragma unroll
            for (int nt = 0; nt < 4; ++nt)
#pragma unroll
                for (int i = 0; i < 4; ++i) Gm[(16 * strip + 4 * fq + i) * 65 + 16 * nt + fr] = acc[nt][i];
        }
        __syncthreads();
        {   const bf16_t* pz = P + (size_t)(b * SEQ + t0 + sg * 8) * PP + C_Z + chg;
            bf16_t zr[8];
#pragma unroll
            for (int k = 0; k < 8; ++k) zr[k] = pz[(size_t)k * PP];
            float av[8], bv[8]; float A = 1.f, Bc = 0.f;
#pragma unroll
            for (int k = 0; k < 8; ++k) {
                const int tk = sg * 8 + k;
                const float r = fsig(G[tk * 65 + ch] + ba), ig = fsig(G[64 * 65 + tk * 65 + ch] + bx), xcv = XF[tk * 64 + ch];
                const float la = r * sp8;
                av[k] = __expf(la); bv[k] = sqrtf(neg_expm1(2.f * la)) * (ig * xcv);
                Bc = av[k] * Bc + bv[k]; A *= av[k];
            }
            SA[sg * 64 + ch] = A; SB[sg * 64 + ch] = Bc;
            __syncthreads();
            float hs = CY[(tile & 1) * 64 + ch];
            for (int s = 0; s < sg; ++s) hs = SA[s * 64 + ch] * hs + SB[s * 64 + ch];
            bf16_t* py = Y + (size_t)(b * SEQ + t0 + sg * 8) * DMIX + chg;
#pragma unroll
            for (int k = 0; k < 8; ++k) { hs = av[k] * hs + bv[k]; py[(size_t)k * DMIX] = (bf16_t)f2bf(hs * siluf_(bf2f(zr[k]))); }
            if (sg == 7) CY[((tile & 1) ^ 1) * 64 + ch] = hs;
        }
    }
    __syncthreads();
}


template <bool ONLINE> DI void phase_mix(const Args& a, int l, unsigned char* lds, int cofs = 0, bool only_lru = false) {
    unsigned* ctr = (unsigned*)(a.ws + WS_CTL) + l * 16 + cofs;
    volatile int* UNIT = (volatile int*)(lds + A_UNIT);
    if (blockIdx.x < 128) lru_unit(a, l, lds, blockIdx.x >> 3, blockIdx.x & 7);
    if (only_lru) return;
    __syncthreads();
    if (threadIdx.x == 0) UNIT[0] = (int)atomicAdd(ctr, 1u);
    __syncthreads();
    for (int u = UNIT[0]; u < 1024; ) {
        int nxt = 0; if (threadIdx.x == 0) nxt = (int)atomicAdd(ctr, 1u);
        nsa_unit<ONLINE>(a, l, lds, (u & 31) >> 1, u & 1, 31 - (u >> 5));
        if (threadIdx.x == 0) UNIT[0] = nxt;
        __syncthreads();
        u = UNIT[0];
    }
    __syncthreads();
    if (threadIdx.x == 0) UNIT[0] = (int)atomicAdd(ctr + 1, 1u);
    __syncthreads();
    for (int u = UNIT[0]; u < 1024; ) {
        int nxt = 0; if (threadIdx.x == 0) nxt = (int)atomicAdd(ctr + 1, 1u);
        fox_unit<ONLINE>(a, l, lds, (u & 127) >> 3, u & 7, 7 - (u >> 7));
        if (threadIdx.x == 0) UNIT[0] = nxt;
        __syncthreads();
        u = UNIT[0];
    }
}

#define XB_TMO      128
#define XB_XCNT(j)  (256  + 64 * (j))
#define XB_XSUB(j)  (1280 + 64 * (j))
#define XB_XGEN(j)  (2304 + 64 * (j))
#define XB_TOP      3328
#define XB_TOPGEN   3392
#define XCD_BAR_WORDS 3456
#define XB_SPIN_CAP (1u << 18)
DI unsigned xb_ld(unsigned* p)              { return __hip_atomic_load(p, __ATOMIC_RELAXED, __HIP_MEMORY_SCOPE_AGENT); }
DI unsigned xb_add(unsigned* p, unsigned v) { return __hip_atomic_fetch_add(p, v, __ATOMIC_RELAXED, __HIP_MEMORY_SCOPE_AGENT); }
DI unsigned xb_xcc_id() { return (unsigned)__builtin_amdgcn_s_getreg((3 << 11) | 20) & 0xFu; }
#define XB_SPIN(cond, bar) do { unsigned _sp = 0; while (cond) { __builtin_amdgcn_s_sleep(1); \
    if ((++_sp & 255u) == 0u) { if (xb_ld(&(bar)[XB_TMO])) break; if (_sp > XB_SPIN_CAP) { atomicAdd(&(bar)[XB_TMO], 1u); break; } } } } while (0)
struct XcdBarrier { unsigned* bar; unsigned x; volatile LAS3 unsigned* st; };
DI XcdBarrier xcd_barrier_post(unsigned* bar, volatile LAS3 unsigned* st) {
    XcdBarrier b; b.bar = bar; b.x = xb_xcc_id(); b.st = st;
    if (threadIdx.x == 0) (void)xb_add(&bar[XB_XCNT(b.x)], 1u);
    return b;
}
DI void xcd_barrier_complete(unsigned* bar, unsigned x, unsigned& nloc, unsigned& nx) {
    const unsigned G = gridDim.x * gridDim.y * gridDim.z;
    unsigned sum, cnt, mine, sp = 0u;
    for (;;) {
        sum = 0u; cnt = 0u; mine = 0u;
#pragma unroll
        for (unsigned j = 0; j < 16; ++j) { const unsigned c = xb_ld(&bar[XB_XCNT(j)]); sum += c; cnt += (c > 0u) ? 1u : 0u; mine = (j == x) ? c : mine; }
        if (sum == G) break;
        __builtin_amdgcn_s_sleep(1);
        if ((++sp & 255u) == 0u) { if (xb_ld(&bar[XB_TMO])) break; if (sp > XB_SPIN_CAP) { atomicAdd(&bar[XB_TMO], 1u); break; } }
    }
    nloc = mine > 0u ? mine : 1u; nx = cnt > 0u ? cnt : 1u;
}
DI void xcd_barrier(const XcdBarrier& b) {
    asm volatile("s_waitcnt vmcnt(0)" ::: "memory");
    __syncthreads();
    if (threadIdx.x == 0) {
        unsigned* bar = b.bar;
        __builtin_amdgcn_s_waitcnt(0);
        unsigned nloc = b.st[0], nx = b.st[1];
        if (nloc == 0u) { xcd_barrier_complete(bar, b.x, nloc, nx); b.st[0] = nloc; b.st[1] = nx; }
        const unsigned old = xb_add(&bar[XB_XSUB(b.x)], 1u);
        const unsigned gen = old / nloc;
        if (old + 1u == (gen + 1u) * nloc) {
            __builtin_amdgcn_fence(__ATOMIC_RELEASE, "agent");
            asm volatile("s_waitcnt vmcnt(0)" ::: "memory");
            const unsigned og = xb_add(&bar[XB_TOP], 1u);
            const unsigned tg = og / nx;
            if (og + 1u == (tg + 1u) * nx) xb_add(&bar[XB_TOPGEN], 1u);
            else XB_SPIN(xb_ld(&bar[XB_TOPGEN]) == tg, bar);
            __builtin_amdgcn_fence(__ATOMIC_ACQUIRE, "agent");
            xb_add(&bar[XB_XGEN(b.x)], 1u);
            asm volatile("s_waitcnt vmcnt(0)" ::: "memory");
        } else {
            XB_SPIN(xb_ld(&bar[XB_XGEN(b.x)]) == gen, bar);
            __builtin_amdgcn_fence(__ATOMIC_ACQUIRE, "agent");
            asm volatile("s_waitcnt vmcnt(0)" ::: "memory");
        }
    }
    __syncthreads();
}

#ifndef DUP
#define DUP 0
#endif
#define LP_PTRS unsigned char* ws = a.ws; bf16_t* P = (bf16_t*)(ws + WS_P); bf16_t* HY = (bf16_t*)(ws + WS_HY); bf16_t* H = (bf16_t*)(ws + WS_H); float* SS = (float*)(ws + WS_SS); float* GL = (float*)(ws + WS_GL); const float* xin = L ? a.out : a.in[I_X]; (void)P; (void)HY; (void)H; (void)SS; (void)GL; (void)xin
template <int L> DI void layer_phases(const Args& a, const XcdBarrier& bar, unsigned char* lds) {
    {   LP_PTRS; const bf16_t* W = (const bf16_t*)(ws + WS_WIN) + (size_t)L * NPAD * DM;
        pg8::Gemm g{H, W, NT, PP, DM}; pg8::StaticOrder S; S.init(NT, PP, (int)gridDim.x, (int)blockIdx.x);
        pg8::EpiProjF E{P, L ? SS : nullptr, (PG8_LAS float*)((PG8_LAS unsigned char*)lds + pg8::STAGE_BYTES), (const float*)(ws + WS_GAINS) + L * 320}; pg8::gemm_phase<pg8::EpiProjF, pg8::StaticOrder, true, true>((PG8_LAS unsigned char*)lds, g, S, E);
        gates_gemm(H, W + (size_t)PP * DM, GL, L ? SS : nullptr, L == 1);
        if (L == 0) { __syncthreads(); win1_late(a, (float*)lds); }
        if (DUP == 2 && L == 0) { xcd_barrier(bar); pg8::gemm_phase<pg8::EpiProjF, pg8::StaticOrder, true, true>((PG8_LAS unsigned char*)lds, g, S, E); gates_gemm(H, W + (size_t)PP * DM, GL, L ? SS : nullptr, false); } }
    xcd_barrier(bar);
    {   LP_PTRS; prep_cumsum(a, L, (float*)lds); prep_compress(a, L, P); if (L == 0) { __syncthreads(); phase_wprep(a, (float*)lds, 1); }
        if (DUP == 3 && L == 0) { xcd_barrier(bar); prep_cumsum(a, L, (float*)lds); prep_compress(a, L, P); } }
    xcd_barrier(bar);
    {   const float* bnd = (const float*)(a.ws + WS_BND) + L * 4;
        const bool online = fmaxf(fmaxf(bnd[0], bnd[1]), fmaxf(bnd[2], bnd[3])) > 60.f;
        if (online) phase_mix<true>(a, L, lds); else phase_mix<false>(a, L, lds);
        if (DUP == 4 && L == 0) { xcd_barrier(bar); phase_mix<false>(a, L, lds, 4); } }
    xcd_barrier(bar);
    {   LP_PTRS; pg8::Gemm g{HY, (const bf16_t*)(ws + WS_WOUT) + (size_t)L * DM * DMIX, NT, DM, DMIX}; pg8::StaticOrder S; S.init(NT, DM, (int)gridDim.x, (int)blockIdx.x);
        pg8::EpiOutF E{L ? nullptr : a.in[I_X], L ? H : nullptr, L ? a.out : nullptr, L ? nullptr : H, SS}; pg8::gemm_phase<pg8::EpiOutF, pg8::StaticOrder, true, true>((PG8_LAS unsigned char*)lds, g, S, E); }
}
__global__ void __launch_bounds__(512, 2) mk(Args a) {
    extern __shared__ __attribute__((aligned(16))) unsigned char lds[];
    __shared__ unsigned xb_st[2];
    cg::grid_group grid = cg::this_grid();
    if (threadIdx.x < 2) xb_st[threadIdx.x] = 0u;
    __syncthreads();
    const XcdBarrier bar = xcd_barrier_post((unsigned*)(a.ws + WS_CTL + 1024), (volatile LAS3 unsigned*)xb_st);
    phase_wprep(a, (float*)lds, 0);
    phase_rms(a.in[I_X], a.in[I_NG], (bf16_t*)(a.ws + WS_H));
    for (int i = blockIdx.x * 512 + threadIdx.x; i < NT; i += gridDim.x * 512) ((float*)(a.ws + WS_SS))[i] = 0.f;
    if (a.ph_lo < 0) grid.sync();
    xcd_barrier(bar);
    layer_phases<0>(a, bar, lds);
    xcd_barrier(bar);
    layer_phases<1>(a, bar, lds);
}

extern "C" void kernel_launch(void* const* d_in, const int* in_sizes, int n_in, void* d_out, int out_size, void* d_ws, size_t ws_size, hipStream_t stream) {
    static int grid = 0;
    if (grid == 0) {
        if (n_in != 21 || ws_size < WS_END) { fprintf(stderr, "kernel_launch: unexpected n_in %d / ws_size %zu (need %zu)\n", n_in, ws_size, (size_t)WS_END); grid = -1; return; }
        int dev = 0, cus = 0, per_cu = 0;
        (void)hipGetDevice(&dev); (void)hipDeviceGetAttribute(&cus, hipDeviceAttributeMultiprocessorCount, dev);
        (void)hipFuncSetAttribute((const void*)mk, hipFuncAttributeMaxDynamicSharedMemorySize, LDS_BYTES);
        (void)hipOccupancyMaxActiveBlocksPerMultiprocessor(&per_cu, (const void*)mk, 512, LDS_BYTES);
        if (per_cu < 1) { fprintf(stderr, "kernel_launch: occupancy query says %d blocks/CU\n", per_cu); per_cu = 1; }
        if (per_cu > 1) per_cu = 1;
        grid = cus * per_cu;
        (void)hipGetLastError();
    }
    if (grid < 0) return;
    if (hipMemsetAsync((char*)d_ws + WS_CTL, 0, WS_CTL_BYTES, stream) != hipSuccess) { fprintf(stderr, "kernel_launch: memset failed\n"); return; }
    Args a{};
    for (int i = 0; i < 21; ++i) a.in[i] = (const float*)d_in[i];
    a.out = (float*)d_out; a.ws = (unsigned char*)d_ws; a.ph_lo = 0; a.ph_hi = 13;
    void* args[] = {&a};
    hipError_t e = hipLaunchCooperativeKernel((const void*)mk, dim3(grid), dim3(512), args, LDS_BYTES, stream);
    if (e != hipSuccess) fprintf(stderr, "cooperative launch failed: %s (grid %d)\n", hipGetErrorString(e), grid);
}
```

```cpp
#define DUP 0
#include <hip/hip_runtime.h>
#include <hip/hip_cooperative_groups.h>
#include <stdint.h>
#include <stdio.h>
namespace cg = cooperative_groups;

#define DI __device__ __forceinline__
typedef unsigned short bf16_t;
typedef short bf16x8 __attribute__((ext_vector_type(8)));
typedef float f32x4 __attribute__((ext_vector_type(4)));
typedef float f32x16 __attribute__((ext_vector_type(16)));
typedef unsigned u32x4 __attribute__((ext_vector_type(4)));
typedef unsigned u32x2 __attribute__((ext_vector_type(2)));

constexpr int NB = 16, SEQ = 2048, DM = 1024, NT = NB * SEQ;
constexpr int DIN = 4896, DMIX = 1536, PP = 4864, NPAD = 5120;
constexpr int C_U = 0, C_Z = 512, C_NQ = 1024, C_KC = 1536, C_VC = 1664, C_KS = 1792, C_VS = 1920, C_KW = 2048, C_VW = 2176,
              C_NZ = 2304, C_FQ = 2816, C_FK = 3328, C_FV = 3840, C_FZ = 4352;
constexpr float LOG2E = 1.4426950408889634f, QS = 0.125f * LOG2E, EPS = 1e-6f;

constexpr size_t WS_P = 0;
constexpr size_t WS_HY = WS_P + (size_t)NT * PP * 2;
constexpr size_t WS_H = WS_HY + (size_t)NT * DMIX * 2;
constexpr size_t WS_SS = WS_H + (size_t)NT * DM * 2;
constexpr size_t WS_GL = WS_SS + (size_t)NT * 4;
constexpr size_t WS_WIN = WS_GL + (size_t)NT * 32 * 4;
constexpr size_t WS_WOUT = WS_WIN + (size_t)2 * NPAD * DM * 2;
constexpr size_t WS_WA = WS_WOUT + (size_t)2 * DM * DMIX * 2;
constexpr size_t WS_WX = WS_WA + 131072;
constexpr size_t WS_WCK = WS_WX + 131072;
constexpr size_t WS_WCV = WS_WCK + 524288;
constexpr size_t WS_BKV = WS_WCV + 524288;
constexpr size_t WS_BND = WS_BKV + 1024;
constexpr size_t WS_GAINS = WS_BKV + 2048;
constexpr size_t WS_C2 = WS_BKV + 8192;
constexpr size_t WS_KCMP = WS_C2 + (size_t)NB * 8 * SEQ * 4;
constexpr size_t WS_VCMP = WS_KCMP + 524288;
constexpr size_t WS_CTL = WS_VCMP + 524288;
constexpr size_t WS_CTL_BYTES = 16384;
constexpr size_t WS_END = WS_CTL + WS_CTL_BYTES;

constexpr int LDS_BYTES = 143360;

struct Args { const float* in[21]; float* out; unsigned char* ws; int ph_lo, ph_hi; };
enum { I_X = 0, I_NG, I_WIN, I_WOUT, I_CW, I_CB, I_WA, I_BA, I_WX, I_BX, I_LAM, I_NQG, I_NKG, I_PEK, I_PEV, I_WCK, I_WCV, I_GB, I_FQG, I_FKG, I_FFB };

DI int opaque_tid() { int t = threadIdx.x; asm volatile("" : "+v"(t)); return t; }
DI unsigned f2bf(float f) { unsigned u = __float_as_uint(f); return (u + 0x7fffu + ((u >> 16) & 1u)) >> 16; }
DI float bf2f(unsigned h) { return __uint_as_float(h << 16); }
DI unsigned pk2(float lo, float hi) { return f2bf(lo) | (f2bf(hi) << 16); }
DI float wave_sum(float v) { for (int o = 32; o; o >>= 1) v += __shfl_xor(v, o); return v; }
DI float sigmoidf_(float x) { return 1.f / (1.f + __expf(-x)); }
DI float siluf_(float x) { return x / (1.f + __expf(-x)); }
DI void unpack8(u32x4 r, float* f) {
#pragma unroll
    for (int i = 0; i < 4; ++i) { f[2 * i] = bf2f(r[i] & 0xffffu); f[2 * i + 1] = bf2f(r[i] >> 16); }
}

DI int win_col(int pc) {
    if (pc < 2304) return pc; if (pc < 4352) return pc + 24; if (pc < 4864) return pc + 32;
    if (pc < 4888) return 2304 + pc - 4864; if (pc < 4896) return 4376 + pc - 4888; return -1;
}
DI void wtile(const float* src, int ldsrc, bf16_t* dst, int K, int n0, int k0, int mode, float* t, const float* rowg = nullptr) {
    const int tid = opaque_tid();
#pragma unroll
    for (int i = 0; i < 8; ++i) {
        int kk = (tid >> 6) + 8 * i, nn = tid & 63, n = n0 + nn; int oc = mode ? win_col(n) : n;
        t[kk * 65 + nn] = oc >= 0 ? src[(size_t)(k0 + kk) * ldsrc + oc] * (rowg ? rowg[k0 + kk] : 1.f) : 0.f;
    }
    __syncthreads();
    {   const int nn = tid >> 3, k8 = (tid & 7) * 8; u32x4 w;
#pragma unroll
        for (int i = 0; i < 4; ++i) w[i] = pk2(t[(k8 + 2 * i) * 65 + nn], t[(k8 + 2 * i + 1) * 65 + nn]);
        *(u32x4*)(dst + (size_t)(n0 + nn) * K + k0 + k8) = w; }
    __syncthreads();
}
DI void phase_wprep(const Args& a, float* ldsf, int stage) {
    unsigned char* ws = a.ws;
    constexpr int PER = 1280 + 384 + 8 + 8 + 32 + 32 + 2;
    const bool split = gridDim.x >= 256;
    if (stage == 1 && (!split || blockIdx.x < 16)) return;
    const int ub = stage == 1 ? (int)blockIdx.x - 16 : (int)blockIdx.x, us = stage == 1 ? (int)gridDim.x - 16 : (int)gridDim.x;
    for (int u = ub; u < 2 * PER; u += us) {
        int l = u / PER, r = u % PER;
        if (split) {
            const bool early = (l == 0 && r < 1280) || (l == 0 && r >= 1280 + 384 + 16 && r < PER - 2) || (r >= PER - 2);
            const bool late1 = (r >= 1280 && r < 1280 + 384 + 16) || (l == 1 && r >= 1280 + 384 + 16 && r < PER - 2);
            if (stage == 0 ? !early : !late1) continue;
        }
        if (r < 1280) { wtile(a.in[I_WIN] + (size_t)l * DM * DIN, DIN, (bf16_t*)(ws + WS_WIN) + (size_t)l * NPAD * DM, DM, (r % 80) * 64, (r / 80) * 64, 1, ldsf, l ? a.in[I_NG] + DM : nullptr); continue; }
        r -= 1280;
        if (r < 384) { wtile(a.in[I_WOUT] + (size_t)l * DMIX * DM, DM, (bf16_t*)(ws + WS_WOUT) + (size_t)l * DM * DMIX, DMIX, (r % 16) * 64, (r / 16) * 64, 0, ldsf); continue; }
        r -= 384;
        if (r < 8) { wtile(a.in[I_WA] + (size_t)(l * 8 + r) * 4096, 64, (bf16_t*)(ws + WS_WA) + (size_t)(l * 8 + r) * 4096, 64, 0, 0, 0, ldsf); continue; }
        r -= 8;
        if (r < 8) { wtile(a.in[I_WX] + (size_t)(l * 8 + r) * 4096, 64, (bf16_t*)(ws + WS_WX) + (size_t)(l * 8 + r) * 4096, 64, 0, 0, 0, ldsf); continue; }
        r -= 8;
        if (r < 32) { wtile(a.in[I_WCK] + (size_t)l * 131072, 64, (bf16_t*)(ws + WS_WCK) + (size_t)l * 131072, 2048, 0, r * 64, 0, ldsf); continue; }
        r -= 32;
        if (r < 32) { wtile(a.in[I_WCV] + (size_t)l * 131072, 64, (bf16_t*)(ws + WS_WCV) + (size_t)l * 131072, 2048, 0, r * 64, 0, ldsf); continue; }
        r -= 32;
        {
            const float* pe = a.in[r ? I_PEV : I_PEK] + (size_t)l * 2048; const float* w = a.in[r ? I_WCV : I_WCK] + (size_t)l * 131072;
            const int e = threadIdx.x & 63, part = threadIdx.x >> 6; float s = 0.f;
#pragma unroll 16
            for (int k = part * 256; k < part * 256 + 256; ++k) s += pe[k] * w[(size_t)k * 64 + e];
            ldsf[part * 64 + e] = s; __syncthreads();
            if (threadIdx.x < 64) { float t = 0.f; for (int p = 0; p < 8; ++p) t += ldsf[p * 64 + e]; ((float*)(ws + WS_BKV))[(l * 2 + r) * 64 + e] = t; }
            if (r == 1 && threadIdx.x < 64) { float* gn = (float*)(ws + WS_GAINS) + l * 320;
                gn[e] = a.in[I_NQG][l * 64 + e] * QS; gn[64 + e] = a.in[I_NKG][(l * 3 + 1) * 64 + e]; gn[128 + e] = a.in[I_NKG][(l * 3 + 2) * 64 + e]; gn[192 + e] = a.in[I_FQG][l * 64 + e] * QS; gn[256 + e] = a.in[I_FKG][l * 64 + e]; }
            if (r == 0 && threadIdx.x < 64) {
                float gq = fabsf(a.in[I_NQG][l * 64 + e]), k0 = fabsf(a.in[I_NKG][(l * 3 + 0) * 64 + e]), k1 = fabsf(a.in[I_NKG][(l * 3 + 1) * 64 + e]), k2 = fabsf(a.in[I_NKG][(l * 3 + 2) * 64 + e]);
                float fq = fabsf(a.in[I_FQG][l * 64 + e]), fk = fabsf(a.in[I_FKG][l * 64 + e]);
                for (int o = 32; o; o >>= 1) { gq = fmaxf(gq, __shfl_xor(gq, o)); k0 = fmaxf(k0, __shfl_xor(k0, o)); k1 = fmaxf(k1, __shfl_xor(k1, o)); k2 = fmaxf(k2, __shfl_xor(k2, o)); fq = fmaxf(fq, __shfl_xor(fq, o)); fk = fmaxf(fk, __shfl_xor(fk, o)); }
                if (e == 0) { float* bnd = (float*)(ws + WS_BND) + l * 4; bnd[0] = QS * 64.f * gq * k0 * 1.01f + 0.5f; bnd[1] = QS * 64.f * gq * k1 * 1.01f + 0.5f; bnd[2] = QS * 64.f * gq * k2 * 1.01f + 0.5f; bnd[3] = QS * 64.f * fq * fk * 1.01f + 0.5f; }
            }
            __syncthreads();
        }
    }
}

DI void win1_late(const Args& a, float* ldsf) {
    if (gridDim.x < 256 || blockIdx.x < 128) return;
    for (int r = (int)blockIdx.x - 128; r < 1280; r += (int)gridDim.x - 128)
        wtile(a.in[I_WIN] + (size_t)DM * DIN, DIN, (bf16_t*)(a.ws + WS_WIN) + (size_t)NPAD * DM, DM, (r % 80) * 64, (r / 80) * 64, 1, ldsf, a.in[I_NG] + DM);
}

DI void phase_rms(const float* x, const float* g, bf16_t* H) {
    const int tid_ = opaque_tid(); const int lane = tid_ & 63, wid = tid_ >> 6;
    const int stride = gridDim.x * 8;
    int row = blockIdx.x * 8 + wid;
    f32x4 v[4], vn[4];
    if (row < NT) {
#pragma unroll
        for (int i = 0; i < 4; ++i) vn[i] = ((const f32x4*)(x + (size_t)row * DM))[lane + 64 * i];
    }
    for (; row < NT; row += stride) {
#pragma unroll
        for (int i = 0; i < 4; ++i) v[i] = vn[i];
        if (row + stride < NT) {
#pragma unroll
            for (int i = 0; i < 4; ++i) vn[i] = ((const f32x4*)(x + (size_t)(row + stride) * DM))[lane + 64 * i];
        }
        float ss = 0.f;
#pragma unroll
        for (int i = 0; i < 4; ++i) ss += v[i][0] * v[i][0] + v[i][1] * v[i][1] + v[i][2] * v[i][2] + v[i][3] * v[i][3];
        ss = wave_sum(ss);
        const float r = rsqrtf(ss * (1.f / DM) + EPS);
#pragma unroll
        for (int i = 0; i < 4; ++i) {
            const f32x4 gg = ((const f32x4*)g)[lane + 64 * i];
            u32x2 o; o[0] = pk2(v[i][0] * r * gg[0], v[i][1] * r * gg[1]); o[1] = pk2(v[i][2] * r * gg[2], v[i][3] * r * gg[3]);
            *(u32x2*)(H + (size_t)row * DM + (lane + 64 * i) * 4) = o;
        }
    }
}

namespace pg8 {
#define PG8_LAS __attribute__((address_space(3)))
typedef unsigned short bf16_t;
typedef short bf16x8 __attribute__((ext_vector_type(8)));
typedef float f32x4 __attribute__((ext_vector_type(4)));
typedef unsigned u32x4 __attribute__((ext_vector_type(4)));
constexpr int BM = 256, BK = 64, HALF = 128, HTB = HALF * BK * 2  , STAGE_BYTES = 8 * HTB, NXCD = 8, WGM = 8;

__host__ __device__ __forceinline__ int lds_byte(int r, int c) { const int st = (r >> 4) * 2 + (c >> 5), rr = r & 15, cc = c & 31, ob = rr * 64 + cc * 2; return st * 1024 + (ob ^ (((ob >> 9) & 1) << 5)); }
__host__ __device__ __forceinline__ void stage_rc(int b, int& R, int& C) { const int st = b / 1024, sb = b % 1024, swz = sb ^ (((sb >> 9) & 1) << 5); R = (st >> 1) * 16 + swz / 64; C = (st & 1) * 32 + (swz % 64) / 2; }
__host__ __device__ __forceinline__ int perm32(int rho) { const int n = rho >> 4, i = rho & 15; return 8 * (i >> 2) + 4 * n + (i & 3); }

struct Unit { int pm, pn; };
struct Gemm { const bf16_t* A; const bf16_t* Bt; int M, N, K; };

struct StaticOrder {
    int nM, nN, nwg, G, c;
    __host__ __device__ void init(int M, int N, int G_, int c_) { nM = M / BM; nN = N / BM; nwg = nM * nN; G = G_; c = c_; }
    __host__ __device__ bool next(int i, Unit& u) const {
        const long L = (long)i * G + c; if (L >= nwg) return false;
        int wgid = (int)L; { const int q = nwg / NXCD, r = nwg % NXCD, xcd = wgid % NXCD, off = wgid / NXCD; wgid = (xcd < r ? xcd * (q + 1) : r * (q + 1) + (xcd - r) * q) + off; }
        const int nig = WGM * nN, gid = wgid / nig, fm = gid * WGM, gsz = (nM - fm) < WGM ? (nM - fm) : WGM;
        u.pm = fm + ((wgid % nig) % gsz); u.pn = (wgid % nig) / gsz; return true;
    }
    __device__ __forceinline__ void a_ready(const Unit&) const {}
    __device__ __forceinline__ void done(const Unit&) const {}
};
__device__ __forceinline__ unsigned cvt_pk_bf16(float lo, float hi) { unsigned r; asm volatile("v_cvt_pk_bf16_f32 %0, %1, %2" : "=v"(r) : "v"(lo), "v"(hi)); return r; }

struct EpiProjF {
    static constexpr bool PERM = true, AFTER_DRAIN = false;
    bf16_t* P; const float* ss; PG8_LAS float* xs  ; const float* gains  ;
    __device__ __forceinline__ void operator()(const f32x4 (&acc)[2][2][4][2], const Unit& u, int wr, int wc, int fr, int fq) const {
        const int row0 = u.pm * BM + wr * 64 + fr;
        const int col0 = u.pn * BM + wc * 32 + 8 * fq;
        const int pn = u.pn, wid = wr * 4 + wc;
        const bool need = (pn == 4) | (pn == 5) | (pn == 7) | (pn == 8) | ((pn >= 11) & (pn <= 14));
        float hs[2][4][2];
        if (need) {
#pragma unroll
            for (int ai = 0; ai < 2; ++ai)
#pragma unroll
                for (int m = 0; m < 4; ++m)
#pragma unroll
                    for (int bj = 0; bj < 2; ++bj) { const f32x4 v0 = acc[ai][bj][m][0], v1 = acc[ai][bj][m][1];
                        float s = v0[0] * v0[0] + v0[1] * v0[1] + v0[2] * v0[2] + v0[3] * v0[3] + v1[0] * v1[0] + v1[1] * v1[1] + v1[2] * v1[2] + v1[3] * v1[3];
                        s += __shfl_xor(s, 16); s += __shfl_xor(s, 32);
                        hs[ai][m][bj] = s;
                        if (fq == 0) xs[(((wid * 2 + ai) * 4 + m) * 2 + bj) * 16 + fr] = s; }
            asm volatile("s_waitcnt lgkmcnt(0)" ::: "memory");
            __builtin_amdgcn_s_barrier();
        }
        const int kind = (pn <= 5) ? 0 : (pn == 7) ? 1 : (pn == 8) ? 2 : (pn <= 12) ? 3 : 4;
#pragma unroll
        for (int bj = 0; bj < 2; ++bj) {
            const bool hn = need && !((pn == 7 || pn == 8) && bj == 1);
            f32x4 g0 = (f32x4){1.f, 1.f, 1.f, 1.f}, g1 = g0;
            if (hn) { g0 = *(const f32x4*)(gains + kind * 64 + (wc & 1) * 32 + 8 * fq); g1 = *(const f32x4*)(gains + kind * 64 + (wc & 1) * 32 + 8 * fq + 4); }
#pragma unroll
            for (int ai = 0; ai < 2; ++ai)
#pragma unroll
                for (int m = 0; m < 4; ++m) { const int row = row0 + ai * HALF + m * 16;
                    const float rr = ss ? rsqrtf(ss[row] * (1.f / 1024) + 1e-6f) : 1.f;
                    float rs = rr;
                    if (hn) { const float tot = (hs[ai][m][bj] + xs[((((wid ^ 1) * 2 + ai) * 4 + m) * 2 + bj) * 16 + fr]) * rr * rr; rs = rr * rsqrtf(tot * (1.f / 64) + 1e-6f); }
                    const f32x4 v0 = acc[ai][bj][m][0] * rs * g0, v1 = acc[ai][bj][m][1] * rs * g1;
                    u32x4 w; w.x = cvt_pk_bf16(v0[0], v0[1]); w.y = cvt_pk_bf16(v0[2], v0[3]); w.z = cvt_pk_bf16(v1[0], v1[1]); w.w = cvt_pk_bf16(v1[2], v1[3]);
                    *(u32x4*)(P + (size_t)row * 4864 + col0 + bj * HALF) = w; }
        }
    }
};
struct EpiOutF {
    static constexpr bool PERM = true, AFTER_DRAIN = false;
    const float* res32; const bf16_t* res16; float* out32; bf16_t* out16; float* ss;
    __device__ __forceinline__ void operator()(const f32x4 (&acc)[2][2][4][2], const Unit& u, int wr, int wc, int fr, int fq) const {
        const int row0 = u.pm * BM + wr * 64 + fr, col0 = u.pn * BM + wc * 32 + 8 * fq;
#pragma unroll
        for (int ai = 0; ai < 2; ++ai)
#pragma unroll
            for (int m = 0; m < 4; ++m) { const int row = row0 + ai * HALF + m * 16; const size_t off = (size_t)row * 1024 + col0;
                float sq = 0.f;
#pragma unroll
                for (int bj = 0; bj < 2; ++bj) {
                    f32x4 r0, r1;
                    if (res16) { const u32x4 rb = *(const u32x4*)(res16 + off + bj * HALF);
                        r0 = (f32x4){__uint_as_float(rb[0] << 16), __uint_as_float(rb[0] & 0xffff0000u), __uint_as_float(rb[1] << 16), __uint_as_float(rb[1] & 0xffff0000u)};
                        r1 = (f32x4){__uint_as_float(rb[2] << 16), __uint_as_float(rb[2] & 0xffff0000u), __uint_as_float(rb[3] << 16), __uint_as_float(rb[3] & 0xffff0000u)}; }
                    else { r0 = *(const f32x4*)(res32 + off + bj * HALF); r1 = *(const f32x4*)(res32 + off + bj * HALF + 4); }
                    const f32x4 o0 = r0 + acc[ai][bj][m][0], o1 = r1 + acc[ai][bj][m][1];
                    if (out32) { *(f32x4*)(out32 + off + bj * HALF) = o0; *(f32x4*)(out32 + off + bj * HALF + 4) = o1; }
                    if (out16) { sq += o0[0] * o0[0] + o0[1] * o0[1] + o0[2] * o0[2] + o0[3] * o0[3] + o1[0] * o1[0] + o1[1] * o1[1] + o1[2] * o1[2] + o1[3] * o1[3];
                        u32x4 w; w.x = cvt_pk_bf16(o0[0], o0[1]); w.y = cvt_pk_bf16(o0[2], o0[3]); w.z = cvt_pk_bf16(o1[0], o1[1]); w.w = cvt_pk_bf16(o1[2], o1[3]);
                        *(u32x4*)(out16 + off + bj * HALF) = w; }
                    __builtin_amdgcn_sched_barrier(0); }
                if (out16) { sq += __shfl_xor(sq, 16); sq += __shfl_xor(sq, 32); if (fq == 0) atomicAdd(ss + row, sq); } }
    }
};

template <class Epi, class Sched, bool ALIGN_EPI = false, bool SP2 = false>
__device__ __forceinline__ void gemm_phase(PG8_LAS unsigned char* lds, const Gemm g, const Sched& S, const Epi& E) {
    int tid = threadIdx.x; asm volatile("" : "+v"(tid));
    const int wid = __builtin_amdgcn_readfirstlane(tid >> 6), lane = tid & 63, wr = wid >> 2, wc = wid & 3, fr = lane & 15, fq = lane >> 4;
    const int K = g.K, nt = K / BK;
    unsigned voffA[2], voffB[2];
#pragma unroll
    for (int i = 0; i < 2; ++i) { int R, C; stage_rc(tid * 16 + i * 8192, R, C); const int Rb = Epi::PERM ? ((R & ~31) + perm32(R & 31)) : R;
        voffA[i] = (unsigned)(R * K + C) * 2u; voffB[i] = (unsigned)(Rb * K + C) * 2u; }
    const size_t kstep = (size_t)(BK * 2);
    const size_t hstep = (size_t)HALF * K * 2;
    const size_t tstep = 2 * hstep;
    const unsigned ldsw = (unsigned)wid * 1024u;
    const int aoff = lds_byte(wr * 64 + fr, fq * 8), boff = lds_byte(wc * 32 + fr, fq * 8);
#define PG8_SA(b, h) (((b) * 2 + (h)) * HTB)
#define PG8_SB(b, h) ((4 + (b) * 2 + (h)) * HTB)
#define PG8_STAGE(bufoff, gbase, voff) do { _Pragma("unroll") for (int _i = 0; _i < 2; ++_i) \
        __builtin_amdgcn_global_load_lds((const unsigned*)((const char*)(gbase) + (voff)[_i]), (PG8_LAS unsigned*)(lds + (bufoff) + ldsw + _i * 8192), 16, 0, 0); } while (0)
#define PG8_LDA(dst, b, h) do { _Pragma("unroll") for (int m = 0; m < 4; ++m) _Pragma("unroll") for (int k = 0; k < 2; ++k) dst[m][k] = *(const PG8_LAS bf16x8*)(lds + PG8_SA(b, h) + aoff + m * 2048 + k * 1024); } while (0)
#define PG8_LDB(dst, b, h) do { _Pragma("unroll") for (int n = 0; n < 2; ++n) _Pragma("unroll") for (int k = 0; k < 2; ++k) dst[n][k] = *(const PG8_LAS bf16x8*)(lds + PG8_SB(b, h) + boff + n * 2048 + k * 1024); } while (0)
#define PG8_MMA(ai, bj, At, Bt) do { __builtin_amdgcn_s_setprio(1); _Pragma("unroll") for (int m = 0; m < 4; ++m) _Pragma("unroll") for (int n = 0; n < 2; ++n) _Pragma("unroll") for (int k = 0; k < 2; ++k) \
        acc[ai][bj][m][n] = __builtin_amdgcn_mfma_f32_16x16x32_bf16(Bt[n][k], At[m][k], acc[ai][bj][m][n], 0, 0, 0); __builtin_amdgcn_s_setprio(0); } while (0)
#define PG8_WAIT_V(n) asm volatile("s_waitcnt vmcnt(" #n ")" ::: "memory")
#define PG8_WAIT_L(n) asm volatile("s_waitcnt lgkmcnt(" #n ")" ::: "memory")
#define PG8_BAR __builtin_amdgcn_s_barrier()
#define PG8_SCHED __builtin_amdgcn_sched_barrier(0)
    Unit cur, nxt; int ui = 0;
    if (!S.next(0, cur)) return;
    f32x4 acc[2][2][4][2];
#pragma unroll
    for (int a = 0; a < 2; ++a)
#pragma unroll
        for (int b = 0; b < 2; ++b)
#pragma unroll
            for (int m = 0; m < 4; ++m)
#pragma unroll
                for (int n = 0; n < 2; ++n) acc[a][b][m][n] = (f32x4){0.f, 0.f, 0.f, 0.f};
    bf16x8 At[4][2], B0[2][2], B1[2][2];
    const char* cA = (const char*)g.A + (size_t)cur.pm * tstep; const char* cB = (const char*)g.Bt + (size_t)cur.pn * tstep;
    S.a_ready(cur);
    if constexpr (SP2) {
        PG8_STAGE(PG8_SB(0, 0), cB, voffB); PG8_STAGE(PG8_SB(0, 1), cB + hstep, voffB); PG8_STAGE(PG8_SA(0, 0), cA, voffA); PG8_STAGE(PG8_SA(0, 1), cA + hstep, voffA);
        if (wr == 1) PG8_BAR;
        PG8_WAIT_V(2); PG8_BAR;
        PG8_STAGE(PG8_SB(1, 0), cB + kstep, voffB); PG8_STAGE(PG8_SA(1, 0), cA + kstep, voffA); PG8_STAGE(PG8_SB(1, 1), cB + hstep + kstep, voffB);
        PG8_WAIT_V(6); PG8_BAR;
    } else {
        PG8_STAGE(PG8_SB(0, 0), cB, voffB); PG8_STAGE(PG8_SA(0, 0), cA, voffA); PG8_STAGE(PG8_SB(0, 1), cB + hstep, voffB); PG8_STAGE(PG8_SA(0, 1), cA + hstep, voffA);
        if (wr == 1) PG8_BAR;
        PG8_WAIT_V(4); PG8_BAR;
        PG8_STAGE(PG8_SB(1, 0), cB + kstep, voffB); PG8_STAGE(PG8_SA(1, 0), cA + kstep, voffA); PG8_STAGE(PG8_SB(1, 1), cB + hstep + kstep, voffB);
        PG8_WAIT_V(6); PG8_BAR;
    }
    for (;;) {
        const bool has_next = S.next(ui + 1, nxt);
        const char* nA = has_next ? (const char*)g.A + (size_t)nxt.pm * tstep : cA; const char* nB = has_next ? (const char*)g.Bt + (size_t)nxt.pn * tstep : cB;
        for (int t = 0; t < nt; t += 2) {
            const bool last = (t == nt - 2);
            const char* a1 = cA + (size_t)(t + 1) * kstep;
            const char* a2 = last ? nA : cA + (size_t)(t + 2) * kstep; const char* b2 = last ? nB : cB + (size_t)(t + 2) * kstep;
            const char* a3 = a2 + kstep; const char* b3 = b2 + kstep;
            if (last && has_next) S.a_ready(nxt);
            if constexpr (SP2) {
            PG8_LDB(B0, 0, 0); PG8_LDB(B1, 0, 1); PG8_SCHED; PG8_LDA(At, 0, 0); PG8_STAGE(PG8_SA(1, 1), a1 + hstep, voffA);
            PG8_WAIT_V(8); PG8_WAIT_L(0); PG8_BAR; PG8_MMA(0, 0, At, B0); PG8_MMA(0, 1, At, B1); PG8_BAR; PG8_SCHED;
            PG8_LDA(At, 0, 1); PG8_STAGE(PG8_SB(0, 0), b2, voffB); PG8_STAGE(PG8_SB(0, 1), b2 + hstep, voffB); PG8_STAGE(PG8_SA(0, 0), a2, voffA);
            PG8_WAIT_V(8); PG8_WAIT_L(0); PG8_BAR; PG8_MMA(1, 0, At, B0); PG8_MMA(1, 1, At, B1); PG8_BAR; PG8_SCHED;
            PG8_LDB(B0, 1, 0); PG8_LDB(B1, 1, 1); PG8_SCHED; PG8_LDA(At, 1, 0); PG8_STAGE(PG8_SA(0, 1), a2 + hstep, voffA);
            PG8_WAIT_V(8); PG8_WAIT_L(0); PG8_BAR; PG8_MMA(0, 0, At, B0); PG8_MMA(0, 1, At, B1); PG8_BAR; PG8_SCHED;
            PG8_LDA(At, 1, 1); PG8_STAGE(PG8_SB(1, 0), b3, voffB); PG8_STAGE(PG8_SB(1, 1), b3 + hstep, voffB); PG8_STAGE(PG8_SA(1, 0), a3, voffA);
            PG8_WAIT_V(8); PG8_WAIT_L(0); PG8_BAR; PG8_MMA(1, 0, At, B0); PG8_MMA(1, 1, At, B1); PG8_BAR; PG8_SCHED;
            } else {
            PG8_LDB(B0, 0, 0); PG8_SCHED; PG8_LDA(At, 0, 0); PG8_STAGE(PG8_SA(1, 1), a1 + hstep, voffA);
            PG8_WAIT_L(8); PG8_BAR; PG8_WAIT_L(0); PG8_MMA(0, 0, At, B0); PG8_BAR; PG8_SCHED;
            PG8_LDB(B1, 0, 1); PG8_STAGE(PG8_SB(0, 0), b2, voffB);
            PG8_BAR; PG8_WAIT_L(0); PG8_MMA(0, 1, At, B1); PG8_BAR;
            PG8_LDA(At, 0, 1); PG8_STAGE(PG8_SA(0, 0), a2, voffA);
            PG8_BAR; PG8_WAIT_L(0); PG8_MMA(1, 0, At, B0); PG8_BAR; PG8_SCHED;
            PG8_STAGE(PG8_SB(0, 1), b2 + hstep, voffB);
            PG8_WAIT_V(6); PG8_BAR; PG8_MMA(1, 1, At, B1); PG8_BAR;
            PG8_LDB(B0, 1, 0); PG8_SCHED; PG8_LDA(At, 1, 0); PG8_STAGE(PG8_SA(0, 1), a2 + hstep, voffA);
            PG8_WAIT_L(8); PG8_BAR; PG8_WAIT_L(0); PG8_MMA(0, 0, At, B0); PG8_BAR; PG8_SCHED;
            PG8_LDB(B1, 1, 1); PG8_STAGE(PG8_SB(1, 0), b3, voffB);
            PG8_BAR; PG8_WAIT_L(0); PG8_MMA(0, 1, At, B1); PG8_BAR;
            PG8_LDA(At, 1, 1); PG8_STAGE(PG8_SA(1, 0), a3, voffA);
            PG8_BAR; PG8_WAIT_L(0); PG8_MMA(1, 0, At, B0); PG8_BAR; PG8_SCHED;
            PG8_STAGE(PG8_SB(1, 1), b3 + hstep, voffB);
            PG8_WAIT_V(6); PG8_BAR; PG8_MMA(1, 1, At, B1); PG8_BAR;
            }
        }
        if constexpr (ALIGN_EPI) { if (wr == 0) PG8_BAR; }
        if constexpr (!Epi::AFTER_DRAIN) { E(acc, cur, wr, wc, fr, fq); S.done(cur); }
        if (!has_next) break;
#pragma unroll
        for (int a = 0; a < 2; ++a)
#pragma unroll
            for (int b = 0; b < 2; ++b)
#pragma unroll
                for (int m = 0; m < 4; ++m)
#pragma unroll
                    for (int n = 0; n < 2; ++n) acc[a][b][m][n] = (f32x4){0.f, 0.f, 0.f, 0.f};
        cur = nxt; cA = nA; cB = nB; ++ui;
        if constexpr (ALIGN_EPI) { if (wr == 1) PG8_BAR; }
    }
    PG8_WAIT_V(0);
    if constexpr (!ALIGN_EPI) { if (wr == 0) PG8_BAR; }
    PG8_BAR;
    if constexpr (Epi::AFTER_DRAIN) { E.fused(acc, cur, wr, wc, fr, fq, lds, wid, lane); S.done(cur); }
#undef PG8_SA
#undef PG8_SB
#undef PG8_STAGE
#undef PG8_LDA
#undef PG8_LDB
#undef PG8_MMA
#undef PG8_WAIT_V
#undef PG8_WAIT_L
#undef PG8_BAR
#undef PG8_SCHED
}
}


DI void gates_gemm(const bf16_t* H, const bf16_t* WgT  , float* GL, const float* ss, bool upper_half_only) {
    const int tid_ = opaque_tid(); const int lane = tid_ & 63, wid = tid_ >> 6, r32 = lane & 31, hi = lane >> 5;
    const int nb = (upper_half_only && gridDim.x >= 256) ? (int)gridDim.x - 128 : (int)gridDim.x, b0 = (int)gridDim.x - nb;
    if ((int)blockIdx.x < b0) return;
    for (int u = ((int)blockIdx.x - b0) + nb * wid; u < NT / 32; u += nb * 8) {
        const bf16_t* ap = H + (size_t)(u * 32 + r32) * DM + hi * 8; const bf16_t* bp = WgT + (size_t)r32 * DM + hi * 8;
        f32x16 acc;
#pragma unroll
        for (int i = 0; i < 16; ++i) acc[i] = 0.f;
#pragma unroll 8
        for (int k = 0; k < DM; k += 16) acc = __builtin_amdgcn_mfma_f32_32x32x16_bf16(*(const bf16x8*)(ap + k), *(const bf16x8*)(bp + k), acc, 0, 0, 0);
#pragma unroll
        for (int i = 0; i < 16; ++i) { const int row = u * 32 + (i & 3) + 8 * (i >> 2) + 4 * hi; const float rs = ss ? rsqrtf(ss[row] * (1.f / 1024) + EPS) : 1.f; GL[(size_t)row * 32 + r32] = acc[i] * rs; }
    }
}

DI float log_sigmoid_(float x) { return fminf(x, 0.f) - log1pf(__expf(-fabsf(x))); }
DI void prep_cumsum(const Args& a, int l, float* LS) {
    const float* GL = (const float*)(a.ws + WS_GL); float* C2 = (float*)(a.ws + WS_C2);
    const int tid = opaque_tid(), lane = tid & 63, wid = tid >> 6;
    for (int b = blockIdx.x; b < NB; b += gridDim.x) {
        __syncthreads();
#pragma unroll
        for (int i = 0; i < 4; ++i) {
            const int t = tid + 512 * i;
            const f32x4 v0 = *(const f32x4*)(GL + (size_t)(b * SEQ + t) * 32 + 24), v1 = *(const f32x4*)(GL + (size_t)(b * SEQ + t) * 32 + 28);
#pragma unroll
            for (int h = 0; h < 4; ++h) { LS[h * 2112 + (t >> 5) * 33 + (t & 31)] = log_sigmoid_(v0[h] + a.in[I_FFB][l * 8 + h]); LS[(h + 4) * 2112 + (t >> 5) * 33 + (t & 31)] = log_sigmoid_(v1[h] + a.in[I_FFB][l * 8 + 4 + h]); }
        }
        __syncthreads();
        {   float* row = LS + wid * 2112 + lane * 33;
            float tot = 0.f;
            for (int k = 0; k < 32; ++k) tot += row[k];
            float inc = tot;
#pragma unroll
            for (int o = 1; o < 64; o <<= 1) { const float n = __shfl_up(inc, o); if (lane >= o) inc += n; }
            float run = inc - tot;
            for (int k = 0; k < 32; ++k) { run += row[k]; row[k] = run * LOG2E; }
        }
        __syncthreads();
#pragma unroll
        for (int i = 0; i < 4; ++i) { const int t = tid + 512 * i;
#pragma unroll
            for (int h = 0; h < 8; ++h) C2[(size_t)(b * 8 + h) * SEQ + t] = LS[h * 2112 + (t >> 5) * 33 + (t & 31)]; }
    }
    __syncthreads();
}
DI void prep_compress(const Args& a, int l, const bf16_t* P) {
    unsigned char* ws = a.ws;
    const int tid_ = opaque_tid(); const int lane = tid_ & 63, wid = tid_ >> 6, fr = lane & 15, fq = lane >> 4;
    const int nbk = gridDim.x > 32 ? (int)gridDim.x - 16 : (int)gridDim.x, bk0 = (int)gridDim.x - nbk;
    if ((int)blockIdx.x < bk0) return;
    for (int it = ((int)blockIdx.x - bk0) + nbk * wid; it < NB * 2 * 2 * 8; it += nbk * 8) {
        const int nq = it & 7, kv = (it >> 3) & 1, g = (it >> 4) & 1, b = it >> 5;
        const int n = 16 * nq + fr; const bool ok = n < 127;
        const bf16_t* src = P + (size_t)(b * SEQ + (ok ? 16 * n : 0)) * PP + (kv ? C_VC : C_KC) + g * 64 + fq * 8;
        const bf16_t* W = (const bf16_t*)(ws + (kv ? WS_WCV : WS_WCK)) + (size_t)l * 131072 + (size_t)fr * 2048 + fq * 8;
        f32x4 acc[4];
#pragma unroll
        for (int nt = 0; nt < 4; ++nt) acc[nt] = (f32x4){0.f, 0.f, 0.f, 0.f};
#pragma unroll 4
        for (int ks = 0; ks < 64; ++ks) {
            bf16x8 af = *(const bf16x8*)(src + (size_t)(ks >> 1) * PP + (ks & 1) * 32);
            if (!ok) af = (bf16x8){0, 0, 0, 0, 0, 0, 0, 0};
#pragma unroll
            for (int nt = 0; nt < 4; ++nt) { const bf16x8 bw = *(const bf16x8*)(W + (size_t)nt * 16 * 2048 + ks * 32); acc[nt] = __builtin_amdgcn_mfma_f32_16x16x32_bf16(af, bw, acc[nt], 0, 0, 0); }
        }
        const float* bias = (const float*)(ws + WS_BKV) + (l * 2 + kv) * 64;
        float v[4][4];
#pragma unroll
        for (int nt = 0; nt < 4; ++nt)
#pragma unroll
            for (int i = 0; i < 4; ++i) v[nt][i] = acc[nt][i] + bias[16 * nt + fr];
        bf16_t* out = (bf16_t*)(ws + (kv ? WS_VCMP : WS_KCMP)) + (size_t)(b * 2 + g) * 128 * 64;
#pragma unroll
        for (int i = 0; i < 4; ++i) {
            const int row = 16 * nq + 4 * fq + i;
            float sc = 1.f;
            if (kv == 0) { float ss = v[0][i] * v[0][i] + v[1][i] * v[1][i] + v[2][i] * v[2][i] + v[3][i] * v[3][i];
                ss += __shfl_xor(ss, 1); ss += __shfl_xor(ss, 2); ss += __shfl_xor(ss, 4); ss += __shfl_xor(ss, 8); sc = rsqrtf(ss * (1.f / 64) + EPS); }
#pragma unroll
            for (int nt = 0; nt < 4; ++nt) { const int e = 16 * nt + fr; float o = v[nt][i] * sc; if (kv == 0) o *= a.in[I_NKG][(l * 3 + 0) * 64 + e]; if (row >= 127) o = 0.f;
                out[(size_t)row * 64 + e] = (bf16_t)f2bf(o); }
        }
    }
}


constexpr int A_KB = 0, A_VB = 18432, A_CB = A_VB + 16384, A_IG = A_CB + 512, A_IL = A_IG + 33792, A_SELM = A_IL + 33792, A_UN = A_SELM + 256, A_UNIT = A_UN + 16, A_SC = A_UNIT + 16, A_KG = A_SC + 2048, A_END = A_KG + 512;
static_assert(A_END <= LDS_BYTES, "attention LDS map");
struct ACtx { int r32, hi, tid, tok; bf16x8 qr[4]; };
typedef float f32x2_t __attribute__((ext_vector_type(2))); typedef __bf16 bf16x2_t __attribute__((ext_vector_type(2)));
typedef short v4i16_t __attribute__((ext_vector_type(4)));
#define LAS3 __attribute__((address_space(3)))
DI unsigned cvtpk(float lo, float hi) { f32x2_t v = {lo, hi}; bf16x2_t bb = __builtin_convertvector(v, bf16x2_t); return __builtin_bit_cast(unsigned, bb); }
DI v4i16_t vtr(const LAS3 unsigned char* p) { return __builtin_amdgcn_ds_read_tr16_b64_v4i16((LAS3 v4i16_t*)p); }

DI void load_q(ACtx& x, const bf16_t* qrow) {
#pragma unroll
    for (int d0 = 0; d0 < 4; ++d0) x.qr[d0] = *(const bf16x8*)(qrow + d0 * 16 + x.hi * 8);
}

template <int MODE, bool ONLINE>
DI void attn_tile_compute(const unsigned char* lds, int cur, int j, const ACtx& x, unsigned selm, int cblk, int wtokmin, float bref, float ctb, f32x16 (&oT)[2], float& m, float& l) {
    const bf16_t* KB = (const bf16_t*)(lds + A_KB) + cur * 4608;
    const int lane = x.tid & 63;
    f32x16 p0, p1;
    if (MODE == 3) {
        const float* CB = (const float*)(lds + A_CB) + cur * 64 + 4 * x.hi;
#pragma unroll
        for (int q = 0; q < 4; ++q) { const f32x4 c0 = *(const f32x4*)(CB + 8 * q), c1 = *(const f32x4*)(CB + 32 + 8 * q);
#pragma unroll
            for (int i = 0; i < 4; ++i) { p0[4 * q + i] = (ONLINE ? 0.f : ctb) - c0[i]; p1[4 * q + i] = (ONLINE ? 0.f : ctb) - c1[i]; } }
    } else {
#pragma unroll
        for (int i = 0; i < 16; ++i) { p0[i] = ONLINE ? 0.f : -bref; p1[i] = ONLINE ? 0.f : -bref; }
    }
#pragma unroll
    for (int d0 = 0; d0 < 4; ++d0) {
        const bf16x8 k0 = *(const bf16x8*)(KB + x.r32 * 72 + d0 * 16 + x.hi * 8);
        const bf16x8 k1 = *(const bf16x8*)(KB + (32 + x.r32) * 72 + d0 * 16 + x.hi * 8);
        p0 = __builtin_amdgcn_mfma_f32_32x32x16_bf16(k0, x.qr[d0], p0, 0, 0, 0);
        p1 = __builtin_amdgcn_mfma_f32_32x32x16_bf16(k1, x.qr[d0], p1, 0, 0, 0);
    }
    const float NEG = -INFINITY;
    const int kb = 64 * j + 4 * x.hi;
#define KK(r) (kb + ((r) & 3) + 8 * ((r) >> 2))
    if (MODE == 3) {
        if (64 * j + 63 > wtokmin) {
#pragma unroll
            for (int r = 0; r < 16; ++r) { const int kk = KK(r); if (kk > x.tok) p0[r] = NEG; if (kk + 32 > x.tok) p1[r] = NEG; }
        }
    } else if (MODE == 0) {
#pragma unroll
        for (int r = 0; r < 16; ++r) { const int n = KK(r); if (16 * n + 31 > x.tok) p0[r] = NEG; if (16 * (n + 32) + 31 > x.tok) p1[r] = NEG; }
    } else if (MODE == 1) {
        const bool on = (selm >> j) & 1u;
        const bool allon = __ballot(on) == ~0ull;
        if (j == cblk) {
#pragma unroll
            for (int r = 0; r < 16; ++r) { const int kk = KK(r); if (!on || kk > x.tok) p0[r] = NEG; if (!on || kk + 32 > x.tok) p1[r] = NEG; }
        } else if (!allon) {
#pragma unroll
            for (int r = 0; r < 16; ++r) { if (!on) { p0[r] = NEG; p1[r] = NEG; } }
        }
    } else {
        if (j == cblk) {
#pragma unroll
            for (int r = 0; r < 16; ++r) { const int kk = KK(r); if (kk > x.tok) p0[r] = NEG; if (kk + 32 > x.tok) p1[r] = NEG; }
        } else if (j == cblk - 8) {
#pragma unroll
            for (int r = 0; r < 16; ++r) { const int kk = KK(r); if (x.tok - kk >= 512) p0[r] = NEG; if (x.tok - kk - 32 >= 512) p1[r] = NEG; }
        }
    }
#undef KK
    if (ONLINE) {
        float mx = fmaxf(p0[0], p1[0]);
#pragma unroll
        for (int r = 1; r < 16; ++r) mx = fmaxf(mx, fmaxf(p0[r], p1[r]));
        mx = fmaxf(mx, __shfl_xor(mx, 32));
        const float mn = fmaxf(m, mx);
        if (__any(mn > m)) {
            const float sc = __builtin_amdgcn_exp2f(m - mn); l *= sc;
#pragma unroll
            for (int r = 0; r < 16; ++r) { oT[0][r] *= sc; oT[1][r] *= sc; }
        }
        m = mn;
#pragma unroll
        for (int r = 0; r < 16; ++r) { p0[r] -= mn; p1[r] -= mn; }
    }
    f32x2_t ls2 = {0.f, 0.f};
#pragma unroll
    for (int r = 0; r < 16; r += 2) { p0[r] = __builtin_amdgcn_exp2f(p0[r]); p0[r + 1] = __builtin_amdgcn_exp2f(p0[r + 1]); p1[r] = __builtin_amdgcn_exp2f(p1[r]); p1[r + 1] = __builtin_amdgcn_exp2f(p1[r + 1]);
        ls2 += (f32x2_t){p0[r], p0[r + 1]}; ls2 += (f32x2_t){p1[r], p1[r + 1]}; }
    l += ls2[0] + ls2[1];
    bf16x8 pf[4];
#pragma unroll
    for (int s = 0; s < 2; ++s) {
        u32x4 a0, a1;
#pragma unroll
        for (int i = 0; i < 4; ++i) { a0[i] = cvtpk(p0[8 * s + 2 * i], p0[8 * s + 2 * i + 1]); a1[i] = cvtpk(p1[8 * s + 2 * i], p1[8 * s + 2 * i + 1]); }
        pf[s] = __builtin_bit_cast(bf16x8, a0); pf[2 + s] = __builtin_bit_cast(bf16x8, a1);
    }
    const LAS3 unsigned char* vp = (const LAS3 unsigned char*)(lds + A_VB) + cur * 8192 + ((lane >> 4) & 1) * 32 + (lane & 3) * 8 + (4 * x.hi + ((lane & 15) >> 2)) * 64;
#pragma unroll
    for (int dh = 0; dh < 2; ++dh)
#pragma unroll
        for (int ks = 0; ks < 4; ++ks) {
            const v4i16_t lo = vtr(vp + dh * 4096 + ks * 1024), hi4 = vtr(vp + dh * 4096 + ks * 1024 + 512);
            const bf16x8 vf = (bf16x8){lo[0], lo[1], lo[2], lo[3], hi4[0], hi4[1], hi4[2], hi4[3]};
            oT[dh] = __builtin_amdgcn_mfma_f32_32x32x16_bf16(vf, pf[ks], oT[dh], 0, 0, 0);
        }
}

template <int MODE, bool ONLINE>
DI void attn_branch(unsigned char* lds, const bf16_t* Kg, int kp, const bf16_t* Vg, int vp, const float* Cg, int kgofs, unsigned tiles,
                    const ACtx& x, unsigned selm, int cblk, int wtokmin, int wtokmax, float bref, float ctb, f32x16 (&oT)[2], float& m, float& l) {
    const int tid = x.tid, srow = tid >> 3, sc8 = tid & 7;
    bf16_t* KB = (bf16_t*)(lds + A_KB); unsigned char* VB = lds + A_VB; float* CB = (float*)(lds + A_CB);
    const int kofs = srow * 72 + sc8 * 8, vofs = ((sc8 >> 2) * 4 + (srow >> 4)) * 1024 + (srow & 15) * 64 + (sc8 & 3) * 16;
    unsigned rem = tiles; if (!rem) return;
    u32x4 krA, vrA, krB, vrB; f32x4 crA = {0.f, 0.f, 0.f, 0.f}, crB = {0.f, 0.f, 0.f, 0.f};
#define POP(jv) do { jv = -1; if (rem) { jv = __builtin_ctz(rem); rem &= rem - 1; } } while (0)
#define LOADT(jj, kr, vr, cr) do { kr = *(const u32x4*)(Kg + (size_t)(64 * (jj) + srow) * kp + sc8 * 8); vr = *(const u32x4*)(Vg + (size_t)(64 * (jj) + srow) * vp + sc8 * 8); \
        if (MODE == 3 && tid < 16) cr = *(const f32x4*)(Cg + 64 * (jj) + tid * 4); } while (0)
#define STORET(buf, kr, vr, cr) do { *(u32x4*)(KB + (buf) * 4608 + kofs) = kr; *(u32x4*)(VB + (buf) * 8192 + vofs) = vr; if (MODE == 3 && tid < 16) *(f32x4*)(CB + (buf) * 64 + tid * 4) = cr; } while (0)
#define ACTIVE(jj) ((MODE == 1) ? (__ballot((selm >> (jj)) & 1u) != 0ull) : ((MODE == 3) ? (64 * (jj) <= wtokmax) : true))
    int j0, j1, j2, j3;
    POP(j0); LOADT(j0, krA, vrA, crA); STORET(0, krA, vrA, crA);
    POP(j1); if (j1 >= 0) LOADT(j1, krA, vrA, crA);
    __syncthreads();
    int cur = 0;
    for (;;) {
        POP(j2); if (j2 >= 0) LOADT(j2, krB, vrB, crB);
        if (ACTIVE(j0)) attn_tile_compute<MODE, ONLINE>(lds, cur, j0, x, selm, cblk, wtokmin, bref, ctb, oT, m, l);
        if (j1 >= 0) STORET(cur ^ 1, krA, vrA, crA);
        __syncthreads();
        if (j1 < 0) break;
        cur ^= 1;
        POP(j3); if (j3 >= 0) LOADT(j3, krA, vrA, crA);
        if (ACTIVE(j1)) attn_tile_compute<MODE, ONLINE>(lds, cur, j1, x, selm, cblk, wtokmin, bref, ctb, oT, m, l);
        if (j2 >= 0) STORET(cur ^ 1, krB, vrB, crB);
        __syncthreads();
        if (j2 < 0) break;
        cur ^= 1; j0 = j2; j1 = j3;
    }
#undef POP
#undef ACTIVE
#undef LOADT
#undef STORET
}
DI void zero_o(f32x16 (&oT)[2]) {
#pragma unroll
    for (int r = 0; r < 16; ++r) { oT[0][r] = 0.f; oT[1][r] = 0.f; }
}

template <bool ONLINE> DI void nsa_unit(const Args& a, int l, unsigned char* lds, int b, int g, int c) {
    unsigned char* ws = a.ws;
    const bf16_t* P = (const bf16_t*)(ws + WS_P); bf16_t* Y = (bf16_t*)(ws + WS_HY); const float* GL = (const float*)(ws + WS_GL);
    ACtx x; x.tid = threadIdx.x; asm volatile("" : "+v"(x.tid));
    const int lane = x.tid & 63, wid = __builtin_amdgcn_readfirstlane(x.tid >> 6); x.r32 = lane & 31; x.hi = lane >> 5;
    const int hq = 4 * g + (wid & 3), tokl = 32 * (wid >> 2) + x.r32; x.tok = 64 * c + tokl;
    const size_t row = (size_t)(b * SEQ + x.tok);
    load_q(x, P + row * PP + C_NQ + hq * 64);
#define GATE(k) sigmoidf_(GL[row * 32 + hq * 3 + (k)] + a.in[I_GB][l * 24 + hq * 3 + (k)])
    float* IG = (float*)(lds + A_IG); float* IL = (float*)(lds + A_IL); unsigned* SELM = (unsigned*)(lds + A_SELM); unsigned* UN = (unsigned*)(lds + A_UN);
    if (x.tid == 0) UN[0] = 0u;
    f32x16 oT[2], tot[2]; zero_o(oT); zero_o(tot);
    float m = -1e30f, ls = 0.f;
    const float* bnd = (const float*)(ws + WS_BND) + l * 4;
    const float b_cmp = bnd[0], b_slc = bnd[1], b_win = bnd[2];
    constexpr bool online = ONLINE;
#define BRANCH(MODE, ...) do { attn_branch<MODE, ONLINE>(__VA_ARGS__); } while (0)
    const bf16_t* KC = (const bf16_t*)(ws + WS_KCMP) + (size_t)(b * 2 + g) * 128 * 64; const bf16_t* VC = (const bf16_t*)(ws + WS_VCMP) + (size_t)(b * 2 + g) * 128 * 64;
    const int ncmpt = c >= 16 ? 2 : 1;
    BRANCH(0, lds, KC, 64, VC, 64, nullptr, 0, c >= 16 ? 3u : 1u, x, 0u, c, 0, 0, b_cmp, 0.f, oT, m, ls);
    const float cref = online ? m : b_cmp;
    {   float lt = ls + __shfl_xor(ls, 32); const float inv = lt > 0.f ? 1.f / lt : 0.f; const float g0 = GATE(0);
#pragma unroll
        for (int r = 0; r < 16; ++r) { tot[0][r] = oT[0][r] * (inv * g0); tot[1][r] = oT[1][r] * (inv * g0); }
        for (int tt = 0; tt < ncmpt; ++tt) {
            const bf16_t* KB = (const bf16_t*)(lds + A_KB) + tt * 4608;
            f32x16 p0, p1;
#pragma unroll
            for (int i = 0; i < 16; ++i) { p0[i] = -cref; p1[i] = -cref; }
#pragma unroll
            for (int d0 = 0; d0 < 4; ++d0) {
                const bf16x8 k0 = *(const bf16x8*)(KB + x.r32 * 72 + d0 * 16 + x.hi * 8); const bf16x8 k1 = *(const bf16x8*)(KB + (32 + x.r32) * 72 + d0 * 16 + x.hi * 8);
                p0 = __builtin_amdgcn_mfma_f32_32x32x16_bf16(k0, x.qr[d0], p0, 0, 0, 0); p1 = __builtin_amdgcn_mfma_f32_32x32x16_bf16(k1, x.qr[d0], p1, 0, 0, 0);
            }
            const int kb = 64 * tt + 4 * x.hi;
#pragma unroll
            for (int r = 0; r < 16; ++r) { const int n = kb + (r & 3) + 8 * (r >> 2);
                p0[r] = (16 * n + 31 <= x.tok) ? __builtin_amdgcn_exp2f(p0[r]) * inv : 0.f; p1[r] = (16 * (n + 32) + 31 <= x.tok) ? __builtin_amdgcn_exp2f(p1[r]) * inv : 0.f; }
            float* ig = IG + ((wid & 3) * 64 + tokl) * 33; float* il = IL + ((wid & 3) * 64 + tokl) * 33;
#pragma unroll
            for (int q = 0; q < 4; ++q) { const int jj = 16 * tt + 2 * q + x.hi;
                ig[jj] = p0[4 * q] + p0[4 * q + 1] + p0[4 * q + 2] + p0[4 * q + 3]; il[jj] = p0[4 * q + 3];
                ig[jj + 8] = p1[4 * q] + p1[4 * q + 1] + p1[4 * q + 2] + p1[4 * q + 3]; il[jj + 8] = p1[4 * q + 3]; }
        }
    }
    __syncthreads();
    {   int j = lane & 31; asm volatile("" : "+v"(j));
        unsigned wor = 0u;
#pragma unroll
        for (int it = 0; it < 4; ++it) {
            const int tl = 8 * wid + 2 * it + (lane >> 5);
            float imp = 0.f;
#pragma unroll
            for (int h4 = 0; h4 < 4; ++h4) { imp += IG[(h4 * 64 + tl) * 33 + j]; if (j > 0) imp += IL[(h4 * 64 + tl) * 33 + j - 1]; }
            const bool valid = j <= c, forced = (j == 0) || (j == c) || (j == c - 1);
            const float score = !valid ? -1e30f : (forced ? 1e9f : imp);
            float* scw = (float*)(lds + A_SC) + wid * 64;
            scw[lane] = score;
            __builtin_amdgcn_s_waitcnt(0xc07f); __builtin_amdgcn_wave_barrier();
            int rank = 0;
#pragma unroll
            for (int k4 = 0; k4 < 8; ++k4) { const f32x4 sk = *(const f32x4*)(scw + (lane & 32) + 4 * k4);
#pragma unroll
                for (int i = 0; i < 4; ++i) rank += (sk[i] > score) || (sk[i] == score && 4 * k4 + i < j); }
            __builtin_amdgcn_wave_barrier();
            const unsigned long long bal = __ballot(valid && rank < 16);
            const unsigned mine = (lane >> 5) ? (unsigned)(bal >> 32) : (unsigned)bal;
            if (j == 0) SELM[tl] = mine;
            wor |= (unsigned)bal | (unsigned)(bal >> 32);
        }
        if (lane == 0) atomicOr(UN, wor);
    }
    __syncthreads();
    const unsigned selm = SELM[tokl]; const unsigned un = UN[0];
    float* TOT = (float*)(lds + A_IG) + wid * 2048 + lane;
#pragma unroll
    for (int r = 0; r < 16; ++r) { TOT[r * 64] = tot[0][r]; TOT[(16 + r) * 64] = tot[1][r]; }
    zero_o(oT); m = -1e30f; ls = 0.f;
    BRANCH(1, lds, P + (size_t)b * SEQ * PP + C_KS + g * 64, PP, P + (size_t)b * SEQ * PP + C_VS + g * 64, PP, nullptr, 0, un, x, selm, c, 0, 0, b_slc, 0.f, oT, m, ls);
    {   float lt = ls + __shfl_xor(ls, 32); const float inv = lt > 0.f ? GATE(1) / lt : 0.f;
#pragma unroll
        for (int r = 0; r < 16; ++r) { TOT[r * 64] += oT[0][r] * inv; TOT[(16 + r) * 64] += oT[1][r] * inv; } }
    zero_o(oT); m = -1e30f; ls = 0.f;
    {   const int jlo = c >= 8 ? c - 8 : 0; const unsigned wt = (c >= 31 ? 0xffffffffu : ((1u << (c + 1)) - 1u)) & ~((1u << jlo) - 1u);
        BRANCH(2, lds, P + (size_t)b * SEQ * PP + C_KW + g * 64, PP, P + (size_t)b * SEQ * PP + C_VW + g * 64, PP, nullptr, 64, wt, x, 0u, c, 0, 0, b_win, 0.f, oT, m, ls); }
    {   float lt = ls + __shfl_xor(ls, 32); const float inv = lt > 0.f ? GATE(2) / lt : 0.f;
#pragma unroll
        for (int r = 0; r < 16; ++r) { tot[0][r] = TOT[r * 64] + oT[0][r] * inv; tot[1][r] = TOT[(16 + r) * 64] + oT[1][r] * inv; } }
#pragma unroll
    for (int dh = 0; dh < 2; ++dh)
#pragma unroll
        for (int q = 0; q < 4; ++q) {
            const int d = 32 * dh + 8 * q + 4 * x.hi;
            const u32x2 zz = *(const u32x2*)(P + row * PP + C_NZ + hq * 64 + d);
            const float z0 = bf2f(zz[0] & 0xffffu), z1 = bf2f(zz[0] >> 16), z2 = bf2f(zz[1] & 0xffffu), z3 = bf2f(zz[1] >> 16);
            u32x2 o; o[0] = cvtpk(tot[dh][4 * q] * siluf_(z0), tot[dh][4 * q + 1] * siluf_(z1)); o[1] = cvtpk(tot[dh][4 * q + 2] * siluf_(z2), tot[dh][4 * q + 3] * siluf_(z3));
            *(u32x2*)(Y + row * DMIX + 512 + hq * 64 + d) = o;
        }
}

template <bool ONLINE> DI void fox_unit(const Args& a, int l, unsigned char* lds, int b, int h, int c) {
    unsigned char* ws = a.ws;
    const bf16_t* P = (const bf16_t*)(ws + WS_P); bf16_t* Y = (bf16_t*)(ws + WS_HY);
    ACtx x; x.tid = threadIdx.x; asm volatile("" : "+v"(x.tid));
    const int lane = x.tid & 63, wid = __builtin_amdgcn_readfirstlane(x.tid >> 6); x.r32 = lane & 31; x.hi = lane >> 5;
    x.tok = 256 * c + 32 * wid + x.r32;
    const size_t row = (size_t)(b * SEQ + x.tok);
    load_q(x, P + row * PP + C_FQ + h * 64);
    const float* c2 = (const float*)(ws + WS_C2) + (size_t)(b * 8 + h) * SEQ;
    f32x16 oT[2]; zero_o(oT); float m = -1e30f, ls = 0.f;
    const int ntile = 4 * c + 4; const unsigned tiles = ntile >= 32 ? 0xffffffffu : ((1u << ntile) - 1u);
    unsigned tiles_ = tiles;
    if (!ONLINE) {
        const float cj = c2[64 * (lane & 31) + 63], c0 = c2[256 * c];
        tiles_ &= ~(unsigned)__ballot((lane < 32) && (c0 - cj <= -152.f));
    }
    const float b_fox = ((const float*)(ws + WS_BND))[l * 4 + 3]; const float ctb = c2[x.tok] - b_fox;
    attn_branch<3, ONLINE>(lds, P + (size_t)b * SEQ * PP + C_FK + h * 64, PP, P + (size_t)b * SEQ * PP + C_FV + h * 64, PP, c2, 0, tiles_, x, 0u, 0, 256 * c + 32 * wid, 256 * c + 32 * wid + 31, b_fox, ctb, oT, m, ls);
    float lt = ls + __shfl_xor(ls, 32); const float inv = lt > 0.f ? 1.f / lt : 0.f;
#pragma unroll
    for (int dh = 0; dh < 2; ++dh)
#pragma unroll
        for (int q = 0; q < 4; ++q) {
            const int d = 32 * dh + 8 * q + 4 * x.hi;
            const u32x2 zz = *(const u32x2*)(P + row * PP + C_FZ + h * 64 + d);
            const float z0 = bf2f(zz[0] & 0xffffu), z1 = bf2f(zz[0] >> 16), z2 = bf2f(zz[1] & 0xffffu), z3 = bf2f(zz[1] >> 16);
            u32x2 o; o[0] = cvtpk(oT[dh][4 * q] * inv * siluf_(z0), oT[dh][4 * q + 1] * inv * siluf_(z1)); o[1] = cvtpk(oT[dh][4 * q + 2] * inv * siluf_(z2), oT[dh][4 * q + 3] * inv * siluf_(z3));
            *(u32x2*)(Y + row * DMIX + 1024 + h * 64 + d) = o;
        }
}


constexpr int L_WA = 0, L_WX = 9216, L_XB = 18432, L_XF = 27648, L_G = 44032, L_SA = L_G + 2 * 64 * 65 * 4, L_SB = L_SA + 2048, L_CY = L_SB + 2048, L_END = L_CY + 512;
static_assert(L_END <= LDS_BYTES, "LRU LDS map");
DI float fsig(float x) { return __builtin_amdgcn_rcpf(1.f + __expf(-x)); }
DI float neg_expm1(float x, float ex) {
    const float t = x * (1.f + x * (0.5f + x * (0.16666667f + x * (0.041666668f + x * (0.0083333338f + x * 0.0013888889f)))));
    return (x > -0.25f) ? -t : 1.f - ex;
}
DI void lru_unit(const Args& a, int l, unsigned char* lds, int b, int h) {
    unsigned char* ws = a.ws;
    const bf16_t* P = (const bf16_t*)(ws + WS_P); bf16_t* Y = (bf16_t*)(ws + WS_HY);
    int tid = threadIdx.x; asm volatile("" : "+v"(tid));
    const int lane = tid & 63, wid = __builtin_amdgcn_readfirstlane(tid >> 6);
    bf16_t* WAl = (bf16_t*)(lds + L_WA); bf16_t* WXl = (bf16_t*)(lds + L_WX); bf16_t* XB = (bf16_t*)(lds + L_XB);
    float* XF = (float*)(lds + L_XF); float* G = (float*)(lds + L_G); float* SA = (float*)(lds + L_SA); float* SB = (float*)(lds + L_SB); float* CY = (float*)(lds + L_CY);
    __syncthreads();
    {   const int r = tid >> 3, c8 = (tid & 7) * 8;
        *(u32x4*)(WAl + r * 72 + c8) = *(const u32x4*)((const bf16_t*)(ws + WS_WA) + (size_t)(l * 8 + h) * 4096 + r * 64 + c8);
        *(u32x4*)(WXl + r * 72 + c8) = *(const u32x4*)((const bf16_t*)(ws + WS_WX) + (size_t)(l * 8 + h) * 4096 + r * 64 + c8);
        if (tid < 128) CY[tid] = 0.f; }
    const int tk1 = tid >> 3, c8 = (tid & 7) * 8, chb = h * 64 + c8;
    float cw[4][8], cb8[8];
#pragma unroll
    for (int i = 0; i < 8; ++i) { cb8[i] = a.in[I_CB][l * 512 + chb + i];
#pragma unroll
        for (int k = 0; k < 4; ++k) cw[k][i] = a.in[I_CW][(l * 4 + k) * 512 + chb + i]; }
    const int ch = tid & 63, sg = tid >> 6, chg = h * 64 + ch;
    const float ba = a.in[I_BA][l * 512 + chg], bx = a.in[I_BX][l * 512 + chg], lam = a.in[I_LAM][l * 512 + chg];
    const float sp8 = -8.f * (fmaxf(-lam, 0.f) + log1pf(__expf(-fabsf(lam))));
    const int fr = lane & 15, fq = lane >> 4, mat = wid >> 2, strip = wid & 3;
    const bf16_t* pu = P + (size_t)b * SEQ * PP + C_U + chb;
    u32x4 ur[4];
#pragma unroll
    for (int k = 0; k < 4; ++k) { const int t = tk1 - 3 + k; ur[k] = (t >= 0) ? *(const u32x4*)(pu + (size_t)t * PP) : (u32x4){0u, 0u, 0u, 0u}; }
    for (int tile = 0; tile < SEQ / 64; ++tile) {
        const int t0 = tile * 64;
        {   float xc[8];
#pragma unroll
            for (int i = 0; i < 8; ++i) xc[i] = cb8[i];
#pragma unroll
            for (int k = 0; k < 4; ++k) { float uf[8]; unpack8(ur[k], uf);
#pragma unroll
                for (int i = 0; i < 8; ++i) xc[i] += cw[k][i] * uf[i]; }
            *(f32x4*)(XF + tk1 * 64 + c8) = (f32x4){xc[0], xc[1], xc[2], xc[3]}; *(f32x4*)(XF + tk1 * 64 + c8 + 4) = (f32x4){xc[4], xc[5], xc[6], xc[7]};
            u32x4 pk; pk[0] = pk2(xc[0], xc[1]); pk[1] = pk2(xc[2], xc[3]); pk[2] = pk2(xc[4], xc[5]); pk[3] = pk2(xc[6], xc[7]);
            *(u32x4*)(XB + tk1 * 72 + c8) = pk;
            if (tile + 1 < SEQ / 64) {
#pragma unroll
                for (int k = 0; k < 4; ++k) ur[k] = *(const u32x4*)(pu + (size_t)(t0 + 64 + tk1 - 3 + k) * PP);
            }
        }
        __syncthreads();
        {   const bf16_t* W = mat ? WXl : WAl;
            f32x4 acc[4];
#pragma unroll
            for (int nt = 0; nt < 4; ++nt) acc[nt] = (f32x4){0.f, 0.f, 0.f, 0.f};
#pragma unroll
            for (int ks = 0; ks < 2; ++ks) {
                const bf16x8 af = *(const bf16x8*)(XB + (16 * strip + fr) * 72 + ks * 32 + fq * 8);
#pragma unroll
                for (int nt = 0; nt < 4; ++nt) { const bf16x8 bw = *(const bf16x8*)(W + (16 * nt + fr) * 72 + ks * 32 + fq * 8); acc[nt] = __builtin_amdgcn_mfma_f32_16x16x32_bf16(af, bw, acc[nt], 0, 0, 0); }
            }
            float* Gm = G + mat * 64 * 65;
#pragma unroll
            for (int nt = 0; nt < 4; ++nt)
#pragma unroll
                for (int i = 0; i < 4; ++i) Gm[(16 * strip + 4 * fq + i) * 65 + 16 * nt + fr] = acc[nt][i];
        }
        __syncthreads();
        {   const bf16_t* pz = P + (size_t)(b * SEQ + t0 + sg * 8) * PP + C_Z + chg;
            bf16_t zr[8];
#pragma unroll
            for (int k = 0; k < 8; ++k) zr[k] = pz[(size_t)k * PP];
            float av[8], bv[8]; float A = 1.f, Bc = 0.f;
#pragma unroll
            for (int k = 0; k < 8; ++k) {
                const int tk = sg * 8 + k;
                const float r = fsig(G[tk * 65 + ch] + ba), ig = fsig(G[64 * 65 + tk * 65 + ch] + bx), xcv = XF[tk * 64 + ch];
                const float la = r * sp8;
                av[k] = __expf(la); bv[k] = sqrtf(neg_expm1(2.f * la, av[k] * av[k])) * (ig * xcv);
                Bc = av[k] * Bc + bv[k]; A *= av[k];
            }
            SA[sg * 64 + ch] = A; SB[sg * 64 + ch] = Bc;
            __syncthreads();
            float hs = CY[(tile & 1) * 64 + ch];
            for (int s = 0; s < sg; ++s) hs = SA[s * 64 + ch] * hs + SB[s * 64 + ch];
            bf16_t* py = Y + (size_t)(b * SEQ + t0 + sg * 8) * DMIX + chg;
#pragma unroll
            for (int k = 0; k < 8; ++k) { hs = av[k] * hs + bv[k]; const float zf = bf2f(zr[k]); py[(size_t)k * DMIX] = (bf16_t)f2bf(hs * zf * fsig(zf)); }
            if (sg == 7) CY[((tile & 1) ^ 1) * 64 + ch] = hs;
        }
    }
    __syncthreads();
}


template <bool ONLINE> DI void phase_mix(const Args& a, int l, unsigned char* lds, int cofs = 0, bool only_lru = false) {
    unsigned* ctr = (unsigned*)(a.ws + WS_CTL) + l * 16 + cofs;
    volatile int* UNIT = (volatile int*)(lds + A_UNIT);
    if (blockIdx.x < 128) lru_unit(a, l, lds, blockIdx.x >> 3, blockIdx.x & 7);
    if (only_lru) return;
    __syncthreads();
    if (threadIdx.x == 0) UNIT[0] = (int)atomicAdd(ctr, 1u);
    __syncthreads();
    for (int u = UNIT[0]; u < 1024; ) {
        int nxt = 0; if (threadIdx.x == 0) nxt = (int)atomicAdd(ctr, 1u);
        nsa_unit<ONLINE>(a, l, lds, (u & 31) >> 1, u & 1, 31 - (u >> 5));
        if (threadIdx.x == 0) UNIT[0] = nxt;
        __syncthreads();
        u = UNIT[0];
    }
    __syncthreads();
    if (threadIdx.x == 0) UNIT[0] = (int)atomicAdd(ctr + 1, 1u);
    __syncthreads();
    for (int u = UNIT[0]; u < 1024; ) {
        int nxt = 0; if (threadIdx.x == 0) nxt = (int)atomicAdd(ctr + 1, 1u);
        fox_unit<ONLINE>(a, l, lds, (u & 127) >> 3, u & 7, 7 - (u >> 7));
        if (threadIdx.x == 0) UNIT[0] = nxt;
        __syncthreads();
        u = UNIT[0];
    }
}

#define XB_TMO      128
#define XB_XCNT(j)  (256  + 64 * (j))
#define XB_XSUB(j)  (1280 + 64 * (j))
#define XB_XGEN(j)  (2304 + 64 * (j))
#define XB_TOP      3328
#define XB_TOPGEN   3392
#define XCD_BAR_WORDS 3456
#define XB_SPIN_CAP (1u << 18)
DI unsigned xb_ld(unsigned* p)              { return __hip_atomic_load(p, __ATOMIC_RELAXED, __HIP_MEMORY_SCOPE_AGENT); }
DI unsigned xb_add(unsigned* p, unsigned v) { return __hip_atomic_fetch_add(p, v, __ATOMIC_RELAXED, __HIP_MEMORY_SCOPE_AGENT); }
DI unsigned xb_xcc_id() { return (unsigned)__builtin_amdgcn_s_getreg((3 << 11) | 20) & 0xFu; }
#define XB_SPIN(cond, bar) do { unsigned _sp = 0; while (cond) { __builtin_amdgcn_s_sleep(1); \
    if ((++_sp & 255u) == 0u) { if (xb_ld(&(bar)[XB_TMO])) break; if (_sp > XB_SPIN_CAP) { atomicAdd(&(bar)[XB_TMO], 1u); break; } } } } while (0)
struct XcdBarrier { unsigned* bar; unsigned x; volatile LAS3 unsigned* st; };
DI XcdBarrier xcd_barrier_post(unsigned* bar, volatile LAS3 unsigned* st) {
    XcdBarrier b; b.bar = bar; b.x = xb_xcc_id(); b.st = st;
    if (threadIdx.x == 0) (void)xb_add(&bar[XB_XCNT(b.x)], 1u);
    return b;
}
DI void xcd_barrier_complete(unsigned* bar, unsigned x, unsigned& nloc, unsigned& nx) {
    const unsigned G = gridDim.x * gridDim.y * gridDim.z;
    unsigned sum, cnt, mine, sp = 0u;
    for (;;) {
        sum = 0u; cnt = 0u; mine = 0u;
#pragma unroll
        for (unsigned j = 0; j < 16; ++j) { const unsigned c = xb_ld(&bar[XB_XCNT(j)]); sum += c; cnt += (c > 0u) ? 1u : 0u; mine = (j == x) ? c : mine; }
        if (sum == G) break;
        __builtin_amdgcn_s_sleep(1);
        if ((++sp & 255u) == 0u) { if (xb_ld(&bar[XB_TMO])) break; if (sp > XB_SPIN_CAP) { atomicAdd(&bar[XB_TMO], 1u); break; } }
    }
    nloc = mine > 0u ? mine : 1u; nx = cnt > 0u ? cnt : 1u;
}
DI void xcd_barrier(const XcdBarrier& b) {
    asm volatile("s_waitcnt vmcnt(0)" ::: "memory");
    __syncthreads();
    if (threadIdx.x == 0) {
        unsigned* bar = b.bar;
        __builtin_amdgcn_s_waitcnt(0);
        unsigned nloc = b.st[0], nx = b.st[1];
        if (nloc == 0u) { xcd_barrier_complete(bar, b.x, nloc, nx); b.st[0] = nloc; b.st[1] = nx; }
        const unsigned old = xb_add(&bar[XB_XSUB(b.x)], 1u);
        const unsigned gen = old / nloc;
        if (old + 1u == (gen + 1u) * nloc) {
            __builtin_amdgcn_fence(__ATOMIC_RELEASE, "agent");
            asm volatile("s_waitcnt vmcnt(0)" ::: "memory");
            const unsigned og = xb_add(&bar[XB_TOP], 1u);
            const unsigned tg = og / nx;
            if (og + 1u == (tg + 1u) * nx) xb_add(&bar[XB_TOPGEN], 1u);
            else XB_SPIN(xb_ld(&bar[XB_TOPGEN]) == tg, bar);
            __builtin_amdgcn_fence(__ATOMIC_ACQUIRE, "agent");
            xb_add(&bar[XB_XGEN(b.x)], 1u);
            asm volatile("s_waitcnt vmcnt(0)" ::: "memory");
        } else {
            XB_SPIN(xb_ld(&bar[XB_XGEN(b.x)]) == gen, bar);
            __builtin_amdgcn_fence(__ATOMIC_ACQUIRE, "agent");
            asm volatile("s_waitcnt vmcnt(0)" ::: "memory");
        }
    }
    __syncthreads();
}

#ifndef DUP
#define DUP 0
#endif
#define LP_PTRS unsigned char* ws = a.ws; bf16_t* P = (bf16_t*)(ws + WS_P); bf16_t* HY = (bf16_t*)(ws + WS_HY); bf16_t* H = (bf16_t*)(ws + WS_H); float* SS = (float*)(ws + WS_SS); float* GL = (float*)(ws + WS_GL); const float* xin = L ? a.out : a.in[I_X]; (void)P; (void)HY; (void)H; (void)SS; (void)GL; (void)xin
template <int L> DI void layer_phases(const Args& a, const XcdBarrier& bar, unsigned char* lds) {
    {   LP_PTRS; const bf16_t* W = (const bf16_t*)(ws + WS_WIN) + (size_t)L * NPAD * DM;
        pg8::Gemm g{H, W, NT, PP, DM}; pg8::StaticOrder S; S.init(NT, PP, (int)gridDim.x, (int)blockIdx.x);
        pg8::EpiProjF E{P, L ? SS : nullptr, (PG8_LAS float*)((PG8_LAS unsigned char*)lds + pg8::STAGE_BYTES), (const float*)(ws + WS_GAINS) + L * 320}; pg8::gemm_phase<pg8::EpiProjF, pg8::StaticOrder, true, true>((PG8_LAS unsigned char*)lds, g, S, E);
        gates_gemm(H, W + (size_t)PP * DM, GL, L ? SS : nullptr, L == 1);
        if (L == 0) { __syncthreads(); win1_late(a, (float*)lds); }
        if (DUP == 2 && L == 0) { xcd_barrier(bar); pg8::gemm_phase<pg8::EpiProjF, pg8::StaticOrder, true, true>((PG8_LAS unsigned char*)lds, g, S, E); gates_gemm(H, W + (size_t)PP * DM, GL, L ? SS : nullptr, false); } }
    xcd_barrier(bar);
    {   LP_PTRS; prep_cumsum(a, L, (float*)lds); prep_compress(a, L, P); if (L == 0) { __syncthreads(); phase_wprep(a, (float*)lds, 1); }
        if (DUP == 3 && L == 0) { xcd_barrier(bar); prep_cumsum(a, L, (float*)lds); prep_compress(a, L, P); } }
    xcd_barrier(bar);
    {   const float* bnd = (const float*)(a.ws + WS_BND) + L * 4;
        const bool online = fmaxf(fmaxf(bnd[0], bnd[1]), fmaxf(bnd[2], bnd[3])) > 60.f;
        if (online) phase_mix<true>(a, L, lds); else phase_mix<false>(a, L, lds);
        if (DUP == 4 && L == 0) { xcd_barrier(bar); phase_mix<false>(a, L, lds, 4); } }
    xcd_barrier(bar);
    {   LP_PTRS; pg8::Gemm g{HY, (const bf16_t*)(ws + WS_WOUT) + (size_t)L * DM * DMIX, NT, DM, DMIX}; pg8::StaticOrder S; S.init(NT, DM, (int)gridDim.x, (int)blockIdx.x);
        pg8::EpiOutF E{L ? nullptr : a.in[I_X], L ? H : nullptr, L ? a.out : nullptr, L ? nullptr : H, SS}; pg8::gemm_phase<pg8::EpiOutF, pg8::StaticOrder, true, true>((PG8_LAS unsigned char*)lds, g, S, E); }
}
__global__ void __launch_bounds__(512, 2) mk(Args a) {
    extern __shared__ __attribute__((aligned(16))) unsigned char lds[];
    __shared__ unsigned xb_st[2];
    cg::grid_group grid = cg::this_grid();
    if (threadIdx.x < 2) xb_st[threadIdx.x] = 0u;
    __syncthreads();
    const XcdBarrier bar = xcd_barrier_post((unsigned*)(a.ws + WS_CTL + 1024), (volatile LAS3 unsigned*)xb_st);
    phase_wprep(a, (float*)lds, 0);
    phase_rms(a.in[I_X], a.in[I_NG], (bf16_t*)(a.ws + WS_H));
    for (int i = blockIdx.x * 512 + threadIdx.x; i < NT; i += gridDim.x * 512) ((float*)(a.ws + WS_SS))[i] = 0.f;
    if (a.ph_lo < 0) grid.sync();
    xcd_barrier(bar);
    layer_phases<0>(a, bar, lds);
    xcd_barrier(bar);
    layer_phases<1>(a, bar, lds);
}

extern "C" void kernel_launch(void* const* d_in, const int* in_sizes, int n_in, void* d_out, int out_size, void* d_ws, size_t ws_size, hipStream_t stream) {
    static int grid = 0;
    if (grid == 0) {
        if (n_in != 21 || ws_size < WS_END) { fprintf(stderr, "kernel_launch: unexpected n_in %d / ws_size %zu (need %zu)\n", n_in, ws_size, (size_t)WS_END); grid = -1; return; }
        int dev = 0, cus = 0, per_cu = 0;
        (void)hipGetDevice(&dev); (void)hipDeviceGetAttribute(&cus, hipDeviceAttributeMultiprocessorCount, dev);
        (void)hipFuncSetAttribute((const void*)mk, hipFuncAttributeMaxDynamicSharedMemorySize, LDS_BYTES);
        (void)hipOccupancyMaxActiveBlocksPerMultiprocessor(&per_cu, (const void*)mk, 512, LDS_BYTES);
        if (per_cu < 1) { fprintf(stderr, "kernel_launch: occupancy query says %d blocks/CU\n", per_cu); per_cu = 1; }
        if (per_cu > 1) per_cu = 1;
        grid = cus * per_cu;
        (void)hipGetLastError();
    }
    if (grid < 0) return;
    if (hipMemsetAsync((char*)d_ws + WS_CTL, 0, WS_CTL_BYTES, stream) != hipSuccess) { fprintf(stderr, "kernel_launch: memset failed\n"); return; }
    Args a{};
    for (int i = 0; i < 21; ++i) a.in[i] = (const float*)d_in[i];
    a.out = (float*)d_out; a.ws = (unsigned char*)d_ws; a.ph_lo = 0; a.ph_hi = 13;
    void* args[] = {&a};
    hipError_t e = hipLaunchCooperativeKernel((const void*)mk, dim3(grid), dim3(512), args, LDS_BYTES, stream);
    if (e != hipSuccess) fprintf(stderr, "cooperative launch failed: %s (grid %d)\n", hipGetErrorString(e), grid);
}
```

```cpp
#define DUP 0
#include <hip/hip_runtime.h>
#include <hip/hip_cooperative_groups.h>
#include <stdint.h>
#include <stdio.h>
namespace cg = cooperative_groups;

#define DI __device__ __forceinline__
typedef unsigned short bf16_t;
typedef short bf16x8 __attribute__((ext_vector_type(8)));
typedef float f32x4 __attribute__((ext_vector_type(4)));
typedef float f32x16 __attribute__((ext_vector_type(16)));
typedef unsigned u32x4 __attribute__((ext_vector_type(4)));
typedef unsigned u32x2 __attribute__((ext_vector_type(2)));

constexpr int NB = 16, SEQ = 2048, DM = 1024, NT = NB * SEQ;
constexpr int DIN = 4896, DMIX = 1536, PP = 4864, NPAD = 5120;
constexpr int C_U = 0, C_Z = 512, C_NQ = 1024, C_KC = 1536, C_VC = 1664, C_KS = 1792, C_VS = 1920, C_KW = 2048, C_VW = 2176,
              C_NZ = 2304, C_FQ = 2816, C_FK = 3328, C_FV = 3840, C_FZ = 4352;
constexpr float LOG2E = 1.4426950408889634f, QS = 0.125f * LOG2E, EPS = 1e-6f;

constexpr size_t WS_P = 0;
constexpr size_t WS_HY = WS_P + (size_t)NT * PP * 2;
constexpr size_t WS_H = WS_HY + (size_t)NT * DMIX * 2;
constexpr size_t WS_SS = WS_H + (size_t)NT * DM * 2;
constexpr size_t WS_GL = WS_SS + (size_t)NT * 4;
constexpr size_t WS_WIN = WS_GL + (size_t)NT * 32 * 4;
constexpr size_t WS_WOUT = WS_WIN + (size_t)2 * NPAD * DM * 2;
constexpr size_t WS_WA = WS_WOUT + (size_t)2 * DM * DMIX * 2;
constexpr size_t WS_WX = WS_WA + 131072;
constexpr size_t WS_WCK = WS_WX + 131072;
constexpr size_t WS_WCV = WS_WCK + 524288;
constexpr size_t WS_BKV = WS_WCV + 524288;
constexpr size_t WS_BND = WS_BKV + 1024;
constexpr size_t WS_GAINS = WS_BKV + 2048;
constexpr size_t WS_C2 = WS_BKV + 8192;
constexpr size_t WS_KCMP = WS_C2 + (size_t)NB * 8 * SEQ * 4;
constexpr size_t WS_VCMP = WS_KCMP + 524288;
constexpr size_t WS_CTL = WS_VCMP + 524288;
constexpr size_t WS_CTL_BYTES = 16384;
constexpr size_t WS_END = WS_CTL + WS_CTL_BYTES;

constexpr int LDS_BYTES = 143360;

struct Args { const float* in[21]; float* out; unsigned char* ws; int ph_lo, ph_hi; };
enum { I_X = 0, I_NG, I_WIN, I_WOUT, I_CW, I_CB, I_WA, I_BA, I_WX, I_BX, I_LAM, I_NQG, I_NKG, I_PEK, I_PEV, I_WCK, I_WCV, I_GB, I_FQG, I_FKG, I_FFB };

DI int opaque_tid() { int t = threadIdx.x; asm volatile("" : "+v"(t)); return t; }
DI unsigned f2bf(float f) { unsigned u = __float_as_uint(f); return (u + 0x7fffu + ((u >> 16) & 1u)) >> 16; }
DI float bf2f(unsigned h) { return __uint_as_float(h << 16); }
DI unsigned pk2(float lo, float hi) { return f2bf(lo) | (f2bf(hi) << 16); }
DI float wave_sum(float v) { for (int o = 32; o; o >>= 1) v += __shfl_xor(v, o); return v; }
DI float sigmoidf_(float x) { return 1.f / (1.f + __expf(-x)); }
DI float siluf_(float x) { return x / (1.f + __expf(-x)); }
DI void unpack8(u32x4 r, float* f) {
#pragma unroll
    for (int i = 0; i < 4; ++i) { f[2 * i] = bf2f(r[i] & 0xffffu); f[2 * i + 1] = bf2f(r[i] >> 16); }
}

DI int win_col(int pc) {
    if (pc < 2304) return pc; if (pc < 4352) return pc + 24; if (pc < 4864) return pc + 32;
    if (pc < 4888) return 2304 + pc - 4864; if (pc < 4896) return 4376 + pc - 4888; return -1;
}
DI void wtile(const float* src, int ldsrc, bf16_t* dst, int K, int n0, int k0, int mode, float* t, const float* rowg = nullptr) {
    const int tid = opaque_tid();
#pragma unroll
    for (int i = 0; i < 8; ++i) {
        int kk = (tid >> 6) + 8 * i, nn = tid & 63, n = n0 + nn; int oc = mode ? win_col(n) : n;
        t[kk * 65 + nn] = oc >= 0 ? src[(size_t)(k0 + kk) * ldsrc + oc] * (rowg ? rowg[k0 + kk] : 1.f) : 0.f;
    }
    __syncthreads();
    {   const int nn = tid >> 3, k8 = (tid & 7) * 8; u32x4 w;
#pragma unroll
        for (int i = 0; i < 4; ++i) w[i] = pk2(t[(k8 + 2 * i) * 65 + nn], t[(k8 + 2 * i + 1) * 65 + nn]);
        *(u32x4*)(dst + (size_t)(n0 + nn) * K + k0 + k8) = w; }
    __syncthreads();
}
DI void phase_wprep(const Args& a, float* ldsf, int stage) {
    unsigned char* ws = a.ws;
    constexpr int PER = 1280 + 384 + 8 + 8 + 32 + 32 + 2;
    const bool split = gridDim.x >= 256;
    if (stage == 1 && (!split || blockIdx.x < 16)) return;
    const int ub = stage == 1 ? (int)blockIdx.x - 16 : (int)blockIdx.x, us = stage == 1 ? (int)gridDim.x - 16 : (int)gridDim.x;
    for (int u = ub; u < 2 * PER; u += us) {
        int l = u / PER, r = u % PER;
        if (split) {
            const bool early = (l == 0 && r < 1280) || (l == 0 && r >= 1280 + 384 + 16 && r < PER - 2) || (r >= PER - 2);
            const bool late1 = (r >= 1280 && r < 1280 + 384 + 16) || (l == 1 && r >= 1280 + 384 + 16 && r < PER - 2);
            if (stage == 0 ? !early : !late1) continue;
        }
        if (r < 1280) { wtile(a.in[I_WIN] + (size_t)l * DM * DIN, DIN, (bf16_t*)(ws + WS_WIN) + (size_t)l * NPAD * DM, DM, (r % 80) * 64, (r / 80) * 64, 1, ldsf, l ? a.in[I_NG] + DM : nullptr); continue; }
        r -= 1280;
        if (r < 384) { wtile(a.in[I_WOUT] + (size_t)l * DMIX * DM, DM, (bf16_t*)(ws + WS_WOUT) + (size_t)l * DM * DMIX, DMIX, (r % 16) * 64, (r / 16) * 64, 0, ldsf); continue; }
        r -= 384;
        if (r < 8) { wtile(a.in[I_WA] + (size_t)(l * 8 + r) * 4096, 64, (bf16_t*)(ws + WS_WA) + (size_t)(l * 8 + r) * 4096, 64, 0, 0, 0, ldsf); continue; }
        r -= 8;
        if (r < 8) { wtile(a.in[I_WX] + (size_t)(l * 8 + r) * 4096, 64, (bf16_t*)(ws + WS_WX) + (size_t)(l * 8 + r) * 4096, 64, 0, 0, 0, ldsf); continue; }
        r -= 8;
        if (r < 32) { wtile(a.in[I_WCK] + (size_t)l * 131072, 64, (bf16_t*)(ws + WS_WCK) + (size_t)l * 131072, 2048, 0, r * 64, 0, ldsf); continue; }
        r -= 32;
        if (r < 32) { wtile(a.in[I_WCV] + (size_t)l * 131072, 64, (bf16_t*)(ws + WS_WCV) + (size_t)l * 131072, 2048, 0, r * 64, 0, ldsf); continue; }
        r -= 32;
        {
            const float* pe = a.in[r ? I_PEV : I_PEK] + (size_t)l * 2048; const float* w = a.in[r ? I_WCV : I_WCK] + (size_t)l * 131072;
            const int e = threadIdx.x & 63, part = threadIdx.x >> 6; float s = 0.f;
#pragma unroll 16
            for (int k = part * 256; k < part * 256 + 256; ++k) s += pe[k] * w[(size_t)k * 64 + e];
            ldsf[part * 64 + e] = s; __syncthreads();
            if (threadIdx.x < 64) { float t = 0.f; for (int p = 0; p < 8; ++p) t += ldsf[p * 64 + e]; ((float*)(ws + WS_BKV))[(l * 2 + r) * 64 + e] = t; }
            if (r == 1 && threadIdx.x < 64) { float* gn = (float*)(ws + WS_GAINS) + l * 320;
                gn[e] = a.in[I_NQG][l * 64 + e] * QS; gn[64 + e] = a.in[I_NKG][(l * 3 + 1) * 64 + e]; gn[128 + e] = a.in[I_NKG][(l * 3 + 2) * 64 + e]; gn[192 + e] = a.in[I_FQG][l * 64 + e] * QS; gn[256 + e] = a.in[I_FKG][l * 64 + e]; }
            if (r == 0 && threadIdx.x < 64) {
                float gq = fabsf(a.in[I_NQG][l * 64 + e]), k0 = fabsf(a.in[I_NKG][(l * 3 + 0) * 64 + e]), k1 = fabsf(a.in[I_NKG][(l * 3 + 1) * 64 + e]), k2 = fabsf(a.in[I_NKG][(l * 3 + 2) * 64 + e]);
                float fq = fabsf(a.in[I_FQG][l * 64 + e]), fk = fabsf(a.in[I_FKG][l * 64 + e]);
                for (int o = 32; o; o >>= 1) { gq = fmaxf(gq, __shfl_xor(gq, o)); k0 = fmaxf(k0, __shfl_xor(k0, o)); k1 = fmaxf(k1, __shfl_xor(k1, o)); k2 = fmaxf(k2, __shfl_xor(k2, o)); fq = fmaxf(fq, __shfl_xor(fq, o)); fk = fmaxf(fk, __shfl_xor(fk, o)); }
                if (e == 0) { float* bnd = (float*)(ws + WS_BND) + l * 4; bnd[0] = QS * 64.f * gq * k0 * 1.01f + 0.5f; bnd[1] = QS * 64.f * gq * k1 * 1.01f + 0.5f; bnd[2] = QS * 64.f * gq * k2 * 1.01f + 0.5f; bnd[3] = QS * 64.f * fq * fk * 1.01f + 0.5f; }
            }
            __syncthreads();
        }
    }
}

DI void win1_late(const Args& a, float* ldsf) {
    if (gridDim.x < 256 || blockIdx.x < 128) return;
    for (int r = (int)blockIdx.x - 128; r < 1280; r += (int)gridDim.x - 128)
        wtile(a.in[I_WIN] + (size_t)DM * DIN, DIN, (bf16_t*)(a.ws + WS_WIN) + (size_t)NPAD * DM, DM, (r % 80) * 64, (r / 80) * 64, 1, ldsf, a.in[I_NG] + DM);
}

DI void phase_rms(const float* x, const float* g, bf16_t* H) {
    const int tid_ = opaque_tid(); const int lane = tid_ & 63, wid = tid_ >> 6;
    const int stride = gridDim.x * 8;
    int row = blockIdx.x * 8 + wid;
    f32x4 v[4], vn[4];
    if (row < NT) {
#pragma unroll
        for (int i = 0; i < 4; ++i) vn[i] = ((const f32x4*)(x + (size_t)row * DM))[lane + 64 * i];
    }
    for (; row < NT; row += stride) {
#pragma unroll
        for (int i = 0; i < 4; ++i) v[i] = vn[i];
        if (row + stride < NT) {
#pragma unroll
            for (int i = 0; i < 4; ++i) vn[i] = ((const f32x4*)(x + (size_t)(row + stride) * DM))[lane + 64 * i];
        }
        float ss = 0.f;
#pragma unroll
        for (int i = 0; i < 4; ++i) ss += v[i][0] * v[i][0] + v[i][1] * v[i][1] + v[i][2] * v[i][2] + v[i][3] * v[i][3];
        ss = wave_sum(ss);
        const float r = rsqrtf(ss * (1.f / DM) + EPS);
#pragma unroll
        for (int i = 0; i < 4; ++i) {
            const f32x4 gg = ((const f32x4*)g)[lane + 64 * i];
            u32x2 o; o[0] = pk2(v[i][0] * r * gg[0], v[i][1] * r * gg[1]); o[1] = pk2(v[i][2] * r * gg[2], v[i][3] * r * gg[3]);
            *(u32x2*)(H + (size_t)row * DM + (lane + 64 * i) * 4) = o;
        }
    }
}

namespace pg8 {
#define PG8_LAS __attribute__((address_space(3)))
typedef unsigned short bf16_t;
typedef short bf16x8 __attribute__((ext_vector_type(8)));
typedef float f32x4 __attribute__((ext_vector_type(4)));
typedef unsigned u32x4 __attribute__((ext_vector_type(4)));
constexpr int BM = 256, BK = 64, HALF = 128, HTB = HALF * BK * 2  , STAGE_BYTES = 8 * HTB, NXCD = 8, WGM = 8;

__host__ __device__ __forceinline__ int lds_byte(int r, int c) { const int st = (r >> 4) * 2 + (c >> 5), rr = r & 15, cc = c & 31, ob = rr * 64 + cc * 2; return st * 1024 + (ob ^ (((ob >> 9) & 1) << 5)); }
__host__ __device__ __forceinline__ void stage_rc(int b, int& R, int& C) { const int st = b / 1024, sb = b % 1024, swz = sb ^ (((sb >> 9) & 1) << 5); R = (st >> 1) * 16 + swz / 64; C = (st & 1) * 32 + (swz % 64) / 2; }
__host__ __device__ __forceinline__ int perm32(int rho) { const int n = rho >> 4, i = rho & 15; return 8 * (i >> 2) + 4 * n + (i & 3); }

struct Unit { int pm, pn; };
struct Gemm { const bf16_t* A; const bf16_t* Bt; int M, N, K; };

struct StaticOrder {
    int nM, nN, nwg, G, c;
    __host__ __device__ void init(int M, int N, int G_, int c_) { nM = M / BM; nN = N / BM; nwg = nM * nN; G = G_; c = c_; }
    __host__ __device__ bool next(int i, Unit& u) const {
        const long L = (long)i * G + c; if (L >= nwg) return false;
        int wgid = (int)L; { const int q = nwg / NXCD, r = nwg % NXCD, xcd = wgid % NXCD, off = wgid / NXCD; wgid = (xcd < r ? xcd * (q + 1) : r * (q + 1) + (xcd - r) * q) + off; }
        const int nig = WGM * nN, gid = wgid / nig, fm = gid * WGM, gsz = (nM - fm) < WGM ? (nM - fm) : WGM;
        u.pm = fm + ((wgid % nig) % gsz); u.pn = (wgid % nig) / gsz; return true;
    }
    __device__ __forceinline__ void a_ready(const Unit&) const {}
    __device__ __forceinline__ void done(const Unit&) const {}
};
__device__ __forceinline__ unsigned cvt_pk_bf16(float lo, float hi) { unsigned r; asm volatile("v_cvt_pk_bf16_f32 %0, %1, %2" : "=v"(r) : "v"(lo), "v"(hi)); return r; }

struct EpiProjF {
    static constexpr bool PERM = true, AFTER_DRAIN = false;
    bf16_t* P; const float* ss; PG8_LAS float* xs  ; const float* gains  ;
    __device__ __forceinline__ void operator()(const f32x4 (&acc)[2][2][4][2], const Unit& u, int wr, int wc, int fr, int fq) const {
        const int row0 = u.pm * BM + wr * 64 + fr;
        const int col0 = u.pn * BM + wc * 32 + 8 * fq;
        const int pn = u.pn, wid = wr * 4 + wc;
        const bool need = (pn == 4) | (pn == 5) | (pn == 7) | (pn == 8) | ((pn >= 11) & (pn <= 14));
        float hs[2][4][2];
        if (need) {
#pragma unroll
            for (int ai = 0; ai < 2; ++ai)
#pragma unroll
                for (int m = 0; m < 4; ++m)
#pragma unroll
                    for (int bj = 0; bj < 2; ++bj) { const f32x4 v0 = acc[ai][bj][m][0], v1 = acc[ai][bj][m][1];
                        float s = v0[0] * v0[0] + v0[1] * v0[1] + v0[2] * v0[2] + v0[3] * v0[3] + v1[0] * v1[0] + v1[1] * v1[1] + v1[2] * v1[2] + v1[3] * v1[3];
                        s += __shfl_xor(s, 16); s += __shfl_xor(s, 32);
                        hs[ai][m][bj] = s;
                        if (fq == 0) xs[(((wid * 2 + ai) * 4 + m) * 2 + bj) * 16 + fr] = s; }
            asm volatile("s_waitcnt lgkmcnt(0)" ::: "memory");
            __builtin_amdgcn_s_barrier();
        }
        const int kind = (pn <= 5) ? 0 : (pn == 7) ? 1 : (pn == 8) ? 2 : (pn <= 12) ? 3 : 4;
#pragma unroll
        for (int bj = 0; bj < 2; ++bj) {
            const bool hn = need && !((pn == 7 || pn == 8) && bj == 1);
            f32x4 g0 = (f32x4){1.f, 1.f, 1.f, 1.f}, g1 = g0;
            if (hn) { g0 = *(const f32x4*)(gains + kind * 64 + (wc & 1) * 32 + 8 * fq); g1 = *(const f32x4*)(gains + kind * 64 + (wc & 1) * 32 + 8 * fq + 4); }
#pragma unroll
            for (int ai = 0; ai < 2; ++ai)
#pragma unroll
                for (int m = 0; m < 4; ++m) { const int row = row0 + ai * HALF + m * 16;
                    const float rr = ss ? rsqrtf(ss[row] * (1.f / 1024) + 1e-6f) : 1.f;
                    float rs = rr;
                    if (hn) { const float tot = (hs[ai][m][bj] + xs[((((wid ^ 1) * 2 + ai) * 4 + m) * 2 + bj) * 16 + fr]) * rr * rr; rs = rr * rsqrtf(tot * (1.f / 64) + 1e-6f); }
                    const f32x4 v0 = acc[ai][bj][m][0] * rs * g0, v1 = acc[ai][bj][m][1] * rs * g1;
                    u32x4 w; w.x = cvt_pk_bf16(v0[0], v0[1]); w.y = cvt_pk_bf16(v0[2], v0[3]); w.z = cvt_pk_bf16(v1[0], v1[1]); w.w = cvt_pk_bf16(v1[2], v1[3]);
                    *(u32x4*)(P + (size_t)row * 4864 + col0 + bj * HALF) = w; }
        }
    }
};
struct EpiOutF {
    static constexpr bool PERM = true, AFTER_DRAIN = false;
    const float* res32; const bf16_t* res16; float* out32; bf16_t* out16; float* ss;
    __device__ __forceinline__ void operator()(const f32x4 (&acc)[2][2][4][2], const Unit& u, int wr, int wc, int fr, int fq) const {
        const int row0 = u.pm * BM + wr * 64 + fr, col0 = u.pn * BM + wc * 32 + 8 * fq;
#pragma unroll
        for (int ai = 0; ai < 2; ++ai)
#pragma unroll
            for (int m = 0; m < 4; ++m) { const int row = row0 + ai * HALF + m * 16; const size_t off = (size_t)row * 1024 + col0;
                float sq = 0.f;
#pragma unroll
                for (int bj = 0; bj < 2; ++bj) {
                    f32x4 r0, r1;
                    if (res16) { const u32x4 rb = *(const u32x4*)(res16 + off + bj * HALF);
                        r0 = (f32x4){__uint_as_float(rb[0] << 16), __uint_as_float(rb[0] & 0xffff0000u), __uint_as_float(rb[1] << 16), __uint_as_float(rb[1] & 0xffff0000u)};
                        r1 = (f32x4){__uint_as_float(rb[2] << 16), __uint_as_float(rb[2] & 0xffff0000u), __uint_as_float(rb[3] << 16), __uint_as_float(rb[3] & 0xffff0000u)}; }
                    else { r0 = *(const f32x4*)(res32 + off + bj * HALF); r1 = *(const f32x4*)(res32 + off + bj * HALF + 4); }
                    const f32x4 o0 = r0 + acc[ai][bj][m][0], o1 = r1 + acc[ai][bj][m][1];
                    if (out32) { *(f32x4*)(out32 + off + bj * HALF) = o0; *(f32x4*)(out32 + off + bj * HALF + 4) = o1; }
                    if (out16) { sq += o0[0] * o0[0] + o0[1] * o0[1] + o0[2] * o0[2] + o0[3] * o0[3] + o1[0] * o1[0] + o1[1] * o1[1] + o1[2] * o1[2] + o1[3] * o1[3];
                        u32x4 w; w.x = cvt_pk_bf16(o0[0], o0[1]); w.y = cvt_pk_bf16(o0[2], o0[3]); w.z = cvt_pk_bf16(o1[0], o1[1]); w.w = cvt_pk_bf16(o1[2], o1[3]);
                        *(u32x4*)(out16 + off + bj * HALF) = w; }
                    __builtin_amdgcn_sched_barrier(0); }
                if (out16) { sq += __shfl_xor(sq, 16); sq += __shfl_xor(sq, 32); if (fq == 0) atomicAdd(ss + row, sq); } }
    }
};

template <class Epi, class Sched, bool ALIGN_EPI = false, bool SP2 = false>
__device__ __forceinline__ void gemm_phase(PG8_LAS unsigned char* lds, const Gemm g, const Sched& S, const Epi& E) {
    int tid = threadIdx.x; asm volatile("" : "+v"(tid));
    const int wid = __builtin_amdgcn_readfirstlane(tid >> 6), lane = tid & 63, wr = wid >> 2, wc = wid & 3, fr = lane & 15, fq = lane >> 4;
    const int K = g.K, nt = K / BK;
    unsigned voffA[2], voffB[2];
#pragma unroll
    for (int i = 0; i < 2; ++i) { int R, C; stage_rc(tid * 16 + i * 8192, R, C); const int Rb = Epi::PERM ? ((R & ~31) + perm32(R & 31)) : R;
        voffA[i] = (unsigned)(R * K + C) * 2u; voffB[i] = (unsigned)(Rb * K + C) * 2u; }
    const size_t kstep = (size_t)(BK * 2);
    const size_t hstep = (size_t)HALF * K * 2;
    const size_t tstep = 2 * hstep;
    const unsigned ldsw = (unsigned)wid * 1024u;
    const int aoff = lds_byte(wr * 64 + fr, fq * 8), boff = lds_byte(wc * 32 + fr, fq * 8);
#define PG8_SA(b, h) (((b) * 2 + (h)) * HTB)
#define PG8_SB(b, h) ((4 + (b) * 2 + (h)) * HTB)
#define PG8_STAGE(bufoff, gbase, voff) do { _Pragma("unroll") for (int _i = 0; _i < 2; ++_i) \
        __builtin_amdgcn_global_load_lds((const unsigned*)((const char*)(gbase) + (voff)[_i]), (PG8_LAS unsigned*)(lds + (bufoff) + ldsw + _i * 8192), 16, 0, 0); } while (0)
#define PG8_LDA(dst, b, h) do { _Pragma("unroll") for (int m = 0; m < 4; ++m) _Pragma("unroll") for (int k = 0; k < 2; ++k) dst[m][k] = *(const PG8_LAS bf16x8*)(lds + PG8_SA(b, h) + aoff + m * 2048 + k * 1024); } while (0)
#define PG8_LDB(dst, b, h) do { _Pragma("unroll") for (int n = 0; n < 2; ++n) _Pragma("unroll") for (int k = 0; k < 2; ++k) dst[n][k] = *(const PG8_LAS bf16x8*)(lds + PG8_SB(b, h) + boff + n * 2048 + k * 1024); } while (0)
#define PG8_MMA(ai, bj, At, Bt) do { __builtin_amdgcn_s_setprio(1); _Pragma("unroll") for (int m = 0; m < 4; ++m) _Pragma("unroll") for (int n = 0; n < 2; ++n) _Pragma("unroll") for (int k = 0; k < 2; ++k) \
        acc[ai][bj][m][n] = __builtin_amdgcn_mfma_f32_16x16x32_bf16(Bt[n][k], At[m][k], acc[ai][bj][m][n], 0, 0, 0); __builtin_amdgcn_s_setprio(0); } while (0)
#define PG8_WAIT_V(n) asm volatile("s_waitcnt vmcnt(" #n ")" ::: "memory")
#define PG8_WAIT_L(n) asm volatile("s_waitcnt lgkmcnt(" #n ")" ::: "memory")
#define PG8_BAR __builtin_amdgcn_s_barrier()
#define PG8_SCHED __builtin_amdgcn_sched_barrier(0)
    Unit cur, nxt; int ui = 0;
    if (!S.next(0, cur)) return;
    f32x4 acc[2][2][4][2];
#pragma unroll
    for (int a = 0; a < 2; ++a)
#pragma unroll
        for (int b = 0; b < 2; ++b)
#pragma unroll
            for (int m = 0; m < 4; ++m)
#pragma unroll
                for (int n = 0; n < 2; ++n) acc[a][b][m][n] = (f32x4){0.f, 0.f, 0.f, 0.f};
    bf16x8 At[4][2], B0[2][2], B1[2][2];
    const char* cA = (const char*)g.A + (size_t)cur.pm * tstep; const char* cB = (const char*)g.Bt + (size_t)cur.pn * tstep;
    S.a_ready(cur);
    if constexpr (SP2) {
        PG8_STAGE(PG8_SB(0, 0), cB, voffB); PG8_STAGE(PG8_SB(0, 1), cB + hstep, voffB); PG8_STAGE(PG8_SA(0, 0), cA, voffA); PG8_STAGE(PG8_SA(0, 1), cA + hstep, voffA);
        if (wr == 1) PG8_BAR;
        PG8_WAIT_V(2); PG8_BAR;
        PG8_STAGE(PG8_SB(1, 0), cB + kstep, voffB); PG8_STAGE(PG8_SA(1, 0), cA + kstep, voffA); PG8_STAGE(PG8_SB(1, 1), cB + hstep + kstep, voffB);
        PG8_WAIT_V(6); PG8_BAR;
    } else {
        PG8_STAGE(PG8_SB(0, 0), cB, voffB); PG8_STAGE(PG8_SA(0, 0), cA, voffA); PG8_STAGE(PG8_SB(0, 1), cB + hstep, voffB); PG8_STAGE(PG8_SA(0, 1), cA + hstep, voffA);
        if (wr == 1) PG8_BAR;
        PG8_WAIT_V(4); PG8_BAR;
        PG8_STAGE(PG8_SB(1, 0), cB + kstep, voffB); PG8_STAGE(PG8_SA(1, 0), cA + kstep, voffA); PG8_STAGE(PG8_SB(1, 1), cB + hstep + kstep, voffB);
        PG8_WAIT_V(6); PG8_BAR;
    }
    for (;;) {
        const bool has_next = S.next(ui + 1, nxt);
        const char* nA = has_next ? (const char*)g.A + (size_t)nxt.pm * tstep : cA; const char* nB = has_next ? (const char*)g.Bt + (size_t)nxt.pn * tstep : cB;
        for (int t = 0; t < nt; t += 2) {
            const bool last = (t == nt - 2);
            const char* a1 = cA + (size_t)(t + 1) * kstep;
            const char* a2 = last ? nA : cA + (size_t)(t + 2) * kstep; const char* b2 = last ? nB : cB + (size_t)(t + 2) * kstep;
            const char* a3 = a2 + kstep; const char* b3 = b2 + kstep;
            if (last && has_next) S.a_ready(nxt);
            if constexpr (SP2) {
            PG8_LDB(B0, 0, 0); PG8_LDB(B1, 0, 1); PG8_SCHED; PG8_LDA(At, 0, 0); PG8_STAGE(PG8_SA(1, 1), a1 + hstep, voffA);
            PG8_WAIT_V(8); PG8_WAIT_L(0); PG8_BAR; PG8_MMA(0, 0, At, B0); PG8_MMA(0, 1, At, B1); PG8_BAR; PG8_SCHED;
            PG8_LDA(At, 0, 1); PG8_STAGE(PG8_SB(0, 0), b2, voffB); PG8_STAGE(PG8_SB(0, 1), b2 + hstep, voffB); PG8_STAGE(PG8_SA(0, 0), a2, voffA);
            PG8_WAIT_V(8); PG8_WAIT_L(0); PG8_BAR; PG8_MMA(1, 0, At, B0); PG8_MMA(1, 1, At, B1); PG8_BAR; PG8_SCHED;
            PG8_LDB(B0, 1, 0); PG8_LDB(B1, 1, 1); PG8_SCHED; PG8_LDA(At, 1, 0); PG8_STAGE(PG8_SA(0, 1), a2 + hstep, voffA);
            PG8_WAIT_V(8); PG8_WAIT_L(0); PG8_BAR; PG8_MMA(0, 0, At, B0); PG8_MMA(0, 1, At, B1); PG8_BAR; PG8_SCHED;
            PG8_LDA(At, 1, 1); PG8_STAGE(PG8_SB(1, 0), b3, voffB); PG8_STAGE(PG8_SB(1, 1), b3 + hstep, voffB); PG8_STAGE(PG8_SA(1, 0), a3, voffA);
            PG8_WAIT_V(8); PG8_WAIT_L(0); PG8_BAR; PG8_MMA(1, 0, At, B0); PG8_MMA(1, 1, At, B1); PG8_BAR; PG8_SCHED;
            } else {
            PG8_LDB(B0, 0, 0); PG8_SCHED; PG8_LDA(At, 0, 0); PG8_STAGE(PG8_SA(1, 1), a1 + hstep, voffA);
            PG8_WAIT_L(8); PG8_BAR; PG8_WAIT_L(0); PG8_MMA(0, 0, At, B0); PG8_BAR; PG8_SCHED;
            PG8_LDB(B1, 0, 1); PG8_STAGE(PG8_SB(0, 0), b2, voffB);
            PG8_BAR; PG8_WAIT_L(0); PG8_MMA(0, 1, At, B1); PG8_BAR;
            PG8_LDA(At, 0, 1); PG8_STAGE(PG8_SA(0, 0), a2, voffA);
            PG8_BAR; PG8_WAIT_L(0); PG8_MMA(1, 0, At, B0); PG8_BAR; PG8_SCHED;
            PG8_STAGE(PG8_SB(0, 1), b2 + hstep, voffB);
            PG8_WAIT_V(6); PG8_BAR; PG8_MMA(1, 1, At, B1); PG8_BAR;
            PG8_LDB(B0, 1, 0); PG8_SCHED; PG8_LDA(At, 1, 0); PG8_STAGE(PG8_SA(0, 1), a2 + hstep, voffA);
            PG8_WAIT_L(8); PG8_BAR; PG8_WAIT_L(0); PG8_MMA(0, 0, At, B0); PG8_BAR; PG8_SCHED;
            PG8_LDB(B1, 1, 1); PG8_STAGE(PG8_SB(1, 0), b3, voffB);
            PG8_BAR; PG8_WAIT_L(0); PG8_MMA(0, 1, At, B1); PG8_BAR;
            PG8_LDA(At, 1, 1); PG8_STAGE(PG8_SA(1, 0), a3, voffA);
            PG8_BAR; PG8_WAIT_L(0); PG8_MMA(1, 0, At, B0); PG8_BAR; PG8_SCHED;
            PG8_STAGE(PG8_SB(1, 1), b3 + hstep, voffB);
            PG8_WAIT_V(6); PG8_BAR; PG8_MMA(1, 1, At, B1); PG8_BAR;
            }
        }
        if constexpr (ALIGN_EPI) { if (wr == 0) PG8_BAR; }
        if constexpr (!Epi::AFTER_DRAIN) { E(acc, cur, wr, wc, fr, fq); S.done(cur); }
        if (!has_next) break;
#pragma unroll
        for (int a = 0; a < 2; ++a)
#pragma unroll
            for (int b = 0; b < 2; ++b)
#pragma unroll
                for (int m = 0; m < 4; ++m)
#pragma unroll
                    for (int n = 0; n < 2; ++n) acc[a][b][m][n] = (f32x4){0.f, 0.f, 0.f, 0.f};
        cur = nxt; cA = nA; cB = nB; ++ui;
        if constexpr (ALIGN_EPI) { if (wr == 1) PG8_BAR; }
    }
    PG8_WAIT_V(0);
    if constexpr (!ALIGN_EPI) { if (wr == 0) PG8_BAR; }
    PG8_BAR;
    if constexpr (Epi::AFTER_DRAIN) { E.fused(acc, cur, wr, wc, fr, fq, lds, wid, lane); S.done(cur); }
#undef PG8_SA
#undef PG8_SB
#undef PG8_STAGE
#undef PG8_LDA
#undef PG8_LDB
#undef PG8_MMA
#undef PG8_WAIT_V
#undef PG8_WAIT_L
#undef PG8_BAR
#undef PG8_SCHED
}
}


DI void gates_gemm(const bf16_t* H, const bf16_t* WgT  , float* GL, const float* ss, bool upper_half_only) {
    const int tid_ = opaque_tid(); const int lane = tid_ & 63, wid = tid_ >> 6, r32 = lane & 31, hi = lane >> 5;
    const int nb = (upper_half_only && gridDim.x >= 256) ? (int)gridDim.x - 128 : (int)gridDim.x, b0 = (int)gridDim.x - nb;
    if ((int)blockIdx.x < b0) return;
    for (int u = ((int)blockIdx.x - b0) + nb * wid; u < NT / 32; u += nb * 8) {
        const bf16_t* ap = H + (size_t)(u * 32 + r32) * DM + hi * 8; const bf16_t* bp = WgT + (size_t)r32 * DM + hi * 8;
        f32x16 acc;
#pragma unroll
        for (int i = 0; i < 16; ++i) acc[i] = 0.f;
#pragma unroll 8
        for (int k = 0; k < DM; k += 16) acc = __builtin_amdgcn_mfma_f32_32x32x16_bf16(*(const bf16x8*)(ap + k), *(const bf16x8*)(bp + k), acc, 0, 0, 0);
#pragma unroll
        for (int i = 0; i < 16; ++i) { const int row = u * 32 + (i & 3) + 8 * (i >> 2) + 4 * hi; const float rs = ss ? rsqrtf(ss[row] * (1.f / 1024) + EPS) : 1.f; GL[(size_t)row * 32 + r32] = acc[i] * rs; }
    }
}

DI float log_sigmoid_(float x) { return fminf(x, 0.f) - log1pf(__expf(-fabsf(x))); }
DI void prep_cumsum(const Args& a, int l, float* LS) {
    const float* GL = (const float*)(a.ws + WS_GL); float* C2 = (float*)(a.ws + WS_C2);
    const int tid = opaque_tid(), lane = tid & 63, wid = tid >> 6;
    for (int b = blockIdx.x; b < NB; b += gridDim.x) {
        __syncthreads();
#pragma unroll
        for (int i = 0; i < 4; ++i) {
            const int t = tid + 512 * i;
            const f32x4 v0 = *(const f32x4*)(GL + (size_t)(b * SEQ + t) * 32 + 24), v1 = *(const f32x4*)(GL + (size_t)(b * SEQ + t) * 32 + 28);
#pragma unroll
            for (int h = 0; h < 4; ++h) { LS[h * 2112 + (t >> 5) * 33 + (t & 31)] = log_sigmoid_(v0[h] + a.in[I_FFB][l * 8 + h]); LS[(h + 4) * 2112 + (t >> 5) * 33 + (t & 31)] = log_sigmoid_(v1[h] + a.in[I_FFB][l * 8 + 4 + h]); }
        }
        __syncthreads();
        {   float* row = LS + wid * 2112 + lane * 33;
            float tot = 0.f;
            for (int k = 0; k < 32; ++k) tot += row[k];
            float inc = tot;
#pragma unroll
            for (int o = 1; o < 64; o <<= 1) { const float n = __shfl_up(inc, o); if (lane >= o) inc += n; }
            float run = inc - tot;
            for (int k = 0; k < 32; ++k) { run += row[k]; row[k] = run * LOG2E; }
        }
        __syncthreads();
#pragma unroll
        for (int i = 0; i < 4; ++i) { const int t = tid + 512 * i;
#pragma unroll
            for (int h = 0; h < 8; ++h) C2[(size_t)(b * 8 + h) * SEQ + t] = LS[h * 2112 + (t >> 5) * 33 + (t & 31)]; }
    }
    __syncthreads();
}
DI void prep_compress(const Args& a, int l, const bf16_t* P) {
    unsigned char* ws = a.ws;
    const int tid_ = opaque_tid(); const int lane = tid_ & 63, wid = tid_ >> 6, fr = lane & 15, fq = lane >> 4;
    const int nbk = gridDim.x > 32 ? (int)gridDim.x - 16 : (int)gridDim.x, bk0 = (int)gridDim.x - nbk;
    if ((int)blockIdx.x < bk0) return;
    for (int it = ((int)blockIdx.x - bk0) + nbk * wid; it < NB * 2 * 2 * 8; it += nbk * 8) {
        const int nq = it & 7, kv = (it >> 3) & 1, g = (it >> 4) & 1, b = it >> 5;
        const int n = 16 * nq + fr; const bool ok = n < 127;
        const bf16_t* src = P + (size_t)(b * SEQ + (ok ? 16 * n : 0)) * PP + (kv ? C_VC : C_KC) + g * 64 + fq * 8;
        const bf16_t* W = (const bf16_t*)(ws + (kv ? WS_WCV : WS_WCK)) + (size_t)l * 131072 + (size_t)fr * 2048 + fq * 8;
        f32x4 acc[4];
#pragma unroll
        for (int nt = 0; nt < 4; ++nt) acc[nt] = (f32x4){0.f, 0.f, 0.f, 0.f};
#pragma unroll 4
        for (int ks = 0; ks < 64; ++ks) {
            bf16x8 af = *(const bf16x8*)(src + (size_t)(ks >> 1) * PP + (ks & 1) * 32);
            if (!ok) af = (bf16x8){0, 0, 0, 0, 0, 0, 0, 0};
#pragma unroll
            for (int nt = 0; nt < 4; ++nt) { const bf16x8 bw = *(const bf16x8*)(W + (size_t)nt * 16 * 2048 + ks * 32); acc[nt] = __builtin_amdgcn_mfma_f32_16x16x32_bf16(af, bw, acc[nt], 0, 0, 0); }
        }
        const float* bias = (const float*)(ws + WS_BKV) + (l * 2 + kv) * 64;
        float v[4][4];
#pragma unroll
        for (int nt = 0; nt < 4; ++nt)
#pragma unroll
            for (int i = 0; i < 4; ++i) v[nt][i] = acc[nt][i] + bias[16 * nt + fr];
        bf16_t* out = (bf16_t*)(ws + (kv ? WS_VCMP : WS_KCMP)) + (size_t)(b * 2 + g) * 128 * 64;
#pragma unroll
        for (int i = 0; i < 4; ++i) {
            const int row = 16 * nq + 4 * fq + i;
            float sc = 1.f;
            if (kv == 0) { float ss = v[0][i] * v[0][i] + v[1][i] * v[1][i] + v[2][i] * v[2][i] + v[3][i] * v[3][i];
                ss += __shfl_xor(ss, 1); ss += __shfl_xor(ss, 2); ss += __shfl_xor(ss, 4); ss += __shfl_xor(ss, 8); sc = rsqrtf(ss * (1.f / 64) + EPS); }
#pragma unroll
            for (int nt = 0; nt < 4; ++nt) { const int e = 16 * nt + fr; float o = v[nt][i] * sc; if (kv == 0) o *= a.in[I_NKG][(l * 3 + 0) * 64 + e]; if (row >= 127) o = 0.f;
                out[(size_t)row * 64 + e] = (bf16_t)f2bf(o); }
        }
    }
}


constexpr int A_KB = 0, A_VB = 18432, A_CB = A_VB + 16384, A_IG = A_CB + 512, A_IL = A_IG + 33792, A_SELM = A_IL + 33792, A_UN = A_SELM + 256, A_UNIT = A_UN + 16, A_SC = A_UNIT + 16, A_KG = A_SC + 2048, A_END = A_KG + 512;
static_assert(A_END <= LDS_BYTES, "attention LDS map");
struct ACtx { int r32, hi, tid, tok; bf16x8 qr[4]; };
typedef float f32x2_t __attribute__((ext_vector_type(2))); typedef __bf16 bf16x2_t __attribute__((ext_vector_type(2)));
typedef short v4i16_t __attribute__((ext_vector_type(4)));
#define LAS3 __attribute__((address_space(3)))
DI unsigned cvtpk(float lo, float hi) { f32x2_t v = {lo, hi}; bf16x2_t bb = __builtin_convertvector(v, bf16x2_t); return __builtin_bit_cast(unsigned, bb); }
DI v4i16_t vtr(const LAS3 unsigned char* p) { return __builtin_amdgcn_ds_read_tr16_b64_v4i16((LAS3 v4i16_t*)p); }

DI void load_q(ACtx& x, const bf16_t* qrow) {
#pragma unroll
    for (int d0 = 0; d0 < 4; ++d0) x.qr[d0] = *(const bf16x8*)(qrow + d0 * 16 + x.hi * 8);
}

template <int MODE, bool ONLINE>
DI void attn_tile_compute(const unsigned char* lds, int cur, int j, const ACtx& x, unsigned selm, int cblk, int wtokmin, float bref, float ctb, f32x16 (&oT)[2], float& m, float& l) {
    const bf16_t* KB = (const bf16_t*)(lds + A_KB) + cur * 4608;
    const int lane = x.tid & 63;
    f32x16 p0, p1;
    if (MODE == 3) {
        const float* CB = (const float*)(lds + A_CB) + cur * 64 + 4 * x.hi;
#pragma unroll
        for (int q = 0; q < 4; ++q) { const f32x4 c0 = *(const f32x4*)(CB + 8 * q), c1 = *(const f32x4*)(CB + 32 + 8 * q);
#pragma unroll
            for (int i = 0; i < 4; ++i) { p0[4 * q + i] = (ONLINE ? 0.f : ctb) - c0[i]; p1[4 * q + i] = (ONLINE ? 0.f : ctb) - c1[i]; } }
    } else {
#pragma unroll
        for (int i = 0; i < 16; ++i) { p0[i] = ONLINE ? 0.f : -bref; p1[i] = ONLINE ? 0.f : -bref; }
    }
#pragma unroll
    for (int d0 = 0; d0 < 4; ++d0) {
        const bf16x8 k0 = *(const bf16x8*)(KB + x.r32 * 72 + d0 * 16 + x.hi * 8);
        const bf16x8 k1 = *(const bf16x8*)(KB + (32 + x.r32) * 72 + d0 * 16 + x.hi * 8);
        p0 = __builtin_amdgcn_mfma_f32_32x32x16_bf16(k0, x.qr[d0], p0, 0, 0, 0);
        p1 = __builtin_amdgcn_mfma_f32_32x32x16_bf16(k1, x.qr[d0], p1, 0, 0, 0);
    }
    const float NEG = -INFINITY;
    const int kb = 64 * j + 4 * x.hi;
#define KK(r) (kb + ((r) & 3) + 8 * ((r) >> 2))
    if (MODE == 3) {
        if (64 * j + 63 > wtokmin) {
#pragma unroll
            for (int r = 0; r < 16; ++r) { const int kk = KK(r); if (kk > x.tok) p0[r] = NEG; if (kk + 32 > x.tok) p1[r] = NEG; }
        }
    } else if (MODE == 0) {
#pragma unroll
        for (int r = 0; r < 16; ++r) { const int n = KK(r); if (16 * n + 31 > x.tok) p0[r] = NEG; if (16 * (n + 32) + 31 > x.tok) p1[r] = NEG; }
    } else if (MODE == 1) {
        const bool on = (selm >> j) & 1u;
        const bool allon = __ballot(on) == ~0ull;
        if (j == cblk) {
#pragma unroll
            for (int r = 0; r < 16; ++r) { const int kk = KK(r); if (!on || kk > x.tok) p0[r] = NEG; if (!on || kk + 32 > x.tok) p1[r] = NEG; }
        } else if (!allon) {
#pragma unroll
            for (int r = 0; r < 16; ++r) { if (!on) { p0[r] = NEG; p1[r] = NEG; } }
        }
    } else {
        if (j == cblk) {
#pragma unroll
            for (int r = 0; r < 16; ++r) { const int kk = KK(r); if (kk > x.tok) p0[r] = NEG; if (kk + 32 > x.tok) p1[r] = NEG; }
        } else if (j == cblk - 8) {
#pragma unroll
            for (int r = 0; r < 16; ++r) { const int kk = KK(r); if (x.tok - kk >= 512) p0[r] = NEG; if (x.tok - kk - 32 >= 512) p1[r] = NEG; }
        }
    }
#undef KK
    if (ONLINE) {
        float mx = fmaxf(p0[0], p1[0]);
#pragma unroll
        for (int r = 1; r < 16; ++r) mx = fmaxf(mx, fmaxf(p0[r], p1[r]));
        mx = fmaxf(mx, __shfl_xor(mx, 32));
        const float mn = fmaxf(m, mx);
        if (__any(mn > m)) {
            const float sc = __builtin_amdgcn_exp2f(m - mn); l *= sc;
#pragma unroll
            for (int r = 0; r < 16; ++r) { oT[0][r] *= sc; oT[1][r] *= sc; }
        }
        m = mn;
#pragma unroll
        for (int r = 0; r < 16; ++r) { p0[r] -= mn; p1[r] -= mn; }
    }
    f32x2_t ls2 = {0.f, 0.f};
#pragma unroll
    for (int r = 0; r < 16; r += 2) { p0[r] = __builtin_amdgcn_exp2f(p0[r]); p0[r + 1] = __builtin_amdgcn_exp2f(p0[r + 1]); p1[r] = __builtin_amdgcn_exp2f(p1[r]); p1[r + 1] = __builtin_amdgcn_exp2f(p1[r + 1]);
        ls2 += (f32x2_t){p0[r], p0[r + 1]}; ls2 += (f32x2_t){p1[r], p1[r + 1]}; }
    l += ls2[0] + ls2[1];
    bf16x8 pf[4];
#pragma unroll
    for (int s = 0; s < 2; ++s) {
        u32x4 a0, a1;
#pragma unroll
        for (int i = 0; i < 4; ++i) { a0[i] = cvtpk(p0[8 * s + 2 * i], p0[8 * s + 2 * i + 1]); a1[i] = cvtpk(p1[8 * s + 2 * i], p1[8 * s + 2 * i + 1]); }
        pf[s] = __builtin_bit_cast(bf16x8, a0); pf[2 + s] = __builtin_bit_cast(bf16x8, a1);
    }
    const LAS3 unsigned char* vp = (const LAS3 unsigned char*)(lds + A_VB) + cur * 8192 + ((lane >> 4) & 1) * 32 + (lane & 3) * 8 + (4 * x.hi + ((lane & 15) >> 2)) * 64;
#pragma unroll
    for (int dh = 0; dh < 2; ++dh)
#pragma unroll
        for (int ks = 0; ks < 4; ++ks) {
            const v4i16_t lo = vtr(vp + dh * 4096 + ks * 1024), hi4 = vtr(vp + dh * 4096 + ks * 1024 + 512);
            const bf16x8 vf = (bf16x8){lo[0], lo[1], lo[2], lo[3], hi4[0], hi4[1], hi4[2], hi4[3]};
            oT[dh] = __builtin_amdgcn_mfma_f32_32x32x16_bf16(vf, pf[ks], oT[dh], 0, 0, 0);
        }
}

template <int MODE, bool ONLINE>
DI void attn_branch(unsigned char* lds, const bf16_t* Kg, int kp, const bf16_t* Vg, int vp, const float* Cg, int kgofs, unsigned tiles,
                    const ACtx& x, unsigned selm, int cblk, int wtokmin, int wtokmax, float bref, float ctb, f32x16 (&oT)[2], float& m, float& l) {
    const int tid = x.tid, srow = tid >> 3, sc8 = tid & 7;
    bf16_t* KB = (bf16_t*)(lds + A_KB); unsigned char* VB = lds + A_VB; float* CB = (float*)(lds + A_CB);
    const int kofs = srow * 72 + sc8 * 8, vofs = ((sc8 >> 2) * 4 + (srow >> 4)) * 1024 + (srow & 15) * 64 + (sc8 & 3) * 16;
    unsigned rem = tiles; if (!rem) return;
    u32x4 krA, vrA, krB, vrB; f32x4 crA = {0.f, 0.f, 0.f, 0.f}, crB = {0.f, 0.f, 0.f, 0.f};
#define POP(jv) do { jv = -1; if (rem) { jv = __builtin_ctz(rem); rem &= rem - 1; } } while (0)
#define LOADT(jj, kr, vr, cr) do { kr = *(const u32x4*)(Kg + (size_t)(64 * (jj) + srow) * kp + sc8 * 8); vr = *(const u32x4*)(Vg + (size_t)(64 * (jj) + srow) * vp + sc8 * 8); \
        if (MODE == 3 && tid < 16) cr = *(const f32x4*)(Cg + 64 * (jj) + tid * 4); } while (0)
#define STORET(buf, kr, vr, cr) do { *(u32x4*)(KB + (buf) * 4608 + kofs) = kr; *(u32x4*)(VB + (buf) * 8192 + vofs) = vr; if (MODE == 3 && tid < 16) *(f32x4*)(CB + (buf) * 64 + tid * 4) = cr; } while (0)
#define ACTIVE(jj) ((MODE == 1) ? (__ballot((selm >> (jj)) & 1u) != 0ull) : ((MODE == 3) ? (64 * (jj) <= wtokmax) : true))
    int j0, j1, j2, j3;
    POP(j0); LOADT(j0, krA, vrA, crA); STORET(0, krA, vrA, crA);
    POP(j1); if (j1 >= 0) LOADT(j1, krA, vrA, crA);
    __syncthreads();
    int cur = 0;
    for (;;) {
        POP(j2); if (j2 >= 0) LOADT(j2, krB, vrB, crB);
        if (ACTIVE(j0)) attn_tile_compute<MODE, ONLINE>(lds, cur, j0, x, selm, cblk, wtokmin, bref, ctb, oT, m, l);
        if (j1 >= 0) STORET(cur ^ 1, krA, vrA, crA);
        __syncthreads();
        if (j1 < 0) break;
        cur ^= 1;
        POP(j3); if (j3 >= 0) LOADT(j3, krA, vrA, crA);
        if (ACTIVE(j1)) attn_tile_compute<MODE, ONLINE>(lds, cur, j1, x, selm, cblk, wtokmin, bref, ctb, oT, m, l);
        if (j2 >= 0) STORET(cur ^ 1, krB, vrB, crB);
        __syncthreads();
        if (j2 < 0) break;
        cur ^= 1; j0 = j2; j1 = j3;
    }
#undef POP
#undef ACTIVE
#undef LOADT
#undef STORET
}
DI void zero_o(f32x16 (&oT)[2]) {
#pragma unroll
    for (int r = 0; r < 16; ++r) { oT[0][r] = 0.f; oT[1][r] = 0.f; }
}

template <bool ONLINE> DI void nsa_unit(const Args& a, int l, unsigned char* lds, int b, int g, int c) {
    unsigned char* ws = a.ws;
    const bf16_t* P = (const bf16_t*)(ws + WS_P); bf16_t* Y = (bf16_t*)(ws + WS_HY); const float* GL = (const float*)(ws + WS_GL);
    ACtx x; x.tid = threadIdx.x; asm volatile("" : "+v"(x.tid));
    const int lane = x.tid & 63, wid = __builtin_amdgcn_readfirstlane(x.tid >> 6); x.r32 = lane & 31; x.hi = lane >> 5;
    const int hq = 4 * g + (wid & 3), tokl = 32 * (wid >> 2) + x.r32; x.tok = 64 * c + tokl;
    const size_t row = (size_t)(b * SEQ + x.tok);
    load_q(x, P + row * PP + C_NQ + hq * 64);
#define GATE(k) sigmoidf_(GL[row * 32 + hq * 3 + (k)] + a.in[I_GB][l * 24 + hq * 3 + (k)])
    float* IG = (float*)(lds + A_IG); float* IL = (float*)(lds + A_IL); unsigned* SELM = (unsigned*)(lds + A_SELM); unsigned* UN = (unsigned*)(lds + A_UN);
    if (x.tid == 0) UN[0] = 0u;
    f32x16 oT[2], tot[2]; zero_o(oT); zero_o(tot);
    float m = -1e30f, ls = 0.f;
    const float* bnd = (const float*)(ws + WS_BND) + l * 4;
    const float b_cmp = bnd[0], b_slc = bnd[1], b_win = bnd[2];
    constexpr bool online = ONLINE;
#define BRANCH(MODE, ...) do { attn_branch<MODE, ONLINE>(__VA_ARGS__); } while (0)
    const bf16_t* KC = (const bf16_t*)(ws + WS_KCMP) + (size_t)(b * 2 + g) * 128 * 64; const bf16_t* VC = (const bf16_t*)(ws + WS_VCMP) + (size_t)(b * 2 + g) * 128 * 64;
    const int ncmpt = c >= 16 ? 2 : 1;
    BRANCH(0, lds, KC, 64, VC, 64, nullptr, 0, c >= 16 ? 3u : 1u, x, 0u, c, 0, 0, b_cmp, 0.f, oT, m, ls);
    const float cref = online ? m : b_cmp;
    {   float lt = ls + __shfl_xor(ls, 32); const float inv = lt > 0.f ? 1.f / lt : 0.f; const float g0 = GATE(0);
#pragma unroll
        for (int r = 0; r < 16; ++r) { tot[0][r] = oT[0][r] * (inv * g0); tot[1][r] = oT[1][r] * (inv * g0); }
        for (int tt = 0; tt < ncmpt; ++tt) {
            const bf16_t* KB = (const bf16_t*)(lds + A_KB) + tt * 4608;
            f32x16 p0, p1;
#pragma unroll
            for (int i = 0; i < 16; ++i) { p0[i] = -cref; p1[i] = -cref; }
#pragma unroll
            for (int d0 = 0; d0 < 4; ++d0) {
                const bf16x8 k0 = *(const bf16x8*)(KB + x.r32 * 72 + d0 * 16 + x.hi * 8); const bf16x8 k1 = *(const bf16x8*)(KB + (32 + x.r32) * 72 + d0 * 16 + x.hi * 8);
                p0 = __builtin_amdgcn_mfma_f32_32x32x16_bf16(k0, x.qr[d0], p0, 0, 0, 0); p1 = __builtin_amdgcn_mfma_f32_32x32x16_bf16(k1, x.qr[d0], p1, 0, 0, 0);
            }
            const int kb = 64 * tt + 4 * x.hi;
#pragma unroll
            for (int r = 0; r < 16; ++r) { const int n = kb + (r & 3) + 8 * (r >> 2);
                p0[r] = (16 * n + 31 <= x.tok) ? __builtin_amdgcn_exp2f(p0[r]) * inv : 0.f; p1[r] = (16 * (n + 32) + 31 <= x.tok) ? __builtin_amdgcn_exp2f(p1[r]) * inv : 0.f; }
            float* ig = IG + ((wid & 3) * 64 + tokl) * 33; float* il = IL + ((wid & 3) * 64 + tokl) * 33;
#pragma unroll
            for (int q = 0; q < 4; ++q) { const int jj = 16 * tt + 2 * q + x.hi;
                ig[jj] = p0[4 * q] + p0[4 * q + 1] + p0[4 * q + 2] + p0[4 * q + 3]; il[jj] = p0[4 * q + 3];
                ig[jj + 8] = p1[4 * q] + p1[4 * q + 1] + p1[4 * q + 2] + p1[4 * q + 3]; il[jj + 8] = p1[4 * q + 3]; }
        }
    }
    __syncthreads();
    {   int j = lane & 31; asm volatile("" : "+v"(j));
        unsigned wor = 0u;
#pragma unroll
        for (int it = 0; it < 4; ++it) {
            const int tl = 8 * wid + 2 * it + (lane >> 5);
            float imp = 0.f;
#pragma unroll
            for (int h4 = 0; h4 < 4; ++h4) { imp += IG[(h4 * 64 + tl) * 33 + j]; if (j > 0) imp += IL[(h4 * 64 + tl) * 33 + j - 1]; }
            const bool valid = j <= c, forced = (j == 0) || (j == c) || (j == c - 1);
            const float score = !valid ? -1e30f : (forced ? 1e9f : imp);
            float* scw = (float*)(lds + A_SC) + wid * 64;
            scw[lane] = score;
            __builtin_amdgcn_s_waitcnt(0xc07f); __builtin_amdgcn_wave_barrier();
            int rank = 0;
#pragma unroll
            for (int k4 = 0; k4 < 8; ++k4) { const f32x4 sk = *(const f32x4*)(scw + (lane & 32) + 4 * k4);
#pragma unroll
                for (int i = 0; i < 4; ++i) rank += (sk[i] > score) || (sk[i] == score && 4 * k4 + i < j); }
            __builtin_amdgcn_wave_barrier();
            const unsigned long long bal = __ballot(valid && rank < 16);
            const unsigned mine = (lane >> 5) ? (unsigned)(bal >> 32) : (unsigned)bal;
            if (j == 0) SELM[tl] = mine;
            wor |= (unsigned)bal | (unsigned)(bal >> 32);
        }
        if (lane == 0) atomicOr(UN, wor);
    }
    __syncthreads();
    const unsigned selm = SELM[tokl]; const unsigned un = UN[0];
    float* TOT = (float*)(lds + A_IG) + wid * 2048 + lane;
#pragma unroll
    for (int r = 0; r < 16; ++r) { TOT[r * 64] = tot[0][r]; TOT[(16 + r) * 64] = tot[1][r]; }
    zero_o(oT); m = -1e30f; ls = 0.f;
    BRANCH(1, lds, P + (size_t)b * SEQ * PP + C_KS + g * 64, PP, P + (size_t)b * SEQ * PP + C_VS + g * 64, PP, nullptr, 0, un, x, selm, c, 0, 0, b_slc, 0.f, oT, m, ls);
    {   float lt = ls + __shfl_xor(ls, 32); const float inv = lt > 0.f ? GATE(1) / lt : 0.f;
#pragma unroll
        for (int r = 0; r < 16; ++r) { TOT[r * 64] += oT[0][r] * inv; TOT[(16 + r) * 64] += oT[1][r] * inv; } }
    zero_o(oT); m = -1e30f; ls = 0.f;
    {   const int jlo = c >= 8 ? c - 8 : 0; const unsigned wt = (c >= 31 ? 0xffffffffu : ((1u << (c + 1)) - 1u)) & ~((1u << jlo) - 1u);
        BRANCH(2, lds, P + (size_t)b * SEQ * PP + C_KW + g * 64, PP, P + (size_t)b * SEQ * PP + C_VW + g * 64, PP, nullptr, 64, wt, x, 0u, c, 0, 0, b_win, 0.f, oT, m, ls); }
    {   float lt = ls + __shfl_xor(ls, 32); const float inv = lt > 0.f ? GATE(2) / lt : 0.f;
#pragma unroll
        for (int r = 0; r < 16; ++r) { tot[0][r] = TOT[r * 64] + oT[0][r] * inv; tot[1][r] = TOT[(16 + r) * 64] + oT[1][r] * inv; } }
#pragma unroll
    for (int dh = 0; dh < 2; ++dh)
#pragma unroll
        for (int q = 0; q < 4; ++q) {
            const int d = 32 * dh + 8 * q + 4 * x.hi;
            const u32x2 zz = *(const u32x2*)(P + row * PP + C_NZ + hq * 64 + d);
            const float z0 = bf2f(zz[0] & 0xffffu), z1 = bf2f(zz[0] >> 16), z2 = bf2f(zz[1] & 0xffffu), z3 = bf2f(zz[1] >> 16);
            u32x2 o; o[0] = cvtpk(tot[dh][4 * q] * siluf_(z0), tot[dh][4 * q + 1] * siluf_(z1)); o[1] = cvtpk(tot[dh][4 * q + 2] * siluf_(z2), tot[dh][4 * q + 3] * siluf_(z3));
            *(u32x2*)(Y + row * DMIX + 512 + hq * 64 + d) = o;
        }
}

template <bool ONLINE> DI void fox_unit(const Args& a, int l, unsigned char* lds, int b, int h, int c) {
    unsigned char* ws = a.ws;
    const bf16_t* P = (const bf16_t*)(ws + WS_P); bf16_t* Y = (bf16_t*)(ws + WS_HY);
    ACtx x; x.tid = threadIdx.x; asm volatile("" : "+v"(x.tid));
    const int lane = x.tid & 63, wid = __builtin_amdgcn_readfirstlane(x.tid >> 6); x.r32 = lane & 31; x.hi = lane >> 5;
    x.tok = 256 * c + 32 * wid + x.r32;
    const size_t row = (size_t)(b * SEQ + x.tok);
    load_q(x, P + row * PP + C_FQ + h * 64);
    const float* c2 = (const float*)(ws + WS_C2) + (size_t)(b * 8 + h) * SEQ;
    f32x16 oT[2]; zero_o(oT); float m = -1e30f, ls = 0.f;
    const int ntile = 4 * c + 4; const unsigned tiles = ntile >= 32 ? 0xffffffffu : ((1u << ntile) - 1u);
    unsigned tiles_ = tiles;
    if (!ONLINE) {
        const float cj = c2[64 * (lane & 31) + 63], c0 = c2[256 * c];
        tiles_ &= ~(unsigned)__ballot((lane < 32) && (c0 - cj <= -152.f));
    }
    const float b_fox = ((const float*)(ws + WS_BND))[l * 4 + 3]; const float ctb = c2[x.tok] - b_fox;
    attn_branch<3, ONLINE>(lds, P + (size_t)b * SEQ * PP + C_FK + h * 64, PP, P + (size_t)b * SEQ * PP + C_FV + h * 64, PP, c2, 0, tiles_, x, 0u, 0, 256 * c + 32 * wid, 256 * c + 32 * wid + 31, b_fox, ctb, oT, m, ls);
    float lt = ls + __shfl_xor(ls, 32); const float inv = lt > 0.f ? 1.f / lt : 0.f;
#pragma unroll
    for (int dh = 0; dh < 2; ++dh)
#pragma unroll
        for (int q = 0; q < 4; ++q) {
            const int d = 32 * dh + 8 * q + 4 * x.hi;
            const u32x2 zz = *(const u32x2*)(P + row * PP + C_FZ + h * 64 + d);
            const float z0 = bf2f(zz[0] & 0xffffu), z1 = bf2f(zz[0] >> 16), z2 = bf2f(zz[1] & 0xffffu), z3 = bf2f(zz[1] >> 16);
            u32x2 o; o[0] = cvtpk(oT[dh][4 * q] * inv * siluf_(z0), oT[dh][4 * q + 1] * inv * siluf_(z1)); o[1] = cvtpk(oT[dh][4 * q + 2] * inv * siluf_(z2), oT[dh][4 * q + 3] * inv * siluf_(z3));
            *(u32x2*)(Y + row * DMIX + 1024 + h * 64 + d) = o;
        }
}


constexpr int L_WA = 0, L_WX = 9216, L_XB = 18432, L_XF = 27648, L_G = 44032, L_SA = L_G + 2 * 64 * 65 * 4, L_SB = L_SA + 2048, L_CY = L_SB + 2048, L_END = L_CY + 512;
static_assert(L_END <= LDS_BYTES, "LRU LDS map");
DI float fsig(float x) { return __builtin_amdgcn_rcpf(1.f + __expf(-x)); }
DI float neg_expm1(float x, float ex) {
    const float t = x * (1.f + x * (0.5f + x * (0.16666667f + x * (0.041666668f + x * (0.0083333338f + x * 0.0013888889f)))));
    return (x > -0.25f) ? -t : 1.f - ex;
}
DI void lru_unit(const Args& a, int l, unsigned char* lds, int b, int h) {
    unsigned char* ws = a.ws;
    const bf16_t* P = (const bf16_t*)(ws + WS_P); bf16_t* Y = (bf16_t*)(ws + WS_HY);
    int tid = threadIdx.x; asm volatile("" : "+v"(tid));
    const int lane = tid & 63, wid = __builtin_amdgcn_readfirstlane(tid >> 6);
    bf16_t* WAl = (bf16_t*)(lds + L_WA); bf16_t* WXl = (bf16_t*)(lds + L_WX); bf16_t* XB = (bf16_t*)(lds + L_XB);
    float* XF = (float*)(lds + L_XF); float* G = (float*)(lds + L_G); float* SA = (float*)(lds + L_SA); float* SB = (float*)(lds + L_SB); float* CY = (float*)(lds + L_CY);
    __syncthreads();
    {   const int r = tid >> 3, c8 = (tid & 7) * 8;
        *(u32x4*)(WAl + r * 72 + c8) = *(const u32x4*)((const bf16_t*)(ws + WS_WA) + (size_t)(l * 8 + h) * 4096 + r * 64 + c8);
        *(u32x4*)(WXl + r * 72 + c8) = *(const u32x4*)((const bf16_t*)(ws + WS_WX) + (size_t)(l * 8 + h) * 4096 + r * 64 + c8);
        if (tid < 128) CY[tid] = 0.f; }
    const int tk1 = tid >> 3, c8 = (tid & 7) * 8, chb = h * 64 + c8;
    float cw[4][8], cb8[8];
#pragma unroll
    for (int i = 0; i < 8; ++i) { cb8[i] = a.in[I_CB][l * 512 + chb + i];
#pragma unroll
        for (int k = 0; k < 4; ++k) cw[k][i] = a.in[I_CW][(l * 4 + k) * 512 + chb + i]; }
    const int ch = tid & 63, sg = tid >> 6, chg = h * 64 + ch;
    const float ba = a.in[I_BA][l * 512 + chg], bx = a.in[I_BX][l * 512 + chg], lam = a.in[I_LAM][l * 512 + chg];
    const float sp8 = -8.f * (fmaxf(-lam, 0.f) + log1pf(__expf(-fabsf(lam))));
    const int fr = lane & 15, fq = lane >> 4, mat = wid >> 2, strip = wid & 3;
    const bf16_t* pu = P + (size_t)b * SEQ * PP + C_U + chb;
    u32x4 ur[4];
#pragma unroll
    for (int k = 0; k < 4; ++k) { const int t = tk1 - 3 + k; ur[k] = (t >= 0) ? *(const u32x4*)(pu + (size_t)t * PP) : (u32x4){0u, 0u, 0u, 0u}; }
    for (int tile = 0; tile < SEQ / 64; ++tile) {
        const int t0 = tile * 64;
        {   float xc[8];
#pragma unroll
            for (int i = 0; i < 8; ++i) xc[i] = cb8[i];
#pragma unroll
            for (int k = 0; k < 4; ++k) { float uf[8]; unpack8(ur[k], uf);
#pragma unroll
                for (int i = 0; i < 8; ++i) xc[i] += cw[k][i] * uf[i]; }
            *(f32x4*)(XF + tk1 * 64 + c8) = (f32x4){xc[0], xc[1], xc[2], xc[3]}; *(f32x4*)(XF + tk1 * 64 + c8 + 4) = (f32x4){xc[4], xc[5], xc[6], xc[7]};
            u32x4 pk; pk[0] = pk2(xc[0], xc[1]); pk[1] = pk2(xc[2], xc[3]); pk[2] = pk2(xc[4], xc[5]); pk[3] = pk2(xc[6], xc[7]);
            *(u32x4*)(XB + tk1 * 72 + c8) = pk;
            if (tile + 1 < SEQ / 64) {
#pragma unroll
                for (int k = 0; k < 4; ++k) ur[k] = *(const u32x4*)(pu + (size_t)(t0 + 64 + tk1 - 3 + k) * PP);
            }
        }
        __syncthreads();
        {   const bf16_t* W = mat ? WXl : WAl;
            f32x4 acc[4];
#pragma unroll
            for (int nt = 0; nt < 4; ++nt) acc[nt] = (f32x4){0.f, 0.f, 0.f, 0.f};
#pragma unroll
            for (int ks = 0; ks < 2; ++ks) {
                const bf16x8 af = *(const bf16x8*)(XB + (16 * strip + fr) * 72 + ks * 32 + fq * 8);
#pragma unroll
                for (int nt = 0; nt < 4; ++nt) { const bf16x8 bw = *(const bf16x8*)(W + (16 * nt + fr) * 72 + ks * 32 + fq * 8); acc[nt] = __builtin_amdgcn_mfma_f32_16x16x32_bf16(af, bw, acc[nt], 0, 0, 0); }
            }
            float* Gm = G + mat * 64 * 65;
#pragma unroll
            for (int nt = 0; nt < 4; ++nt)
#pragma unroll
                for (int i = 0; i < 4; ++i) Gm[(16 * strip + 4 * fq + i) * 65 + 16 * nt + fr] = acc[nt][i];
        }
        __syncthreads();
        {   const bf16_t* pz = P + (size_t)(b * SEQ + t0 + sg * 8) * PP + C_Z + chg;
            bf16_t zr[8];
#pragma unroll
            for (int k = 0; k < 8; ++k) zr[k] = pz[(size_t)k * PP];
            float av[8], bv[8]; float A = 1.f, Bc = 0.f;
#pragma unroll
            for (int k = 0; k < 8; ++k) {
                const int tk = sg * 8 + k;
                const float r = fsig(G[tk * 65 + ch] + ba), ig = fsig(G[64 * 65 + tk * 65 + ch] + bx), xcv = XF[tk * 64 + ch];
                const float la = r * sp8;
                av[k] = __expf(la); bv[k] = __builtin_amdgcn_sqrtf(neg_expm1(2.f * la, av[k] * av[k])) * (ig * xcv);
                Bc = av[k] * Bc + bv[k]; A *= av[k];
            }
            SA[sg * 64 + ch] = A; SB[sg * 64 + ch] = Bc;
            __syncthreads();
            float hs = CY[(tile & 1) * 64 + ch];
            for (int s = 0; s < sg; ++s) hs = SA[s * 64 + ch] * hs + SB[s * 64 + ch];
            bf16_t* py = Y + (size_t)(b * SEQ + t0 + sg * 8) * DMIX + chg;
#pragma unroll
            for (int k = 0; k < 8; ++k) { hs = av[k] * hs + bv[k]; const float zf = bf2f(zr[k]); py[(size_t)k * DMIX] = (bf16_t)f2bf(hs * zf * fsig(zf)); }
            if (sg == 7) CY[((tile & 1) ^ 1) * 64 + ch] = hs;
        }
    }
    __syncthreads();
}


template <bool ONLINE> DI void phase_mix(const Args& a, int l, unsigned char* lds, int cofs = 0, bool only_lru = false) {
    unsigned* ctr = (unsigned*)(a.ws + WS_CTL) + l * 16 + cofs;
    volatile int* UNIT = (volatile int*)(lds + A_UNIT);
    if (blockIdx.x < 128) lru_unit(a, l, lds, blockIdx.x >> 3, blockIdx.x & 7);
    if (only_lru) return;
    __syncthreads();
    if (threadIdx.x == 0) UNIT[0] = (int)atomicAdd(ctr, 1u);
    __syncthreads();
    for (int u = UNIT[0]; u < 1024; ) {
        int nxt = 0; if (threadIdx.x == 0) nxt = (int)atomicAdd(ctr, 1u);
        nsa_unit<ONLINE>(a, l, lds, (u & 31) >> 1, u & 1, 31 - (u >> 5));
        if (threadIdx.x == 0) UNIT[0] = nxt;
        __syncthreads();
        u = UNIT[0];
    }
    __syncthreads();
    if (threadIdx.x == 0) UNIT[0] = (int)atomicAdd(ctr + 1, 1u);
    __syncthreads();
    for (int u = UNIT[0]; u < 1024; ) {
        int nxt = 0; if (threadIdx.x == 0) nxt = (int)atomicAdd(ctr + 1, 1u);
        fox_unit<ONLINE>(a, l, lds, (u & 127) >> 3, u & 7, 7 - (u >> 7));
        if (threadIdx.x == 0) UNIT[0] = nxt;
        __syncthreads();
        u = UNIT[0];
    }
}

#define XB_TMO      128
#define XB_XCNT(j)  (256  + 64 * (j))
#define XB_XSUB(j)  (1280 + 64 * (j))
#define XB_XGEN(j)  (2304 + 64 * (j))
#define XB_TOP      3328
#define XB_TOPGEN   3392
#define XCD_BAR_WORDS 3456
#define XB_SPIN_CAP (1u << 18)
DI unsigned xb_ld(unsigned* p)              { return __hip_atomic_load(p, __ATOMIC_RELAXED, __HIP_MEMORY_SCOPE_AGENT); }
DI unsigned xb_add(unsigned* p, unsigned v) { return __hip_atomic_fetch_add(p, v, __ATOMIC_RELAXED, __HIP_MEMORY_SCOPE_AGENT); }
DI unsigned xb_xcc_id() { return (unsigned)__builtin_amdgcn_s_getreg((3 << 11) | 20) & 0xFu; }
#define XB_SPIN(cond, bar) do { unsigned _sp = 0; while (cond) { __builtin_amdgcn_s_sleep(1); \
    if ((++_sp & 255u) == 0u) { if (xb_ld(&(bar)[XB_TMO])) break; if (_sp > XB_SPIN_CAP) { atomicAdd(&(bar)[XB_TMO], 1u); break; } } } } while (0)
struct XcdBarrier { unsigned* bar; unsigned x; volatile LAS3 unsigned* st; };
DI XcdBarrier xcd_barrier_post(unsigned* bar, volatile LAS3 unsigned* st) {
    XcdBarrier b; b.bar = bar; b.x = xb_xcc_id(); b.st = st;
    if (threadIdx.x == 0) (void)xb_add(&bar[XB_XCNT(b.x)], 1u);
    return b;
}
DI void xcd_barrier_complete(unsigned* bar, unsigned x, unsigned& nloc, unsigned& nx) {
    const unsigned G = gridDim.x * gridDim.y * gridDim.z;
    unsigned sum, cnt, mine, sp = 0u;
    for (;;) {
        sum = 0u; cnt = 0u; mine = 0u;
#pragma unroll
        for (unsigned j = 0; j < 16; ++j) { const unsigned c = xb_ld(&bar[XB_XCNT(j)]); sum += c; cnt += (c > 0u) ? 1u : 0u; mine = (j == x) ? c : mine; }
        if (sum == G) break;
        __builtin_amdgcn_s_sleep(1);
        if ((++sp & 255u) == 0u) { if (xb_ld(&bar[XB_TMO])) break; if (sp > XB_SPIN_CAP) { atomicAdd(&bar[XB_TMO], 1u); break; } }
    }
    nloc = mine > 0u ? mine : 1u; nx = cnt > 0u ? cnt : 1u;
}
DI void xcd_barrier(const XcdBarrier& b) {
    asm volatile("s_waitcnt vmcnt(0)" ::: "memory");
    __syncthreads();
    if (threadIdx.x == 0) {
        unsigned* bar = b.bar;
        __builtin_amdgcn_s_waitcnt(0);
        unsigned nloc = b.st[0], nx = b.st[1];
        if (nloc == 0u) { xcd_barrier_complete(bar, b.x, nloc, nx); b.st[0] = nloc; b.st[1] = nx; }
        const unsigned old = xb_add(&bar[XB_XSUB(b.x)], 1u);
        const unsigned gen = old / nloc;
        if (old + 1u == (gen + 1u) * nloc) {
            __builtin_amdgcn_fence(__ATOMIC_RELEASE, "agent");
            asm volatile("s_waitcnt vmcnt(0)" ::: "memory");
            const unsigned og = xb_add(&bar[XB_TOP], 1u);
            const unsigned tg = og / nx;
            if (og + 1u == (tg + 1u) * nx) xb_add(&bar[XB_TOPGEN], 1u);
            else XB_SPIN(xb_ld(&bar[XB_TOPGEN]) == tg, bar);
            __builtin_amdgcn_fence(__ATOMIC_ACQUIRE, "agent");
            xb_add(&bar[XB_XGEN(b.x)], 1u);
            asm volatile("s_waitcnt vmcnt(0)" ::: "memory");
        } else {
            XB_SPIN(xb_ld(&bar[XB_XGEN(b.x)]) == gen, bar);
            __builtin_amdgcn_fence(__ATOMIC_ACQUIRE, "agent");
            asm volatile("s_waitcnt vmcnt(0)" ::: "memory");
        }
    }
    __syncthreads();
}

#ifndef DUP
#define DUP 0
#endif
#define LP_PTRS unsigned char* ws = a.ws; bf16_t* P = (bf16_t*)(ws + WS_P); bf16_t* HY = (bf16_t*)(ws + WS_HY); bf16_t* H = (bf16_t*)(ws + WS_H); float* SS = (float*)(ws + WS_SS); float* GL = (float*)(ws + WS_GL); const float* xin = L ? a.out : a.in[I_X]; (void)P; (void)HY; (void)H; (void)SS; (void)GL; (void)xin
template <int L> DI void layer_phases(const Args& a, const XcdBarrier& bar, unsigned char* lds) {
    {   LP_PTRS; const bf16_t* W = (const bf16_t*)(ws + WS_WIN) + (size_t)L * NPAD * DM;
        pg8::Gemm g{H, W, NT, PP, DM}; pg8::StaticOrder S; S.init(NT, PP, (int)gridDim.x, (int)blockIdx.x);
        pg8::EpiProjF E{P, L ? SS : nullptr, (PG8_LAS float*)((PG8_LAS unsigned char*)lds + pg8::STAGE_BYTES), (const float*)(ws + WS_GAINS) + L * 320}; pg8::gemm_phase<pg8::EpiProjF, pg8::StaticOrder, true, true>((PG8_LAS unsigned char*)lds, g, S, E);
        gates_gemm(H, W + (size_t)PP * DM, GL, L ? SS : nullptr, L == 1);
        if (L == 0) { __syncthreads(); win1_late(a, (float*)lds); }
        if (DUP == 2 && L == 0) { xcd_barrier(bar); pg8::gemm_phase<pg8::EpiProjF, pg8::StaticOrder, true, true>((PG8_LAS unsigned char*)lds, g, S, E); gates_gemm(H, W + (size_t)PP * DM, GL, L ? SS : nullptr, false); } }
    xcd_barrier(bar);
    {   LP_PTRS; prep_cumsum(a, L, (float*)lds); prep_compress(a, L, P); if (L == 0) { __syncthreads(); phase_wprep(a, (float*)lds, 1); }
        if (DUP == 3 && L == 0) { xcd_barrier(bar); prep_cumsum(a, L, (float*)lds); prep_compress(a, L, P); } }
    xcd_barrier(bar);
    {   const float* bnd = (const float*)(a.ws + WS_BND) + L * 4;
        const bool online = fmaxf(fmaxf(bnd[0], bnd[1]), fmaxf(bnd[2], bnd[3])) > 60.f;
        if (online) phase_mix<true>(a, L, lds); else phase_mix<false>(a, L, lds);
        if (DUP == 4 && L == 0) { xcd_barrier(bar); phase_mix<false>(a, L, lds, 4); } }
    xcd_barrier(bar);
    {   LP_PTRS; pg8::Gemm g{HY, (const bf16_t*)(ws + WS_WOUT) + (size_t)L * DM * DMIX, NT, DM, DMIX}; pg8::StaticOrder S; S.init(NT, DM, (int)gridDim.x, (int)blockIdx.x);
        pg8::EpiOutF E{L ? nullptr : a.in[I_X], L ? H : nullptr, L ? a.out : nullptr, L ? nullptr : H, SS}; pg8::gemm_phase<pg8::EpiOutF, pg8::StaticOrder, true, true>((PG8_LAS unsigned char*)lds, g, S, E); }
}
__global__ void __launch_bounds__(512, 2) mk(Args a) {
    extern __shared__ __attribute__((aligned(16))) unsigned char lds[];
    __shared__ unsigned xb_st[2];
    cg::grid_group grid = cg::this_grid();
    if (threadIdx.x < 2) xb_st[threadIdx.x] = 0u;
    __syncthreads();
    const XcdBarrier bar = xcd_barrier_post((unsigned*)(a.ws + WS_CTL + 1024), (volatile LAS3 unsigned*)xb_st);
    phase_wprep(a, (float*)lds, 0);
    phase_rms(a.in[I_X], a.in[I_NG], (bf16_t*)(a.ws + WS_H));
    for (int i = blockIdx.x * 512 + threadIdx.x; i < NT; i += gridDim.x * 512) ((float*)(a.ws + WS_SS))[i] = 0.f;
    if (a.ph_lo < 0) grid.sync();
    xcd_barrier(bar);
    layer_phases<0>(a, bar, lds);
    xcd_barrier(bar);
    layer_phases<1>(a, bar, lds);
}

extern "C" void kernel_launch(void* const* d_in, const int* in_sizes, int n_in, void* d_out, int out_size, void* d_ws, size_t ws_size, hipStream_t stream) {
    static int grid = 0;
    if (grid == 0) {
        if (n_in != 21 || ws_size < WS_END) { fprintf(stderr, "kernel_launch: unexpected n_in %d / ws_size %zu (need %zu)\n", n_in, ws_size, (size_t)WS_END); grid = -1; return; }
        int dev = 0, cus = 0, per_cu = 0;
        (void)hipGetDevice(&dev); (void)hipDeviceGetAttribute(&cus, hipDeviceAttributeMultiprocessorCount, dev);
        (void)hipFuncSetAttribute((const void*)mk, hipFuncAttributeMaxDynamicSharedMemorySize, LDS_BYTES);
        (void)hipOccupancyMaxActiveBlocksPerMultiprocessor(&per_cu, (const void*)mk, 512, LDS_BYTES);
        if (per_cu < 1) { fprintf(stderr, "kernel_launch: occupancy query says %d blocks/CU\n", per_cu); per_cu = 1; }
        if (per_cu > 1) per_cu = 1;
        grid = cus * per_cu;
        (void)hipGetLastError();
    }
    if (grid < 0) return;
    if (hipMemsetAsync((char*)d_ws + WS_CTL, 0, WS_CTL_BYTES, stream) != hipSuccess) { fprintf(stderr, "kernel_launch: memset failed\n"); return; }
    Args a{};
    for (int i = 0; i < 21; ++i) a.in[i] = (const float*)d_in[i];
    a.out = (float*)d_out; a.ws = (unsigned char*)d_ws; a.ph_lo = 0; a.ph_hi = 13;
    void* args[] = {&a};
    hipError_t e = hipLaunchCooperativeKernel((const void*)mk, dim3(grid), dim3(512), args, LDS_BYTES, stream);
    if (e != hipSuccess) fprintf(stderr, "cooperative launch failed: %s (grid %d)\n", hipGetErrorString(e), grid);
}
```

```cpp
#define DUP 0
#include <hip/hip_runtime.h>
#include <hip/hip_cooperative_groups.h>
#include <stdint.h>
#include <stdio.h>
namespace cg = cooperative_groups;

#define DI __device__ __forceinline__
typedef unsigned short bf16_t;
typedef short bf16x8 __attribute__((ext_vector_type(8)));
typedef float f32x4 __attribute__((ext_vector_type(4)));
typedef float f32x16 __attribute__((ext_vector_type(16)));
typedef unsigned u32x4 __attribute__((ext_vector_type(4)));
typedef unsigned u32x2 __attribute__((ext_vector_type(2)));

constexpr int NB = 16, SEQ = 2048, DM = 1024, NT = NB * SEQ;
constexpr int DIN = 4896, DMIX = 1536, PP = 4864, NPAD = 5120;
constexpr int C_U = 0, C_Z = 512, C_NQ = 1024, C_KC = 1536, C_VC = 1664, C_KS = 1792, C_VS = 1920, C_KW = 2048, C_VW = 2176,
              C_NZ = 2304, C_FQ = 2816, C_FK = 3328, C_FV = 3840, C_FZ = 4352;
constexpr float LOG2E = 1.4426950408889634f, QS = 0.125f * LOG2E, EPS = 1e-6f;

constexpr size_t WS_P = 0;
constexpr size_t WS_HY = WS_P + (size_t)NT * PP * 2;
constexpr size_t WS_H = WS_HY + (size_t)NT * DMIX * 2;
constexpr size_t WS_SS = WS_H + (size_t)NT * DM * 2;
constexpr size_t WS_GL = WS_SS + (size_t)NT * 4;
constexpr size_t WS_WIN = WS_GL + (size_t)NT * 32 * 4;
constexpr size_t WS_WOUT = WS_WIN + (size_t)2 * NPAD * DM * 2;
constexpr size_t WS_WA = WS_WOUT + (size_t)2 * DM * DMIX * 2;
constexpr size_t WS_WX = WS_WA + 131072;
constexpr size_t WS_WCK = WS_WX + 131072;
constexpr size_t WS_WCV = WS_WCK + 524288;
constexpr size_t WS_BKV = WS_WCV + 524288;
constexpr size_t WS_BND = WS_BKV + 1024;
constexpr size_t WS_GAINS = WS_BKV + 2048;
constexpr size_t WS_C2 = WS_BKV + 8192;
constexpr size_t WS_KCMP = WS_C2 + (size_t)NB * 8 * SEQ * 4;
constexpr size_t WS_VCMP = WS_KCMP + 524288;
constexpr size_t WS_CTL = WS_VCMP + 524288;
constexpr size_t WS_CTL_BYTES = 16384;
constexpr size_t WS_END = WS_CTL + WS_CTL_BYTES;

constexpr int LDS_BYTES = 143360;

struct Args { const float* in[21]; float* out; unsigned char* ws; int ph_lo, ph_hi; };
enum { I_X = 0, I_NG, I_WIN, I_WOUT, I_CW, I_CB, I_WA, I_BA, I_WX, I_BX, I_LAM, I_NQG, I_NKG, I_PEK, I_PEV, I_WCK, I_WCV, I_GB, I_FQG, I_FKG, I_FFB };

DI int opaque_tid() { int t = threadIdx.x; asm volatile("" : "+v"(t)); return t; }
DI unsigned f2bf(float f) { unsigned u = __float_as_uint(f); return (u + 0x7fffu + ((u >> 16) & 1u)) >> 16; }
DI float bf2f(unsigned h) { return __uint_as_float(h << 16); }
DI unsigned pk2(float lo, float hi) { return f2bf(lo) | (f2bf(hi) << 16); }
DI float wave_sum(float v) { for (int o = 32; o; o >>= 1) v += __shfl_xor(v, o); return v; }
DI float sigmoidf_(float x) { return __builtin_amdgcn_rcpf(1.f + __expf(-x)); }
DI float siluf_(float x) { return x * __builtin_amdgcn_rcpf(1.f + __expf(-x)); }
DI void unpack8(u32x4 r, float* f) {
#pragma unroll
    for (int i = 0; i < 4; ++i) { f[2 * i] = bf2f(r[i] & 0xffffu); f[2 * i + 1] = bf2f(r[i] >> 16); }
}

DI int win_col(int pc) {
    if (pc < 2304) return pc; if (pc < 4352) return pc + 24; if (pc < 4864) return pc + 32;
    if (pc < 4888) return 2304 + pc - 4864; if (pc < 4896) return 4376 + pc - 4888; return -1;
}
DI void wtile(const float* src, int ldsrc, bf16_t* dst, int K, int n0, int k0, int mode, float* t, const float* rowg = nullptr) {
    const int tid = opaque_tid();
#pragma unroll
    for (int i = 0; i < 8; ++i) {
        int kk = (tid >> 6) + 8 * i, nn = tid & 63, n = n0 + nn; int oc = mode ? win_col(n) : n;
        t[kk * 65 + nn] = oc >= 0 ? src[(size_t)(k0 + kk) * ldsrc + oc] * (rowg ? rowg[k0 + kk] : 1.f) : 0.f;
    }
    __syncthreads();
    {   const int nn = tid >> 3, k8 = (tid & 7) * 8; u32x4 w;
#pragma unroll
        for (int i = 0; i < 4; ++i) w[i] = pk2(t[(k8 + 2 * i) * 65 + nn], t[(k8 + 2 * i + 1) * 65 + nn]);
        *(u32x4*)(dst + (size_t)(n0 + nn) * K + k0 + k8) = w; }
    __syncthreads();
}
DI void phase_wprep(const Args& a, float* ldsf, int stage) {
    unsigned char* ws = a.ws;
    constexpr int PER = 1280 + 384 + 8 + 8 + 32 + 32 + 2;
    const bool split = gridDim.x >= 256;
    if (stage == 1 && (!split || blockIdx.x < 16)) return;
    const int ub = stage == 1 ? (int)blockIdx.x - 16 : (int)blockIdx.x, us = stage == 1 ? (int)gridDim.x - 16 : (int)gridDim.x;
    for (int u = ub; u < 2 * PER; u += us) {
        int l = u / PER, r = u % PER;
        if (split) {
            const bool early = (l == 0 && r < 1280) || (l == 0 && r >= 1280 + 384 + 16 && r < PER - 2) || (r >= PER - 2);
            const bool late1 = (r >= 1280 && r < 1280 + 384 + 16) || (l == 1 && r >= 1280 + 384 + 16 && r < PER - 2);
            if (stage == 0 ? !early : !late1) continue;
        }
        if (r < 1280) { wtile(a.in[I_WIN] + (size_t)l * DM * DIN, DIN, (bf16_t*)(ws + WS_WIN) + (size_t)l * NPAD * DM, DM, (r % 80) * 64, (r / 80) * 64, 1, ldsf, l ? a.in[I_NG] + DM : nullptr); continue; }
        r -= 1280;
        if (r < 384) { wtile(a.in[I_WOUT] + (size_t)l * DMIX * DM, DM, (bf16_t*)(ws + WS_WOUT) + (size_t)l * DM * DMIX, DMIX, (r % 16) * 64, (r / 16) * 64, 0, ldsf); continue; }
        r -= 384;
        if (r < 8) { wtile(a.in[I_WA] + (size_t)(l * 8 + r) * 4096, 64, (bf16_t*)(ws + WS_WA) + (size_t)(l * 8 + r) * 4096, 64, 0, 0, 0, ldsf); continue; }
        r -= 8;
        if (r < 8) { wtile(a.in[I_WX] + (size_t)(l * 8 + r) * 4096, 64, (bf16_t*)(ws + WS_WX) + (size_t)(l * 8 + r) * 4096, 64, 0, 0, 0, ldsf); continue; }
        r -= 8;
        if (r < 32) { wtile(a.in[I_WCK] + (size_t)l * 131072, 64, (bf16_t*)(ws + WS_WCK) + (size_t)l * 131072, 2048, 0, r * 64, 0, ldsf); continue; }
        r -= 32;
        if (r < 32) { wtile(a.in[I_WCV] + (size_t)l * 131072, 64, (bf16_t*)(ws + WS_WCV) + (size_t)l * 131072, 2048, 0, r * 64, 0, ldsf); continue; }
        r -= 32;
        {
            const float* pe = a.in[r ? I_PEV : I_PEK] + (size_t)l * 2048; const float* w = a.in[r ? I_WCV : I_WCK] + (size_t)l * 131072;
            const int e = threadIdx.x & 63, part = threadIdx.x >> 6; float s = 0.f;
#pragma unroll 16
            for (int k = part * 256; k < part * 256 + 256; ++k) s += pe[k] * w[(size_t)k * 64 + e];
            ldsf[part * 64 + e] = s; __syncthreads();
            if (threadIdx.x < 64) { float t = 0.f; for (int p = 0; p < 8; ++p) t += ldsf[p * 64 + e]; ((float*)(ws + WS_BKV))[(l * 2 + r) * 64 + e] = t; }
            if (r == 1 && threadIdx.x < 64) { float* gn = (float*)(ws + WS_GAINS) + l * 320;
                gn[e] = a.in[I_NQG][l * 64 + e] * QS; gn[64 + e] = a.in[I_NKG][(l * 3 + 1) * 64 + e]; gn[128 + e] = a.in[I_NKG][(l * 3 + 2) * 64 + e]; gn[192 + e] = a.in[I_FQG][l * 64 + e] * QS; gn[256 + e] = a.in[I_FKG][l * 64 + e]; }
            if (r == 0 && threadIdx.x < 64) {
                float gq = fabsf(a.in[I_NQG][l * 64 + e]), k0 = fabsf(a.in[I_NKG][(l * 3 + 0) * 64 + e]), k1 = fabsf(a.in[I_NKG][(l * 3 + 1) * 64 + e]), k2 = fabsf(a.in[I_NKG][(l * 3 + 2) * 64 + e]);
                float fq = fabsf(a.in[I_FQG][l * 64 + e]), fk = fabsf(a.in[I_FKG][l * 64 + e]);
                for (int o = 32; o; o >>= 1) { gq = fmaxf(gq, __shfl_xor(gq, o)); k0 = fmaxf(k0, __shfl_xor(k0, o)); k1 = fmaxf(k1, __shfl_xor(k1, o)); k2 = fmaxf(k2, __shfl_xor(k2, o)); fq = fmaxf(fq, __shfl_xor(fq, o)); fk = fmaxf(fk, __shfl_xor(fk, o)); }
                if (e == 0) { float* bnd = (float*)(ws + WS_BND) + l * 4; bnd[0] = QS * 64.f * gq * k0 * 1.01f + 0.5f; bnd[1] = QS * 64.f * gq * k1 * 1.01f + 0.5f; bnd[2] = QS * 64.f * gq * k2 * 1.01f + 0.5f; bnd[3] = QS * 64.f * fq * fk * 1.01f + 0.5f; }
            }
            __syncthreads();
        }
    }
}

DI void win1_late(const Args& a, float* ldsf) {
    if (gridDim.x < 256 || blockIdx.x < 128) return;
    for (int r = (int)blockIdx.x - 128; r < 1280; r += (int)gridDim.x - 128)
        wtile(a.in[I_WIN] + (size_t)DM * DIN, DIN, (bf16_t*)(a.ws + WS_WIN) + (size_t)NPAD * DM, DM, (r % 80) * 64, (r / 80) * 64, 1, ldsf, a.in[I_NG] + DM);
}

DI void phase_rms(const float* x, const float* g, bf16_t* H) {
    const int tid_ = opaque_tid(); const int lane = tid_ & 63, wid = tid_ >> 6;
    const int stride = gridDim.x * 8;
    int row = blockIdx.x * 8 + wid;
    f32x4 v[4], vn[4];
    if (row < NT) {
#pragma unroll
        for (int i = 0; i < 4; ++i) vn[i] = ((const f32x4*)(x + (size_t)row * DM))[lane + 64 * i];
    }
    for (; row < NT; row += stride) {
#pragma unroll
        for (int i = 0; i < 4; ++i) v[i] = vn[i];
        if (row + stride < NT) {
#pragma unroll
            for (int i = 0; i < 4; ++i) vn[i] = ((const f32x4*)(x + (size_t)(row + stride) * DM))[lane + 64 * i];
        }
        float ss = 0.f;
#pragma unroll
        for (int i = 0; i < 4; ++i) ss += v[i][0] * v[i][0] + v[i][1] * v[i][1] + v[i][2] * v[i][2] + v[i][3] * v[i][3];
        ss = wave_sum(ss);
        const float r = rsqrtf(ss * (1.f / DM) + EPS);
#pragma unroll
        for (int i = 0; i < 4; ++i) {
            const f32x4 gg = ((const f32x4*)g)[lane + 64 * i];
            u32x2 o; o[0] = pk2(v[i][0] * r * gg[0], v[i][1] * r * gg[1]); o[1] = pk2(v[i][2] * r * gg[2], v[i][3] * r * gg[3]);
            *(u32x2*)(H + (size_t)row * DM + (lane + 64 * i) * 4) = o;
        }
    }
}

namespace pg8 {
#define PG8_LAS __attribute__((address_space(3)))
typedef unsigned short bf16_t;
typedef short bf16x8 __attribute__((ext_vector_type(8)));
typedef float f32x4 __attribute__((ext_vector_type(4)));
typedef unsigned u32x4 __attribute__((ext_vector_type(4)));
constexpr int BM = 256, BK = 64, HALF = 128, HTB = HALF * BK * 2  , STAGE_BYTES = 8 * HTB, NXCD = 8, WGM = 8;

__host__ __device__ __forceinline__ int lds_byte(int r, int c) { const int st = (r >> 4) * 2 + (c >> 5), rr = r & 15, cc = c & 31, ob = rr * 64 + cc * 2; return st * 1024 + (ob ^ (((ob >> 9) & 1) << 5)); }
__host__ __device__ __forceinline__ void stage_rc(int b, int& R, int& C) { const int st = b / 1024, sb = b % 1024, swz = sb ^ (((sb >> 9) & 1) << 5); R = (st >> 1) * 16 + swz / 64; C = (st & 1) * 32 + (swz % 64) / 2; }
__host__ __device__ __forceinline__ int perm32(int rho) { const int n = rho >> 4, i = rho & 15; return 8 * (i >> 2) + 4 * n + (i & 3); }

struct Unit { int pm, pn; };
struct Gemm { const bf16_t* A; const bf16_t* Bt; int M, N, K; };

struct StaticOrder {
    int nM, nN, nwg, G, c;
    __host__ __device__ void init(int M, int N, int G_, int c_) { nM = M / BM; nN = N / BM; nwg = nM * nN; G = G_; c = c_; }
    __host__ __device__ bool next(int i, Unit& u) const {
        const long L = (long)i * G + c; if (L >= nwg) return false;
        int wgid = (int)L; { const int q = nwg / NXCD, r = nwg % NXCD, xcd = wgid % NXCD, off = wgid / NXCD; wgid = (xcd < r ? xcd * (q + 1) : r * (q + 1) + (xcd - r) * q) + off; }
        const int nig = WGM * nN, gid = wgid / nig, fm = gid * WGM, gsz = (nM - fm) < WGM ? (nM - fm) : WGM;
        u.pm = fm + ((wgid % nig) % gsz); u.pn = (wgid % nig) / gsz; return true;
    }
    __device__ __forceinline__ void a_ready(const Unit&) const {}
    __device__ __forceinline__ void done(const Unit&) const {}
};
__device__ __forceinline__ unsigned cvt_pk_bf16(float lo, float hi) { unsigned r; asm volatile("v_cvt_pk_bf16_f32 %0, %1, %2" : "=v"(r) : "v"(lo), "v"(hi)); return r; }

struct EpiProjF {
    static constexpr bool PERM = true, AFTER_DRAIN = false;
    bf16_t* P; const float* ss; PG8_LAS float* xs  ; const float* gains  ;
    __device__ __forceinline__ void operator()(const f32x4 (&acc)[2][2][4][2], const Unit& u, int wr, int wc, int fr, int fq) const {
        const int row0 = u.pm * BM + wr * 64 + fr;
        const int col0 = u.pn * BM + wc * 32 + 8 * fq;
        const int pn = u.pn, wid = wr * 4 + wc;
        const bool need = (pn == 4) | (pn == 5) | (pn == 7) | (pn == 8) | ((pn >= 11) & (pn <= 14));
        float hs[2][4][2];
        if (need) {
#pragma unroll
            for (int ai = 0; ai < 2; ++ai)
#pragma unroll
                for (int m = 0; m < 4; ++m)
#pragma unroll
                    for (int bj = 0; bj < 2; ++bj) { const f32x4 v0 = acc[ai][bj][m][0], v1 = acc[ai][bj][m][1];
                        float s = v0[0] * v0[0] + v0[1] * v0[1] + v0[2] * v0[2] + v0[3] * v0[3] + v1[0] * v1[0] + v1[1] * v1[1] + v1[2] * v1[2] + v1[3] * v1[3];
                        s += __shfl_xor(s, 16); s += __shfl_xor(s, 32);
                        hs[ai][m][bj] = s;
                        if (fq == 0) xs[(((wid * 2 + ai) * 4 + m) * 2 + bj) * 16 + fr] = s; }
            asm volatile("s_waitcnt lgkmcnt(0)" ::: "memory");
            __builtin_amdgcn_s_barrier();
        }
        const int kind = (pn <= 5) ? 0 : (pn == 7) ? 1 : (pn == 8) ? 2 : (pn <= 12) ? 3 : 4;
#pragma unroll
        for (int bj = 0; bj < 2; ++bj) {
            const bool hn = need && !((pn == 7 || pn == 8) && bj == 1);
            f32x4 g0 = (f32x4){1.f, 1.f, 1.f, 1.f}, g1 = g0;
            if (hn) { g0 = *(const f32x4*)(gains + kind * 64 + (wc & 1) * 32 + 8 * fq); g1 = *(const f32x4*)(gains + kind * 64 + (wc & 1) * 32 + 8 * fq + 4); }
#pragma unroll
            for (int ai = 0; ai < 2; ++ai)
#pragma unroll
                for (int m = 0; m < 4; ++m) { const int row = row0 + ai * HALF + m * 16;
                    const float rr = ss ? rsqrtf(ss[row] * (1.f / 1024) + 1e-6f) : 1.f;
                    float rs = rr;
                    if (hn) { const float tot = (hs[ai][m][bj] + xs[((((wid ^ 1) * 2 + ai) * 4 + m) * 2 + bj) * 16 + fr]) * rr * rr; rs = rr * rsqrtf(tot * (1.f / 64) + 1e-6f); }
                    const f32x4 v0 = acc[ai][bj][m][0] * rs * g0, v1 = acc[ai][bj][m][1] * rs * g1;
                    u32x4 w; w.x = cvt_pk_bf16(v0[0], v0[1]); w.y = cvt_pk_bf16(v0[2], v0[3]); w.z = cvt_pk_bf16(v1[0], v1[1]); w.w = cvt_pk_bf16(v1[2], v1[3]);
                    *(u32x4*)(P + (size_t)row * 4864 + col0 + bj * HALF) = w; }
        }
    }
};
struct EpiOutF {
    static constexpr bool PERM = true, AFTER_DRAIN = false;
    const float* res32; const bf16_t* res16; float* out32; bf16_t* out16; float* ss;
    __device__ __forceinline__ void operator()(const f32x4 (&acc)[2][2][4][2], const Unit& u, int wr, int wc, int fr, int fq) const {
        const int row0 = u.pm * BM + wr * 64 + fr, col0 = u.pn * BM + wc * 32 + 8 * fq;
#pragma unroll
        for (int ai = 0; ai < 2; ++ai)
#pragma unroll
            for (int m = 0; m < 4; ++m) { const int row = row0 + ai * HALF + m * 16; const size_t off = (size_t)row * 1024 + col0;
                float sq = 0.f;
#pragma unroll
                for (int bj = 0; bj < 2; ++bj) {
                    f32x4 r0, r1;
                    if (res16) { const u32x4 rb = *(const u32x4*)(res16 + off + bj * HALF);
                        r0 = (f32x4){__uint_as_float(rb[0] << 16), __uint_as_float(rb[0] & 0xffff0000u), __uint_as_float(rb[1] << 16), __uint_as_float(rb[1] & 0xffff0000u)};
                        r1 = (f32x4){__uint_as_float(rb[2] << 16), __uint_as_float(rb[2] & 0xffff0000u), __uint_as_float(rb[3] << 16), __uint_as_float(rb[3] & 0xffff0000u)}; }
                    else { r0 = *(const f32x4*)(res32 + off + bj * HALF); r1 = *(const f32x4*)(res32 + off + bj * HALF + 4); }
                    const f32x4 o0 = r0 + acc[ai][bj][m][0], o1 = r1 + acc[ai][bj][m][1];
                    if (out32) { *(f32x4*)(out32 + off + bj * HALF) = o0; *(f32x4*)(out32 + off + bj * HALF + 4) = o1; }
                    if (out16) { sq += o0[0] * o0[0] + o0[1] * o0[1] + o0[2] * o0[2] + o0[3] * o0[3] + o1[0] * o1[0] + o1[1] * o1[1] + o1[2] * o1[2] + o1[3] * o1[3];
                        u32x4 w; w.x = cvt_pk_bf16(o0[0], o0[1]); w.y = cvt_pk_bf16(o0[2], o0[3]); w.z = cvt_pk_bf16(o1[0], o1[1]); w.w = cvt_pk_bf16(o1[2], o1[3]);
                        *(u32x4*)(out16 + off + bj * HALF) = w; }
                    __builtin_amdgcn_sched_barrier(0); }
                if (out16) { sq += __shfl_xor(sq, 16); sq += __shfl_xor(sq, 32); if (fq == 0) atomicAdd(ss + row, sq); } }
    }
};

template <class Epi, class Sched, bool ALIGN_EPI = false, bool SP2 = false>
__device__ __forceinline__ void gemm_phase(PG8_LAS unsigned char* lds, const Gemm g, const Sched& S, const Epi& E) {
    int tid = threadIdx.x; asm volatile("" : "+v"(tid));
    const int wid = __builtin_amdgcn_readfirstlane(tid >> 6), lane = tid & 63, wr = wid >> 2, wc = wid & 3, fr = lane & 15, fq = lane >> 4;
    const int K = g.K, nt = K / BK;
    unsigned voffA[2], voffB[2];
#pragma unroll
    for (int i = 0; i < 2; ++i) { int R, C; stage_rc(tid * 16 + i * 8192, R, C); const int Rb = Epi::PERM ? ((R & ~31) + perm32(R & 31)) : R;
        voffA[i] = (unsigned)(R * K + C) * 2u; voffB[i] = (unsigned)(Rb * K + C) * 2u; }
    const size_t kstep = (size_t)(BK * 2);
    const size_t hstep = (size_t)HALF * K * 2;
    const size_t tstep = 2 * hstep;
    const unsigned ldsw = (unsigned)wid * 1024u;
    const int aoff = lds_byte(wr * 64 + fr, fq * 8), boff = lds_byte(wc * 32 + fr, fq * 8);
#define PG8_SA(b, h) (((b) * 2 + (h)) * HTB)
#define PG8_SB(b, h) ((4 + (b) * 2 + (h)) * HTB)
#define PG8_STAGE(bufoff, gbase, voff) do { _Pragma("unroll") for (int _i = 0; _i < 2; ++_i) \
        __builtin_amdgcn_global_load_lds((const unsigned*)((const char*)(gbase) + (voff)[_i]), (PG8_LAS unsigned*)(lds + (bufoff) + ldsw + _i * 8192), 16, 0, 0); } while (0)
#define PG8_LDA(dst, b, h) do { _Pragma("unroll") for (int m = 0; m < 4; ++m) _Pragma("unroll") for (int k = 0; k < 2; ++k) dst[m][k] = *(const PG8_LAS bf16x8*)(lds + PG8_SA(b, h) + aoff + m * 2048 + k * 1024); } while (0)
#define PG8_LDB(dst, b, h) do { _Pragma("unroll") for (int n = 0; n < 2; ++n) _Pragma("unroll") for (int k = 0; k < 2; ++k) dst[n][k] = *(const PG8_LAS bf16x8*)(lds + PG8_SB(b, h) + boff + n * 2048 + k * 1024); } while (0)
#define PG8_MMA(ai, bj, At, Bt) do { __builtin_amdgcn_s_setprio(1); _Pragma("unroll") for (int m = 0; m < 4; ++m) _Pragma("unroll") for (int n = 0; n < 2; ++n) _Pragma("unroll") for (int k = 0; k < 2; ++k) \
        acc[ai][bj][m][n] = __builtin_amdgcn_mfma_f32_16x16x32_bf16(Bt[n][k], At[m][k], acc[ai][bj][m][n], 0, 0, 0); __builtin_amdgcn_s_setprio(0); } while (0)
#define PG8_WAIT_V(n) asm volatile("s_waitcnt vmcnt(" #n ")" ::: "memory")
#define PG8_WAIT_L(n) asm volatile("s_waitcnt lgkmcnt(" #n ")" ::: "memory")
#define PG8_BAR __builtin_amdgcn_s_barrier()
#define PG8_SCHED __builtin_amdgcn_sched_barrier(0)
    Unit cur, nxt; int ui = 0;
    if (!S.next(0, cur)) return;
    f32x4 acc[2][2][4][2];
#pragma unroll
    for (int a = 0; a < 2; ++a)
#pragma unroll
        for (int b = 0; b < 2; ++b)
#pragma unroll
            for (int m = 0; m < 4; ++m)
#pragma unroll
                for (int n = 0; n < 2; ++n) acc[a][b][m][n] = (f32x4){0.f, 0.f, 0.f, 0.f};
    bf16x8 At[4][2], B0[2][2], B1[2][2];
    const char* cA = (const char*)g.A + (size_t)cur.pm * tstep; const char* cB = (const char*)g.Bt + (size_t)cur.pn * tstep;
    S.a_ready(cur);
    if constexpr (SP2) {
        PG8_STAGE(PG8_SB(0, 0), cB, voffB); PG8_STAGE(PG8_SB(0, 1), cB + hstep, voffB); PG8_STAGE(PG8_SA(0, 0), cA, voffA); PG8_STAGE(PG8_SA(0, 1), cA + hstep, voffA);
        if (wr == 1) PG8_BAR;
        PG8_WAIT_V(2); PG8_BAR;
        PG8_STAGE(PG8_SB(1, 0), cB + kstep, voffB); PG8_STAGE(PG8_SA(1, 0), cA + kstep, voffA); PG8_STAGE(PG8_SB(1, 1), cB + hstep + kstep, voffB);
        PG8_WAIT_V(6); PG8_BAR;
    } else {
        PG8_STAGE(PG8_SB(0, 0), cB, voffB); PG8_STAGE(PG8_SA(0, 0), cA, voffA); PG8_STAGE(PG8_SB(0, 1), cB + hstep, voffB); PG8_STAGE(PG8_SA(0, 1), cA + hstep, voffA);
        if (wr == 1) PG8_BAR;
        PG8_WAIT_V(4); PG8_BAR;
        PG8_STAGE(PG8_SB(1, 0), cB + kstep, voffB); PG8_STAGE(PG8_SA(1, 0), cA + kstep, voffA); PG8_STAGE(PG8_SB(1, 1), cB + hstep + kstep, voffB);
        PG8_WAIT_V(6); PG8_BAR;
    }
    for (;;) {
        const bool has_next = S.next(ui + 1, nxt);
        const char* nA = has_next ? (const char*)g.A + (size_t)nxt.pm * tstep : cA; const char* nB = has_next ? (const char*)g.Bt + (size_t)nxt.pn * tstep : cB;
        for (int t = 0; t < nt; t += 2) {
            const bool last = (t == nt - 2);
            const char* a1 = cA + (size_t)(t + 1) * kstep;
            const char* a2 = last ? nA : cA + (size_t)(t + 2) * kstep; const char* b2 = last ? nB : cB + (size_t)(t + 2) * kstep;
            const char* a3 = a2 + kstep; const char* b3 = b2 + kstep;
            if (last && has_next) S.a_ready(nxt);
            if constexpr (SP2) {
            PG8_LDB(B0, 0, 0); PG8_LDB(B1, 0, 1); PG8_SCHED; PG8_LDA(At, 0, 0); PG8_STAGE(PG8_SA(1, 1), a1 + hstep, voffA);
            PG8_WAIT_V(8); PG8_WAIT_L(0); PG8_BAR; PG8_MMA(0, 0, At, B0); PG8_MMA(0, 1, At, B1); PG8_BAR; PG8_SCHED;
            PG8_LDA(At, 0, 1); PG8_STAGE(PG8_SB(0, 0), b2, voffB); PG8_STAGE(PG8_SB(0, 1), b2 + hstep, voffB); PG8_STAGE(PG8_SA(0, 0), a2, voffA);
            PG8_WAIT_V(8); PG8_WAIT_L(0); PG8_BAR; PG8_MMA(1, 0, At, B0); PG8_MMA(1, 1, At, B1); PG8_BAR; PG8_SCHED;
            PG8_LDB(B0, 1, 0); PG8_LDB(B1, 1, 1); PG8_SCHED; PG8_LDA(At, 1, 0); PG8_STAGE(PG8_SA(0, 1), a2 + hstep, voffA);
            PG8_WAIT_V(8); PG8_WAIT_L(0); PG8_BAR; PG8_MMA(0, 0, At, B0); PG8_MMA(0, 1, At, B1); PG8_BAR; PG8_SCHED;
            PG8_LDA(At, 1, 1); PG8_STAGE(PG8_SB(1, 0), b3, voffB); PG8_STAGE(PG8_SB(1, 1), b3 + hstep, voffB); PG8_STAGE(PG8_SA(1, 0), a3, voffA);
            PG8_WAIT_V(8); PG8_WAIT_L(0); PG8_BAR; PG8_MMA(1, 0, At, B0); PG8_MMA(1, 1, At, B1); PG8_BAR; PG8_SCHED;
            } else {
            PG8_LDB(B0, 0, 0); PG8_SCHED; PG8_LDA(At, 0, 0); PG8_STAGE(PG8_SA(1, 1), a1 + hstep, voffA);
            PG8_WAIT_L(8); PG8_BAR; PG8_WAIT_L(0); PG8_MMA(0, 0, At, B0); PG8_BAR; PG8_SCHED;
            PG8_LDB(B1, 0, 1); PG8_STAGE(PG8_SB(0, 0), b2, voffB);
            PG8_BAR; PG8_WAIT_L(0); PG8_MMA(0, 1, At, B1); PG8_BAR;
            PG8_LDA(At, 0, 1); PG8_STAGE(PG8_SA(0, 0), a2, voffA);
            PG8_BAR; PG8_WAIT_L(0); PG8_MMA(1, 0, At, B0); PG8_BAR; PG8_SCHED;
            PG8_STAGE(PG8_SB(0, 1), b2 + hstep, voffB);
            PG8_WAIT_V(6); PG8_BAR; PG8_MMA(1, 1, At, B1); PG8_BAR;
            PG8_LDB(B0, 1, 0); PG8_SCHED; PG8_LDA(At, 1, 0); PG8_STAGE(PG8_SA(0, 1), a2 + hstep, voffA);
            PG8_WAIT_L(8); PG8_BAR; PG8_WAIT_L(0); PG8_MMA(0, 0, At, B0); PG8_BAR; PG8_SCHED;
            PG8_LDB(B1, 1, 1); PG8_STAGE(PG8_SB(1, 0), b3, voffB);
            PG8_BAR; PG8_WAIT_L(0); PG8_MMA(0, 1, At, B1); PG8_BAR;
            PG8_LDA(At, 1, 1); PG8_STAGE(PG8_SA(1, 0), a3, voffA);
            PG8_BAR; PG8_WAIT_L(0); PG8_MMA(1, 0, At, B0); PG8_BAR; PG8_SCHED;
            PG8_STAGE(PG8_SB(1, 1), b3 + hstep, voffB);
            PG8_WAIT_V(6); PG8_BAR; PG8_MMA(1, 1, At, B1); PG8_BAR;
            }
        }
        if constexpr (ALIGN_EPI) { if (wr == 0) PG8_BAR; }
        if constexpr (!Epi::AFTER_DRAIN) { E(acc, cur, wr, wc, fr, fq); S.done(cur); }
        if (!has_next) break;
#pragma unroll
        for (int a = 0; a < 2; ++a)
#pragma unroll
            for (int b = 0; b < 2; ++b)
#pragma unroll
                for (int m = 0; m < 4; ++m)
#pragma unroll
                    for (int n = 0; n < 2; ++n) acc[a][b][m][n] = (f32x4){0.f, 0.f, 0.f, 0.f};
        cur = nxt; cA = nA; cB = nB; ++ui;
        if constexpr (ALIGN_EPI) { if (wr == 1) PG8_BAR; }
    }
    PG8_WAIT_V(0);
    if constexpr (!ALIGN_EPI) { if (wr == 0) PG8_BAR; }
    PG8_BAR;
    if constexpr (Epi::AFTER_DRAIN) { E.fused(acc, cur, wr, wc, fr, fq, lds, wid, lane); S.done(cur); }
#undef PG8_SA
#undef PG8_SB
#undef PG8_STAGE
#undef PG8_LDA
#undef PG8_LDB
#undef PG8_MMA
#undef PG8_WAIT_V
#undef PG8_WAIT_L
#undef PG8_BAR
#undef PG8_SCHED
}
}


DI void gates_gemm(const bf16_t* H, const bf16_t* WgT  , float* GL, const float* ss, bool upper_half_only) {
    const int tid_ = opaque_tid(); const int lane = tid_ & 63, wid = tid_ >> 6, r32 = lane & 31, hi = lane >> 5;
    const int nb = (upper_half_only && gridDim.x >= 256) ? (int)gridDim.x - 128 : (int)gridDim.x, b0 = (int)gridDim.x - nb;
    if ((int)blockIdx.x < b0) return;
    for (int u = ((int)blockIdx.x - b0) + nb * wid; u < NT / 32; u += nb * 8) {
        const bf16_t* ap = H + (size_t)(u * 32 + r32) * DM + hi * 8; const bf16_t* bp = WgT + (size_t)r32 * DM + hi * 8;
        f32x16 acc;
#pragma unroll
        for (int i = 0; i < 16; ++i) acc[i] = 0.f;
#pragma unroll 8
        for (int k = 0; k < DM; k += 16) acc = __builtin_amdgcn_mfma_f32_32x32x16_bf16(*(const bf16x8*)(ap + k), *(const bf16x8*)(bp + k), acc, 0, 0, 0);
#pragma unroll
        for (int i = 0; i < 16; ++i) { const int row = u * 32 + (i & 3) + 8 * (i >> 2) + 4 * hi; const float rs = ss ? rsqrtf(ss[row] * (1.f / 1024) + EPS) : 1.f; GL[(size_t)row * 32 + r32] = acc[i] * rs; }
    }
}

DI float log_sigmoid_(float x) { return fminf(x, 0.f) - log1pf(__expf(-fabsf(x))); }
DI void prep_cumsum(const Args& a, int l, float* LS) {
    const float* GL = (const float*)(a.ws + WS_GL); float* C2 = (float*)(a.ws + WS_C2);
    const int tid = opaque_tid(), lane = tid & 63, wid = tid >> 6;
    for (int b = blockIdx.x; b < NB; b += gridDim.x) {
        __syncthreads();
#pragma unroll
        for (int i = 0; i < 4; ++i) {
            const int t = tid + 512 * i;
            const f32x4 v0 = *(const f32x4*)(GL + (size_t)(b * SEQ + t) * 32 + 24), v1 = *(const f32x4*)(GL + (size_t)(b * SEQ + t) * 32 + 28);
#pragma unroll
            for (int h = 0; h < 4; ++h) { LS[h * 2112 + (t >> 5) * 33 + (t & 31)] = log_sigmoid_(v0[h] + a.in[I_FFB][l * 8 + h]); LS[(h + 4) * 2112 + (t >> 5) * 33 + (t & 31)] = log_sigmoid_(v1[h] + a.in[I_FFB][l * 8 + 4 + h]); }
        }
        __syncthreads();
        {   float* row = LS + wid * 2112 + lane * 33;
            float tot = 0.f;
            for (int k = 0; k < 32; ++k) tot += row[k];
            float inc = tot;
#pragma unroll
            for (int o = 1; o < 64; o <<= 1) { const float n = __shfl_up(inc, o); if (lane >= o) inc += n; }
            float run = inc - tot;
            for (int k = 0; k < 32; ++k) { run += row[k]; row[k] = run * LOG2E; }
        }
        __syncthreads();
#pragma unroll
        for (int i = 0; i < 4; ++i) { const int t = tid + 512 * i;
#pragma unroll
            for (int h = 0; h < 8; ++h) C2[(size_t)(b * 8 + h) * SEQ + t] = LS[h * 2112 + (t >> 5) * 33 + (t & 31)]; }
    }
    __syncthreads();
}
DI void prep_compress(const Args& a, int l, const bf16_t* P) {
    unsigned char* ws = a.ws;
    const int tid_ = opaque_tid(); const int lane = tid_ & 63, wid = tid_ >> 6, fr = lane & 15, fq = lane >> 4;
    const int nbk = gridDim.x > 32 ? (int)gridDim.x - 16 : (int)gridDim.x, bk0 = (int)gridDim.x - nbk;
    if ((int)blockIdx.x < bk0) return;
    for (int it = ((int)blockIdx.x - bk0) + nbk * wid; it < NB * 2 * 2 * 8; it += nbk * 8) {
        const int nq = it & 7, kv = (it >> 3) & 1, g = (it >> 4) & 1, b = it >> 5;
        const int n = 16 * nq + fr; const bool ok = n < 127;
        const bf16_t* src = P + (size_t)(b * SEQ + (ok ? 16 * n : 0)) * PP + (kv ? C_VC : C_KC) + g * 64 + fq * 8;
        const bf16_t* W = (const bf16_t*)(ws + (kv ? WS_WCV : WS_WCK)) + (size_t)l * 131072 + (size_t)fr * 2048 + fq * 8;
        f32x4 acc[4];
#pragma unroll
        for (int nt = 0; nt < 4; ++nt) acc[nt] = (f32x4){0.f, 0.f, 0.f, 0.f};
#pragma unroll 4
        for (int ks = 0; ks < 64; ++ks) {
            bf16x8 af = *(const bf16x8*)(src + (size_t)(ks >> 1) * PP + (ks & 1) * 32);
            if (!ok) af = (bf16x8){0, 0, 0, 0, 0, 0, 0, 0};
#pragma unroll
            for (int nt = 0; nt < 4; ++nt) { const bf16x8 bw = *(const bf16x8*)(W + (size_t)nt * 16 * 2048 + ks * 32); acc[nt] = __builtin_amdgcn_mfma_f32_16x16x32_bf16(af, bw, acc[nt], 0, 0, 0); }
        }
        const float* bias = (const float*)(ws + WS_BKV) + (l * 2 + kv) * 64;
        float v[4][4];
#pragma unroll
        for (int nt = 0; nt < 4; ++nt)
#pragma unroll
            for (int i = 0; i < 4; ++i) v[nt][i] = acc[nt][i] + bias[16 * nt + fr];
        bf16_t* out = (bf16_t*)(ws + (kv ? WS_VCMP : WS_KCMP)) + (size_t)(b * 2 + g) * 128 * 64;
#pragma unroll
        for (int i = 0; i < 4; ++i) {
            const int row = 16 * nq + 4 * fq + i;
            float sc = 1.f;
            if (kv == 0) { float ss = v[0][i] * v[0][i] + v[1][i] * v[1][i] + v[2][i] * v[2][i] + v[3][i] * v[3][i];
                ss += __shfl_xor(ss, 1); ss += __shfl_xor(ss, 2); ss += __shfl_xor(ss, 4); ss += __shfl_xor(ss, 8); sc = rsqrtf(ss * (1.f / 64) + EPS); }
#pragma unroll
            for (int nt = 0; nt < 4; ++nt) { const int e = 16 * nt + fr; float o = v[nt][i] * sc; if (kv == 0) o *= a.in[I_NKG][(l * 3 + 0) * 64 + e]; if (row >= 127) o = 0.f;
                out[(size_t)row * 64 + e] = (bf16_t)f2bf(o); }
        }
    }
}


constexpr int A_KB = 0, A_VB = 18432, A_CB = A_VB + 16384, A_IG = A_CB + 512, A_IL = A_IG + 33792, A_SELM = A_IL + 33792, A_UN = A_SELM + 256, A_UNIT = A_UN + 16, A_SC = A_UNIT + 16, A_KG = A_SC + 2048, A_END = A_KG + 512;
static_assert(A_END <= LDS_BYTES, "attention LDS map");
struct ACtx { int r32, hi, tid, tok; bf16x8 qr[4]; };
typedef float f32x2_t __attribute__((ext_vector_type(2))); typedef __bf16 bf16x2_t __attribute__((ext_vector_type(2)));
typedef short v4i16_t __attribute__((ext_vector_type(4)));
#define LAS3 __attribute__((address_space(3)))
DI unsigned cvtpk(float lo, float hi) { f32x2_t v = {lo, hi}; bf16x2_t bb = __builtin_convertvector(v, bf16x2_t); return __builtin_bit_cast(unsigned, bb); }
DI v4i16_t vtr(const LAS3 unsigned char* p) { return __builtin_amdgcn_ds_read_tr16_b64_v4i16((LAS3 v4i16_t*)p); }

DI void load_q(ACtx& x, const bf16_t* qrow) {
#pragma unroll
    for (int d0 = 0; d0 < 4; ++d0) x.qr[d0] = *(const bf16x8*)(qrow + d0 * 16 + x.hi * 8);
}

template <int MODE, bool ONLINE>
DI void attn_tile_compute(const unsigned char* lds, int cur, int j, const ACtx& x, unsigned selm, int cblk, int wtokmin, float bref, float ctb, f32x16 (&oT)[2], float& m, float& l) {
    const bf16_t* KB = (const bf16_t*)(lds + A_KB) + cur * 4608;
    const int lane = x.tid & 63;
    f32x16 p0, p1;
    if (MODE == 3) {
        const float* CB = (const float*)(lds + A_CB) + cur * 64 + 4 * x.hi;
#pragma unroll
        for (int q = 0; q < 4; ++q) { const f32x4 c0 = *(const f32x4*)(CB + 8 * q), c1 = *(const f32x4*)(CB + 32 + 8 * q);
#pragma unroll
            for (int i = 0; i < 4; ++i) { p0[4 * q + i] = (ONLINE ? 0.f : ctb) - c0[i]; p1[4 * q + i] = (ONLINE ? 0.f : ctb) - c1[i]; } }
    } else {
#pragma unroll
        for (int i = 0; i < 16; ++i) { p0[i] = ONLINE ? 0.f : -bref; p1[i] = ONLINE ? 0.f : -bref; }
    }
#pragma unroll
    for (int d0 = 0; d0 < 4; ++d0) {
        const bf16x8 k0 = *(const bf16x8*)(KB + x.r32 * 72 + d0 * 16 + x.hi * 8);
        const bf16x8 k1 = *(const bf16x8*)(KB + (32 + x.r32) * 72 + d0 * 16 + x.hi * 8);
        p0 = __builtin_amdgcn_mfma_f32_32x32x16_bf16(k0, x.qr[d0], p0, 0, 0, 0);
        p1 = __builtin_amdgcn_mfma_f32_32x32x16_bf16(k1, x.qr[d0], p1, 0, 0, 0);
    }
    const float NEG = -INFINITY;
    const int kb = 64 * j + 4 * x.hi;
#define KK(r) (kb + ((r) & 3) + 8 * ((r) >> 2))
    if (MODE == 3) {
        if (64 * j + 63 > wtokmin) {
#pragma unroll
            for (int r = 0; r < 16; ++r) { const int kk = KK(r); if (kk > x.tok) p0[r] = NEG; if (kk + 32 > x.tok) p1[r] = NEG; }
        }
    } else if (MODE == 0) {
#pragma unroll
        for (int r = 0; r < 16; ++r) { const int n = KK(r); if (16 * n + 31 > x.tok) p0[r] = NEG; if (16 * (n + 32) + 31 > x.tok) p1[r] = NEG; }
    } else if (MODE == 1) {
        const bool on = (selm >> j) & 1u;
        const bool allon = __ballot(on) == ~0ull;
        if (j == cblk) {
#pragma unroll
            for (int r = 0; r < 16; ++r) { const int kk = KK(r); if (!on || kk > x.tok) p0[r] = NEG; if (!on || kk + 32 > x.tok) p1[r] = NEG; }
        } else if (!allon) {
#pragma unroll
            for (int r = 0; r < 16; ++r) { if (!on) { p0[r] = NEG; p1[r] = NEG; } }
        }
    } else {
        if (j == cblk) {
#pragma unroll
            for (int r = 0; r < 16; ++r) { const int kk = KK(r); if (kk > x.tok) p0[r] = NEG; if (kk + 32 > x.tok) p1[r] = NEG; }
        } else if (j == cblk - 8) {
#pragma unroll
            for (int r = 0; r < 16; ++r) { const int kk = KK(r); if (x.tok - kk >= 512) p0[r] = NEG; if (x.tok - kk - 32 >= 512) p1[r] = NEG; }
        }
    }
#undef KK
    if (ONLINE) {
        float mx = fmaxf(p0[0], p1[0]);
#pragma unroll
        for (int r = 1; r < 16; ++r) mx = fmaxf(mx, fmaxf(p0[r], p1[r]));
        mx = fmaxf(mx, __shfl_xor(mx, 32));
        const float mn = fmaxf(m, mx);
        if (__any(mn > m)) {
            const float sc = __builtin_amdgcn_exp2f(m - mn); l *= sc;
#pragma unroll
            for (int r = 0; r < 16; ++r) { oT[0][r] *= sc; oT[1][r] *= sc; }
        }
        m = mn;
#pragma unroll
        for (int r = 0; r < 16; ++r) { p0[r] -= mn; p1[r] -= mn; }
    }
    f32x2_t ls2 = {0.f, 0.f};
#pragma unroll
    for (int r = 0; r < 16; r += 2) { p0[r] = __builtin_amdgcn_exp2f(p0[r]); p0[r + 1] = __builtin_amdgcn_exp2f(p0[r + 1]); p1[r] = __builtin_amdgcn_exp2f(p1[r]); p1[r + 1] = __builtin_amdgcn_exp2f(p1[r + 1]);
        ls2 += (f32x2_t){p0[r], p0[r + 1]}; ls2 += (f32x2_t){p1[r], p1[r + 1]}; }
    l += ls2[0] + ls2[1];
    bf16x8 pf[4];
#pragma unroll
    for (int s = 0; s < 2; ++s) {
        u32x4 a0, a1;
#pragma unroll
        for (int i = 0; i < 4; ++i) { a0[i] = cvtpk(p0[8 * s + 2 * i], p0[8 * s + 2 * i + 1]); a1[i] = cvtpk(p1[8 * s + 2 * i], p1[8 * s + 2 * i + 1]); }
        pf[s] = __builtin_bit_cast(bf16x8, a0); pf[2 + s] = __builtin_bit_cast(bf16x8, a1);
    }
    const LAS3 unsigned char* vp = (const LAS3 unsigned char*)(lds + A_VB) + cur * 8192 + ((lane >> 4) & 1) * 32 + (lane & 3) * 8 + (4 * x.hi + ((lane & 15) >> 2)) * 64;
#pragma unroll
    for (int dh = 0; dh < 2; ++dh)
#pragma unroll
        for (int ks = 0; ks < 4; ++ks) {
            const v4i16_t lo = vtr(vp + dh * 4096 + ks * 1024), hi4 = vtr(vp + dh * 4096 + ks * 1024 + 512);
            const bf16x8 vf = (bf16x8){lo[0], lo[1], lo[2], lo[3], hi4[0], hi4[1], hi4[2], hi4[3]};
            oT[dh] = __builtin_amdgcn_mfma_f32_32x32x16_bf16(vf, pf[ks], oT[dh], 0, 0, 0);
        }
}

template <int MODE, bool ONLINE>
DI void attn_branch(unsigned char* lds, const bf16_t* Kg, int kp, const bf16_t* Vg, int vp, const float* Cg, int kgofs, unsigned tiles,
                    const ACtx& x, unsigned selm, int cblk, int wtokmin, int wtokmax, float bref, float ctb, f32x16 (&oT)[2], float& m, float& l) {
    const int tid = x.tid, srow = tid >> 3, sc8 = tid & 7;
    bf16_t* KB = (bf16_t*)(lds + A_KB); unsigned char* VB = lds + A_VB; float* CB = (float*)(lds + A_CB);
    const int kofs = srow * 72 + sc8 * 8, vofs = ((sc8 >> 2) * 4 + (srow >> 4)) * 1024 + (srow & 15) * 64 + (sc8 & 3) * 16;
    unsigned rem = tiles; if (!rem) return;
    u32x4 krA, vrA, krB, vrB; f32x4 crA = {0.f, 0.f, 0.f, 0.f}, crB = {0.f, 0.f, 0.f, 0.f};
#define POP(jv) do { jv = -1; if (rem) { jv = __builtin_ctz(rem); rem &= rem - 1; } } while (0)
#define LOADT(jj, kr, vr, cr) do { kr = *(const u32x4*)(Kg + (size_t)(64 * (jj) + srow) * kp + sc8 * 8); vr = *(const u32x4*)(Vg + (size_t)(64 * (jj) + srow) * vp + sc8 * 8); \
        if (MODE == 3 && tid < 16) cr = *(const f32x4*)(Cg + 64 * (jj) + tid * 4); } while (0)
#define STORET(buf, kr, vr, cr) do { *(u32x4*)(KB + (buf) * 4608 + kofs) = kr; *(u32x4*)(VB + (buf) * 8192 + vofs) = vr; if (MODE == 3 && tid < 16) *(f32x4*)(CB + (buf) * 64 + tid * 4) = cr; } while (0)
#define ACTIVE(jj) ((MODE == 1) ? (__ballot((selm >> (jj)) & 1u) != 0ull) : ((MODE == 3) ? (64 * (jj) <= wtokmax) : true))
    int j0, j1, j2, j3;
    POP(j0); LOADT(j0, krA, vrA, crA); STORET(0, krA, vrA, crA);
    POP(j1); if (j1 >= 0) LOADT(j1, krA, vrA, crA);
    __syncthreads();
    int cur = 0;
    for (;;) {
        POP(j2); if (j2 >= 0) LOADT(j2, krB, vrB, crB);
        if (ACTIVE(j0)) attn_tile_compute<MODE, ONLINE>(lds, cur, j0, x, selm, cblk, wtokmin, bref, ctb, oT, m, l);
        if (j1 >= 0) STORET(cur ^ 1, krA, vrA, crA);
        __syncthreads();
        if (j1 < 0) break;
        cur ^= 1;
        POP(j3); if (j3 >= 0) LOADT(j3, krA, vrA, crA);
        if (ACTIVE(j1)) attn_tile_compute<MODE, ONLINE>(lds, cur, j1, x, selm, cblk, wtokmin, bref, ctb, oT, m, l);
        if (j2 >= 0) STORET(cur ^ 1, krB, vrB, crB);
        __syncthreads();
        if (j2 < 0) break;
        cur ^= 1; j0 = j2; j1 = j3;
    }
#undef POP
#undef ACTIVE
#undef LOADT
#undef STORET
}
DI void zero_o(f32x16 (&oT)[2]) {
#pragma unroll
    for (int r = 0; r < 16; ++r) { oT[0][r] = 0.f; oT[1][r] = 0.f; }
}

template <bool ONLINE> DI void nsa_unit(const Args& a, int l, unsigned char* lds, int b, int g, int c) {
    unsigned char* ws = a.ws;
    const bf16_t* P = (const bf16_t*)(ws + WS_P); bf16_t* Y = (bf16_t*)(ws + WS_HY); const float* GL = (const float*)(ws + WS_GL);
    ACtx x; x.tid = threadIdx.x; asm volatile("" : "+v"(x.tid));
    const int lane = x.tid & 63, wid = __builtin_amdgcn_readfirstlane(x.tid >> 6); x.r32 = lane & 31; x.hi = lane >> 5;
    const int hq = 4 * g + (wid & 3), tokl = 32 * (wid >> 2) + x.r32; x.tok = 64 * c + tokl;
    const size_t row = (size_t)(b * SEQ + x.tok);
    load_q(x, P + row * PP + C_NQ + hq * 64);
#define GATE(k) sigmoidf_(GL[row * 32 + hq * 3 + (k)] + a.in[I_GB][l * 24 + hq * 3 + (k)])
    float* IG = (float*)(lds + A_IG); float* IL = (float*)(lds + A_IL); unsigned* SELM = (unsigned*)(lds + A_SELM); unsigned* UN = (unsigned*)(lds + A_UN);
    if (x.tid == 0) UN[0] = 0u;
    f32x16 oT[2], tot[2]; zero_o(oT); zero_o(tot);
    float m = -1e30f, ls = 0.f;
    const float* bnd = (const float*)(ws + WS_BND) + l * 4;
    const float b_cmp = bnd[0], b_slc = bnd[1], b_win = bnd[2];
    constexpr bool online = ONLINE;
#define BRANCH(MODE, ...) do { attn_branch<MODE, ONLINE>(__VA_ARGS__); } while (0)
    const bf16_t* KC = (const bf16_t*)(ws + WS_KCMP) + (size_t)(b * 2 + g) * 128 * 64; const bf16_t* VC = (const bf16_t*)(ws + WS_VCMP) + (size_t)(b * 2 + g) * 128 * 64;
    const int ncmpt = c >= 16 ? 2 : 1;
    BRANCH(0, lds, KC, 64, VC, 64, nullptr, 0, c >= 16 ? 3u : 1u, x, 0u, c, 0, 0, b_cmp, 0.f, oT, m, ls);
    const float cref = online ? m : b_cmp;
    {   float lt = ls + __shfl_xor(ls, 32); const float inv = lt > 0.f ? 1.f / lt : 0.f; const float g0 = GATE(0);
#pragma unroll
        for (int r = 0; r < 16; ++r) { tot[0][r] = oT[0][r] * (inv * g0); tot[1][r] = oT[1][r] * (inv * g0); }
        for (int tt = 0; tt < ncmpt; ++tt) {
            const bf16_t* KB = (const bf16_t*)(lds + A_KB) + tt * 4608;
            f32x16 p0, p1;
#pragma unroll
            for (int i = 0; i < 16; ++i) { p0[i] = -cref; p1[i] = -cref; }
#pragma unroll
            for (int d0 = 0; d0 < 4; ++d0) {
                const bf16x8 k0 = *(const bf16x8*)(KB + x.r32 * 72 + d0 * 16 + x.hi * 8); const bf16x8 k1 = *(const bf16x8*)(KB + (32 + x.r32) * 72 + d0 * 16 + x.hi * 8);
                p0 = __builtin_amdgcn_mfma_f32_32x32x16_bf16(k0, x.qr[d0], p0, 0, 0, 0); p1 = __builtin_amdgcn_mfma_f32_32x32x16_bf16(k1, x.qr[d0], p1, 0, 0, 0);
            }
            const int kb = 64 * tt + 4 * x.hi;
#pragma unroll
            for (int r = 0; r < 16; ++r) { const int n = kb + (r & 3) + 8 * (r >> 2);
                p0[r] = (16 * n + 31 <= x.tok) ? __builtin_amdgcn_exp2f(p0[r]) * inv : 0.f; p1[r] = (16 * (n + 32) + 31 <= x.tok) ? __builtin_amdgcn_exp2f(p1[r]) * inv : 0.f; }
            float* ig = IG + ((wid & 3) * 64 + tokl) * 33; float* il = IL + ((wid & 3) * 64 + tokl) * 33;
#pragma unroll
            for (int q = 0; q < 4; ++q) { const int jj = 16 * tt + 2 * q + x.hi;
                ig[jj] = p0[4 * q] + p0[4 * q + 1] + p0[4 * q + 2] + p0[4 * q + 3]; il[jj] = p0[4 * q + 3];
                ig[jj + 8] = p1[4 * q] + p1[4 * q + 1] + p1[4 * q + 2] + p1[4 * q + 3]; il[jj + 8] = p1[4 * q + 3]; }
        }
    }
    __syncthreads();
    {   int j = lane & 31; asm volatile("" : "+v"(j));
        unsigned wor = 0u;
#pragma unroll
        for (int it = 0; it < 4; ++it) {
            const int tl = 8 * wid + 2 * it + (lane >> 5);
            float imp = 0.f;
#pragma unroll
            for (int h4 = 0; h4 < 4; ++h4) { imp += IG[(h4 * 64 + tl) * 33 + j]; if (j > 0) imp += IL[(h4 * 64 + tl) * 33 + j - 1]; }
            const bool valid = j <= c, forced = (j == 0) || (j == c) || (j == c - 1);
            const float score = !valid ? -1e30f : (forced ? 1e9f : imp);
            float* scw = (float*)(lds + A_SC) + wid * 64;
            scw[lane] = score;
            __builtin_amdgcn_s_waitcnt(0xc07f); __builtin_amdgcn_wave_barrier();
            int rank = 0;
#pragma unroll
            for (int k4 = 0; k4 < 8; ++k4) { const f32x4 sk = *(const f32x4*)(scw + (lane & 32) + 4 * k4);
#pragma unroll
                for (int i = 0; i < 4; ++i) rank += (sk[i] > score) || (sk[i] == score && 4 * k4 + i < j); }
            __builtin_amdgcn_wave_barrier();
            const unsigned long long bal = __ballot(valid && rank < 16);
            const unsigned mine = (lane >> 5) ? (unsigned)(bal >> 32) : (unsigned)bal;
            if (j == 0) SELM[tl] = mine;
            wor |= (unsigned)bal | (unsigned)(bal >> 32);
        }
        if (lane == 0) atomicOr(UN, wor);
    }
    __syncthreads();
    const unsigned selm = SELM[tokl]; const unsigned un = UN[0];
    float* TOT = (float*)(lds + A_IG) + wid * 2048 + lane;
#pragma unroll
    for (int r = 0; r < 16; ++r) { TOT[r * 64] = tot[0][r]; TOT[(16 + r) * 64] = tot[1][r]; }
    zero_o(oT); m = -1e30f; ls = 0.f;
    BRANCH(1, lds, P + (size_t)b * SEQ * PP + C_KS + g * 64, PP, P + (size_t)b * SEQ * PP + C_VS + g * 64, PP, nullptr, 0, un, x, selm, c, 0, 0, b_slc, 0.f, oT, m, ls);
    {   float lt = ls + __shfl_xor(ls, 32); const float inv = lt > 0.f ? GATE(1) / lt : 0.f;
#pragma unroll
        for (int r = 0; r < 16; ++r) { TOT[r * 64] += oT[0][r] * inv; TOT[(16 + r) * 64] += oT[1][r] * inv; } }
    zero_o(oT); m = -1e30f; ls = 0.f;
    {   const int jlo = c >= 8 ? c - 8 : 0; const unsigned wt = (c >= 31 ? 0xffffffffu : ((1u << (c + 1)) - 1u)) & ~((1u << jlo) - 1u);
        BRANCH(2, lds, P + (size_t)b * SEQ * PP + C_KW + g * 64, PP, P + (size_t)b * SEQ * PP + C_VW + g * 64, PP, nullptr, 64, wt, x, 0u, c, 0, 0, b_win, 0.f, oT, m, ls); }
    {   float lt = ls + __shfl_xor(ls, 32); const float inv = lt > 0.f ? GATE(2) / lt : 0.f;
#pragma unroll
        for (int r = 0; r < 16; ++r) { tot[0][r] = TOT[r * 64] + oT[0][r] * inv; tot[1][r] = TOT[(16 + r) * 64] + oT[1][r] * inv; } }
#pragma unroll
    for (int dh = 0; dh < 2; ++dh)
#pragma unroll
        for (int q = 0; q < 4; ++q) {
            const int d = 32 * dh + 8 * q + 4 * x.hi;
            const u32x2 zz = *(const u32x2*)(P + row * PP + C_NZ + hq * 64 + d);
            const float z0 = bf2f(zz[0] & 0xffffu), z1 = bf2f(zz[0] >> 16), z2 = bf2f(zz[1] & 0xffffu), z3 = bf2f(zz[1] >> 16);
            u32x2 o; o[0] = cvtpk(tot[dh][4 * q] * siluf_(z0), tot[dh][4 * q + 1] * siluf_(z1)); o[1] = cvtpk(tot[dh][4 * q + 2] * siluf_(z2), tot[dh][4 * q + 3] * siluf_(z3));
            *(u32x2*)(Y + row * DMIX + 512 + hq * 64 + d) = o;
        }
}

template <bool ONLINE> DI void fox_unit(const Args& a, int l, unsigned char* lds, int b, int h, int c) {
    unsigned char* ws = a.ws;
    const bf16_t* P = (const bf16_t*)(ws + WS_P); bf16_t* Y = (bf16_t*)(ws + WS_HY);
    ACtx x; x.tid = threadIdx.x; asm volatile("" : "+v"(x.tid));
    const int lane = x.tid & 63, wid = __builtin_amdgcn_readfirstlane(x.tid >> 6); x.r32 = lane & 31; x.hi = lane >> 5;
    x.tok = 256 * c + 32 * wid + x.r32;
    const size_t row = (size_t)(b * SEQ + x.tok);
    load_q(x, P + row * PP + C_FQ + h * 64);
    const float* c2 = (const float*)(ws + WS_C2) + (size_t)(b * 8 + h) * SEQ;
    f32x16 oT[2]; zero_o(oT); float m = -1e30f, ls = 0.f;
    const int ntile = 4 * c + 4; const unsigned tiles = ntile >= 32 ? 0xffffffffu : ((1u << ntile) - 1u);
    unsigned tiles_ = tiles;
    if (!ONLINE) {
        const float cj = c2[64 * (lane & 31) + 63], c0 = c2[256 * c];
        tiles_ &= ~(unsigned)__ballot((lane < 32) && (c0 - cj <= -152.f));
    }
    const float b_fox = ((const float*)(ws + WS_BND))[l * 4 + 3]; const float ctb = c2[x.tok] - b_fox;
    attn_branch<3, ONLINE>(lds, P + (size_t)b * SEQ * PP + C_FK + h * 64, PP, P + (size_t)b * SEQ * PP + C_FV + h * 64, PP, c2, 0, tiles_, x, 0u, 0, 256 * c + 32 * wid, 256 * c + 32 * wid + 31, b_fox, ctb, oT, m, ls);
    float lt = ls + __shfl_xor(ls, 32); const float inv = lt > 0.f ? 1.f / lt : 0.f;
#pragma unroll
    for (int dh = 0; dh < 2; ++dh)
#pragma unroll
        for (int q = 0; q < 4; ++q) {
            const int d = 32 * dh + 8 * q + 4 * x.hi;
            const u32x2 zz = *(const u32x2*)(P + row * PP + C_FZ + h * 64 + d);
            const float z0 = bf2f(zz[0] & 0xffffu), z1 = bf2f(zz[0] >> 16), z2 = bf2f(zz[1] & 0xffffu), z3 = bf2f(zz[1] >> 16);
            u32x2 o; o[0] = cvtpk(oT[dh][4 * q] * inv * siluf_(z0), oT[dh][4 * q + 1] * inv * siluf_(z1)); o[1] = cvtpk(oT[dh][4 * q + 2] * inv * siluf_(z2), oT[dh][4 * q + 3] * inv * siluf_(z3));
            *(u32x2*)(Y + row * DMIX + 1024 + h * 64 + d) = o;
        }
}


constexpr int L_WA = 0, L_WX = 9216, L_XB = 18432, L_XF = 27648, L_G = 44032, L_SA = L_G + 2 * 64 * 65 * 4, L_SB = L_SA + 2048, L_CY = L_SB + 2048, L_END = L_CY + 512;
static_assert(L_END <= LDS_BYTES, "LRU LDS map");
DI float fsig(float x) { return __builtin_amdgcn_rcpf(1.f + __expf(-x)); }
DI float neg_expm1(float x, float ex) {
    const float t = x * (1.f + x * (0.5f + x * (0.16666667f + x * (0.041666668f + x * (0.0083333338f + x * 0.0013888889f)))));
    return (x > -0.25f) ? -t : 1.f - ex;
}
DI void lru_unit(const Args& a, int l, unsigned char* lds, int b, int h) {
    unsigned char* ws = a.ws;
    const bf16_t* P = (const bf16_t*)(ws + WS_P); bf16_t* Y = (bf16_t*)(ws + WS_HY);
    int tid = threadIdx.x; asm volatile("" : "+v"(tid));
    const int lane = tid & 63, wid = __builtin_amdgcn_readfirstlane(tid >> 6);
    bf16_t* WAl = (bf16_t*)(lds + L_WA); bf16_t* WXl = (bf16_t*)(lds + L_WX); bf16_t* XB = (bf16_t*)(lds + L_XB);
    float* XF = (float*)(lds + L_XF); float* G = (float*)(lds + L_G); float* SA = (float*)(lds + L_SA); float* SB = (float*)(lds + L_SB); float* CY = (float*)(lds + L_CY);
    __syncthreads();
    {   const int r = tid >> 3, c8 = (tid & 7) * 8;
        *(u32x4*)(WAl + r * 72 + c8) = *(const u32x4*)((const bf16_t*)(ws + WS_WA) + (size_t)(l * 8 + h) * 4096 + r * 64 + c8);
        *(u32x4*)(WXl + r * 72 + c8) = *(const u32x4*)((const bf16_t*)(ws + WS_WX) + (size_t)(l * 8 + h) * 4096 + r * 64 + c8);
        if (tid < 128) CY[tid] = 0.f; }
    const int tk1 = tid >> 3, c8 = (tid & 7) * 8, chb = h * 64 + c8;
    float cw[4][8], cb8[8];
#pragma unroll
    for (int i = 0; i < 8; ++i) { cb8[i] = a.in[I_CB][l * 512 + chb + i];
#pragma unroll
        for (int k = 0; k < 4; ++k) cw[k][i] = a.in[I_CW][(l * 4 + k) * 512 + chb + i]; }
    const int ch = tid & 63, sg = tid >> 6, chg = h * 64 + ch;
    const float ba = a.in[I_BA][l * 512 + chg], bx = a.in[I_BX][l * 512 + chg], lam = a.in[I_LAM][l * 512 + chg];
    const float sp8 = -8.f * (fmaxf(-lam, 0.f) + log1pf(__expf(-fabsf(lam))));
    const int fr = lane & 15, fq = lane >> 4, mat = wid >> 2, strip = wid & 3;
    const bf16_t* pu = P + (size_t)b * SEQ * PP + C_U + chb;
    u32x4 ur[4];
#pragma unroll
    for (int k = 0; k < 4; ++k) { const int t = tk1 - 3 + k; ur[k] = (t >= 0) ? *(const u32x4*)(pu + (size_t)t * PP) : (u32x4){0u, 0u, 0u, 0u}; }
    for (int tile = 0; tile < SEQ / 64; ++tile) {
        const int t0 = tile * 64;
        {   float xc[8];
#pragma unroll
            for (int i = 0; i < 8; ++i) xc[i] = cb8[i];
#pragma unroll
            for (int k = 0; k < 4; ++k) { float uf[8]; unpack8(ur[k], uf);
#pragma unroll
                for (int i = 0; i < 8; ++i) xc[i] += cw[k][i] * uf[i]; }
            *(f32x4*)(XF + tk1 * 64 + c8) = (f32x4){xc[0], xc[1], xc[2], xc[3]}; *(f32x4*)(XF + tk1 * 64 + c8 + 4) = (f32x4){xc[4], xc[5], xc[6], xc[7]};
            u32x4 pk; pk[0] = pk2(xc[0], xc[1]); pk[1] = pk2(xc[2], xc[3]); pk[2] = pk2(xc[4], xc[5]); pk[3] = pk2(xc[6], xc[7]);
            *(u32x4*)(XB + tk1 * 72 + c8) = pk;
            if (tile + 1 < SEQ / 64) {
#pragma unroll
                for (int k = 0; k < 4; ++k) ur[k] = *(const u32x4*)(pu + (size_t)(t0 + 64 + tk1 - 3 + k) * PP);
            }
        }
        __syncthreads();
        {   const bf16_t* W = mat ? WXl : WAl;
            f32x4 acc[4];
#pragma unroll
            for (int nt = 0; nt < 4; ++nt) acc[nt] = (f32x4){0.f, 0.f, 0.f, 0.f};
#pragma unroll
            for (int ks = 0; ks < 2; ++ks) {
                const bf16x8 af = *(const bf16x8*)(XB + (16 * strip + fr) * 72 + ks * 32 + fq * 8);
#pragma unroll
                for (int nt = 0; nt < 4; ++nt) { const bf16x8 bw = *(const bf16x8*)(W + (16 * nt + fr) * 72 + ks * 32 + fq * 8); acc[nt] = __builtin_amdgcn_mfma_f32_16x16x32_bf16(af, bw, acc[nt], 0, 0, 0); }
            }
            float* Gm = G + mat * 64 * 65;
#pragma unroll
            for (int nt = 0; nt < 4; ++nt)
#pragma unroll
                for (int i = 0; i < 4; ++i) Gm[(16 * strip + 4 * fq + i) * 65 + 16 * nt + fr] = acc[nt][i];
        }
        __syncthreads();
        {   const bf16_t* pz = P + (size_t)(b * SEQ + t0 + sg * 8) * PP + C_Z + chg;
            bf16_t zr[8];
#pragma unroll
            for (int k = 0; k < 8; ++k) zr[k] = pz[(size_t)k * PP];
            float av[8], bv[8]; float A = 1.f, Bc = 0.f;
#pragma unroll
            for (int k = 0; k < 8; ++k) {
                const int tk = sg * 8 + k;
                const float r = fsig(G[tk * 65 + ch] + ba), ig = fsig(G[64 * 65 + tk * 65 + ch] + bx), xcv = XF[tk * 64 + ch];
                const float la = r * sp8;
                av[k] = __expf(la); bv[k] = __builtin_amdgcn_sqrtf(neg_expm1(2.f * la, av[k] * av[k])) * (ig * xcv);
                Bc = av[k] * Bc + bv[k]; A *= av[k];
            }
            SA[sg * 64 + ch] = A; SB[sg * 64 + ch] = Bc;
            __syncthreads();
            float hs = CY[(tile & 1) * 64 + ch];
            for (int s = 0; s < sg; ++s) hs = SA[s * 64 + ch] * hs + SB[s * 64 + ch];
            bf16_t* py = Y + (size_t)(b * SEQ + t0 + sg * 8) * DMIX + chg;
#pragma unroll
            for (int k = 0; k < 8; ++k) { hs = av[k] * hs + bv[k]; const float zf = bf2f(zr[k]); py[(size_t)k * DMIX] = (bf16_t)f2bf(hs * zf * fsig(zf)); }
            if (sg == 7) CY[((tile & 1) ^ 1) * 64 + ch] = hs;
        }
    }
    __syncthreads();
}


template <bool ONLINE> DI void phase_mix(const Args& a, int l, unsigned char* lds, int cofs = 0, bool only_lru = false) {
    unsigned* ctr = (unsigned*)(a.ws + WS_CTL) + l * 16 + cofs;
    volatile int* UNIT = (volatile int*)(lds + A_UNIT);
    if (blockIdx.x < 128) lru_unit(a, l, lds, blockIdx.x >> 3, blockIdx.x & 7);
    if (only_lru) return;
    __syncthreads();
    if (threadIdx.x == 0) UNIT[0] = (int)atomicAdd(ctr, 1u);
    __syncthreads();
    for (int u = UNIT[0]; u < 1024; ) {
        int nxt = 0; if (threadIdx.x == 0) nxt = (int)atomicAdd(ctr, 1u);
        nsa_unit<ONLINE>(a, l, lds, (u & 31) >> 1, u & 1, 31 - (u >> 5));
        if (threadIdx.x == 0) UNIT[0] = nxt;
        __syncthreads();
        u = UNIT[0];
    }
    __syncthreads();
    if (threadIdx.x == 0) UNIT[0] = (int)atomicAdd(ctr + 1, 1u);
    __syncthreads();
    for (int u = UNIT[0]; u < 1024; ) {
        int nxt = 0; if (threadIdx.x == 0) nxt = (int)atomicAdd(ctr + 1, 1u);
        fox_unit<ONLINE>(a, l, lds, (u & 127) >> 3, u & 7, 7 - (u >> 7));
        if (threadIdx.x == 0) UNIT[0] = nxt;
        __syncthreads();
        u = UNIT[0];
    }
}

#define XB_TMO      128
#define XB_XCNT(j)  (256  + 64 * (j))
#define XB_XSUB(j)  (1280 + 64 * (j))
#define XB_XGEN(j)  (2304 + 64 * (j))
#define XB_TOP      3328
#define XB_TOPGEN   3392
#define XCD_BAR_WORDS 3456
#define XB_SPIN_CAP (1u << 18)
DI unsigned xb_ld(unsigned* p)              { return __hip_atomic_load(p, __ATOMIC_RELAXED, __HIP_MEMORY_SCOPE_AGENT); }
DI unsigned xb_add(unsigned* p, unsigned v) { return __hip_atomic_fetch_add(p, v, __ATOMIC_RELAXED, __HIP_MEMORY_SCOPE_AGENT); }
DI unsigned xb_xcc_id() { return (unsigned)__builtin_amdgcn_s_getreg((3 << 11) | 20) & 0xFu; }
#define XB_SPIN(cond, bar) do { unsigned _sp = 0; while (cond) { __builtin_amdgcn_s_sleep(1); \
    if ((++_sp & 255u) == 0u) { if (xb_ld(&(bar)[XB_TMO])) break; if (_sp > XB_SPIN_CAP) { atomicAdd(&(bar)[XB_TMO], 1u); break; } } } } while (0)
struct XcdBarrier { unsigned* bar; unsigned x; volatile LAS3 unsigned* st; };
DI XcdBarrier xcd_barrier_post(unsigned* bar, volatile LAS3 unsigned* st) {
    XcdBarrier b; b.bar = bar; b.x = xb_xcc_id(); b.st = st;
    if (threadIdx.x == 0) (void)xb_add(&bar[XB_XCNT(b.x)], 1u);
    return b;
}
DI void xcd_barrier_complete(unsigned* bar, unsigned x, unsigned& nloc, unsigned& nx) {
    const unsigned G = gridDim.x * gridDim.y * gridDim.z;
    unsigned sum, cnt, mine, sp = 0u;
    for (;;) {
        sum = 0u; cnt = 0u; mine = 0u;
#pragma unroll
        for (unsigned j = 0; j < 16; ++j) { const unsigned c = xb_ld(&bar[XB_XCNT(j)]); sum += c; cnt += (c > 0u) ? 1u : 0u; mine = (j == x) ? c : mine; }
        if (sum == G) break;
        __builtin_amdgcn_s_sleep(1);
        if ((++sp & 255u) == 0u) { if (xb_ld(&bar[XB_TMO])) break; if (sp > XB_SPIN_CAP) { atomicAdd(&bar[XB_TMO], 1u); break; } }
    }
    nloc = mine > 0u ? mine : 1u; nx = cnt > 0u ? cnt : 1u;
}
DI void xcd_barrier(const XcdBarrier& b) {
    asm volatile("s_waitcnt vmcnt(0)" ::: "memory");
    __syncthreads();
    if (threadIdx.x == 0) {
        unsigned* bar = b.bar;
        __builtin_amdgcn_s_waitcnt(0);
        unsigned nloc = b.st[0], nx = b.st[1];
        if (nloc == 0u) { xcd_barrier_complete(bar, b.x, nloc, nx); b.st[0] = nloc; b.st[1] = nx; }
        const unsigned old = xb_add(&bar[XB_XSUB(b.x)], 1u);
        const unsigned gen = old / nloc;
        if (old + 1u == (gen + 1u) * nloc) {
            __builtin_amdgcn_fence(__ATOMIC_RELEASE, "agent");
            asm volatile("s_waitcnt vmcnt(0)" ::: "memory");
            const unsigned og = xb_add(&bar[XB_TOP], 1u);
            const unsigned tg = og / nx;
            if (og + 1u == (tg + 1u) * nx) xb_add(&bar[XB_TOPGEN], 1u);
            else XB_SPIN(xb_ld(&bar[XB_TOPGEN]) == tg, bar);
            __builtin_amdgcn_fence(__ATOMIC_ACQUIRE, "agent");
            xb_add(&bar[XB_XGEN(b.x)], 1u);
            asm volatile("s_waitcnt vmcnt(0)" ::: "memory");
        } else {
            XB_SPIN(xb_ld(&bar[XB_XGEN(b.x)]) == gen, bar);
            __builtin_amdgcn_fence(__ATOMIC_ACQUIRE, "agent");
            asm volatile("s_waitcnt vmcnt(0)" ::: "memory");
        }
    }
    __syncthreads();
}

#ifndef DUP
#define DUP 0
#endif
#define LP_PTRS unsigned char* ws = a.ws; bf16_t* P = (bf16_t*)(ws + WS_P); bf16_t* HY = (bf16_t*)(ws + WS_HY); bf16_t* H = (bf16_t*)(ws + WS_H); float* SS = (float*)(ws + WS_SS); float* GL = (float*)(ws + WS_GL); const float* xin = L ? a.out : a.in[I_X]; (void)P; (void)HY; (void)H; (void)SS; (void)GL; (void)xin
template <int L> DI void layer_phases(const Args& a, const XcdBarrier& bar, unsigned char* lds) {
    {   LP_PTRS; const bf16_t* W = (const bf16_t*)(ws + WS_WIN) + (size_t)L * NPAD * DM;
        pg8::Gemm g{H, W, NT, PP, DM}; pg8::StaticOrder S; S.init(NT, PP, (int)gridDim.x, (int)blockIdx.x);
        pg8::EpiProjF E{P, L ? SS : nullptr, (PG8_LAS float*)((PG8_LAS unsigned char*)lds + pg8::STAGE_BYTES), (const float*)(ws + WS_GAINS) + L * 320}; pg8::gemm_phase<pg8::EpiProjF, pg8::StaticOrder, true, true>((PG8_LAS unsigned char*)lds, g, S, E);
        gates_gemm(H, W + (size_t)PP * DM, GL, L ? SS : nullptr, L == 1);
        if (L == 0) { __syncthreads(); win1_late(a, (float*)lds); }
        if (DUP == 2 && L == 0) { xcd_barrier(bar); pg8::gemm_phase<pg8::EpiProjF, pg8::StaticOrder, true, true>((PG8_LAS unsigned char*)lds, g, S, E); gates_gemm(H, W + (size_t)PP * DM, GL, L ? SS : nullptr, false); } }
    xcd_barrier(bar);
    {   LP_PTRS; prep_cumsum(a, L, (float*)lds); prep_compress(a, L, P); if (L == 0) { __syncthreads(); phase_wprep(a, (float*)lds, 1); }
        if (DUP == 3 && L == 0) { xcd_barrier(bar); prep_cumsum(a, L, (float*)lds); prep_compress(a, L, P); } }
    xcd_barrier(bar);
    {   const float* bnd = (const float*)(a.ws + WS_BND) + L * 4;
        const bool online = fmaxf(fmaxf(bnd[0], bnd[1]), fmaxf(bnd[2], bnd[3])) > 60.f;
        if (online) phase_mix<true>(a, L, lds); else phase_mix<false>(a, L, lds);
        if (DUP == 4 && L == 0) { xcd_barrier(bar); phase_mix<false>(a, L, lds, 4); } }
    xcd_barrier(bar);
    {   LP_PTRS; pg8::Gemm g{HY, (const bf16_t*)(ws + WS_WOUT) + (size_t)L * DM * DMIX, NT, DM, DMIX}; pg8::StaticOrder S; S.init(NT, DM, (int)gridDim.x, (int)blockIdx.x);
        pg8::EpiOutF E{L ? nullptr : a.in[I_X], L ? H : nullptr, L ? a.out : nullptr, L ? nullptr : H, SS}; pg8::gemm_phase<pg8::EpiOutF, pg8::StaticOrder, true, true>((PG8_LAS unsigned char*)lds, g, S, E); }
}
__global__ void __launch_bounds__(512, 2) mk(Args a) {
    extern __shared__ __attribute__((aligned(16))) unsigned char lds[];
    __shared__ unsigned xb_st[2];
    cg::grid_group grid = cg::this_grid();
    if (threadIdx.x < 2) xb_st[threadIdx.x] = 0u;
    __syncthreads();
    const XcdBarrier bar = xcd_barrier_post((unsigned*)(a.ws + WS_CTL + 1024), (volatile LAS3 unsigned*)xb_st);
    phase_wprep(a, (float*)lds, 0);
    phase_rms(a.in[I_X], a.in[I_NG], (bf16_t*)(a.ws + WS_H));
    for (int i = blockIdx.x * 512 + threadIdx.x; i < NT; i += gridDim.x * 512) ((float*)(a.ws + WS_SS))[i] = 0.f;
    if (a.ph_lo < 0) grid.sync();
    xcd_barrier(bar);
    layer_phases<0>(a, bar, lds);
    xcd_barrier(bar);
    layer_phases<1>(a, bar, lds);
}

extern "C" void kernel_launch(void* const* d_in, const int* in_sizes, int n_in, void* d_out, int out_size, void* d_ws, size_t ws_size, hipStream_t stream) {
    static int grid = 0;
    if (grid == 0) {
        if (n_in != 21 || ws_size < WS_END) { fprintf(stderr, "kernel_launch: unexpected n_in %d / ws_size %zu (need %zu)\n", n_in, ws_size, (size_t)WS_END); grid = -1; return; }
        int dev = 0, cus = 0, per_cu = 0;
        (void)hipGetDevice(&dev); (void)hipDeviceGetAttribute(&cus, hipDeviceAttributeMultiprocessorCount, dev);
        (void)hipFuncSetAttribute((const void*)mk, hipFuncAttributeMaxDynamicSharedMemorySize, LDS_BYTES);
        (void)hipOccupancyMaxActiveBlocksPerMultiprocessor(&per_cu, (const void*)mk, 512, LDS_BYTES);
        if (per_cu < 1) { fprintf(stderr, "kernel_launch: occupancy query says %d blocks/CU\n", per_cu); per_cu = 1; }
        if (per_cu > 1) per_cu = 1;
        grid = cus * per_cu;
        (void)hipGetLastError();
    }
    if (grid < 0) return;
    if (hipMemsetAsync((char*)d_ws + WS_CTL, 0, WS_CTL_BYTES, stream) != hipSuccess) { fprintf(stderr, "kernel_launch: memset failed\n"); return; }
    Args a{};
    for (int i = 0; i < 21; ++i) a.in[i] = (const float*)d_in[i];
    a.out = (float*)d_out; a.ws = (unsigned char*)d_ws; a.ph_lo = 0; a.ph_hi = 13;
    void* args[] = {&a};
    hipError_t e = hipLaunchCooperativeKernel((const void*)mk, dim3(grid), dim3(512), args, LDS_BYTES, stream);
    if (e != hipSuccess) fprintf(stderr, "cooperative launch failed: %s (grid %d)\n", hipGetErrorString(e), grid);
}
```

```cpp
#define DUP 0
#include <hip/hip_runtime.h>
#include <hip/hip_cooperative_groups.h>
#include <stdint.h>
#include <stdio.h>
namespace cg = cooperative_groups;

#define DI __device__ __forceinline__
typedef unsigned short bf16_t;
typedef short bf16x8 __attribute__((ext_vector_type(8)));
typedef float f32x4 __attribute__((ext_vector_type(4)));
typedef float f32x16 __attribute__((ext_vector_type(16)));
typedef unsigned u32x4 __attribute__((ext_vector_type(4)));
typedef unsigned u32x2 __attribute__((ext_vector_type(2)));

constexpr int NB = 16, SEQ = 2048, DM = 1024, NT = NB * SEQ;
constexpr int DIN = 4896, DMIX = 1536, PP = 4864, NPAD = 5120;
constexpr int C_U = 0, C_Z = 512, C_NQ = 1024, C_KC = 1536, C_VC = 1664, C_KS = 1792, C_VS = 1920, C_KW = 2048, C_VW = 2176,
              C_NZ = 2304, C_FQ = 2816, C_FK = 3328, C_FV = 3840, C_FZ = 4352;
constexpr float LOG2E = 1.4426950408889634f, QS = 0.125f * LOG2E, EPS = 1e-6f;

constexpr size_t WS_P = 0;
constexpr size_t WS_HY = WS_P + (size_t)NT * PP * 2;
constexpr size_t WS_H = WS_HY + (size_t)NT * DMIX * 2;
constexpr size_t WS_SS = WS_H + (size_t)NT * DM * 2;
constexpr size_t WS_GL = WS_SS + (size_t)NT * 4;
constexpr size_t WS_WIN = WS_GL + (size_t)NT * 32 * 4;
constexpr size_t WS_WOUT = WS_WIN + (size_t)2 * NPAD * DM * 2;
constexpr size_t WS_WA = WS_WOUT + (size_t)2 * DM * DMIX * 2;
constexpr size_t WS_WX = WS_WA + 131072;
constexpr size_t WS_WCK = WS_WX + 131072;
constexpr size_t WS_WCV = WS_WCK + 524288;
constexpr size_t WS_BKV = WS_WCV + 524288;
constexpr size_t WS_BND = WS_BKV + 1024;
constexpr size_t WS_GAINS = WS_BKV + 2048;
constexpr size_t WS_C2 = WS_BKV + 8192;
constexpr size_t WS_KCMP = WS_C2 + (size_t)NB * 8 * SEQ * 4;
constexpr size_t WS_VCMP = WS_KCMP + 524288;
constexpr size_t WS_CTL = WS_VCMP + 524288;
constexpr size_t WS_CTL_BYTES = 16384;
constexpr size_t WS_END = WS_CTL + WS_CTL_BYTES;

constexpr int LDS_BYTES = 143360;

struct Args { const float* in[21]; float* out; unsigned char* ws; int ph_lo, ph_hi; };
enum { I_X = 0, I_NG, I_WIN, I_WOUT, I_CW, I_CB, I_WA, I_BA, I_WX, I_BX, I_LAM, I_NQG, I_NKG, I_PEK, I_PEV, I_WCK, I_WCV, I_GB, I_FQG, I_FKG, I_FFB };

DI int opaque_tid() { int t = threadIdx.x; asm volatile("" : "+v"(t)); return t; }
DI unsigned f2bf(float f) { unsigned u = __float_as_uint(f); return (u + 0x7fffu + ((u >> 16) & 1u)) >> 16; }
DI float bf2f(unsigned h) { return __uint_as_float(h << 16); }
DI unsigned pk2(float lo, float hi) { return f2bf(lo) | (f2bf(hi) << 16); }
DI float wave_sum(float v) { for (int o = 32; o; o >>= 1) v += __shfl_xor(v, o); return v; }
DI float sigmoidf_(float x) { return __builtin_amdgcn_rcpf(1.f + __expf(-x)); }
DI float siluf_(float x) { return x * __builtin_amdgcn_rcpf(1.f + __expf(-x)); }
DI void unpack8(u32x4 r, float* f) {
#pragma unroll
    for (int i = 0; i < 4; ++i) { f[2 * i] = bf2f(r[i] & 0xffffu); f[2 * i + 1] = bf2f(r[i] >> 16); }
}

DI int win_col(int pc) {
    if (pc < 2304) return pc; if (pc < 4352) return pc + 24; if (pc < 4864) return pc + 32;
    if (pc < 4888) return 2304 + pc - 4864; if (pc < 4896) return 4376 + pc - 4888; return -1;
}
DI void wtile(const float* src, int ldsrc, bf16_t* dst, int K, int n0, int k0, int mode, float* t, const float* rowg = nullptr) {
    const int tid = opaque_tid();
#pragma unroll
    for (int i = 0; i < 8; ++i) {
        int kk = (tid >> 6) + 8 * i, nn = tid & 63, n = n0 + nn; int oc = mode ? win_col(n) : n;
        t[kk * 65 + nn] = oc >= 0 ? src[(size_t)(k0 + kk) * ldsrc + oc] * (rowg ? rowg[k0 + kk] : 1.f) : 0.f;
    }
    __syncthreads();
    {   const int nn = tid >> 3, k8 = (tid & 7) * 8; u32x4 w;
#pragma unroll
        for (int i = 0; i < 4; ++i) w[i] = pk2(t[(k8 + 2 * i) * 65 + nn], t[(k8 + 2 * i + 1) * 65 + nn]);
        *(u32x4*)(dst + (size_t)(n0 + nn) * K + k0 + k8) = w; }
    __syncthreads();
}
DI void phase_wprep(const Args& a, float* ldsf, int stage) {
    unsigned char* ws = a.ws;
    constexpr int PER = 1280 + 384 + 8 + 8 + 32 + 32 + 2;
    const bool split = gridDim.x >= 256;
    if (stage == 1 && (!split || blockIdx.x < 16)) return;
    const int ub = stage == 1 ? (int)blockIdx.x - 16 : (int)blockIdx.x, us = stage == 1 ? (int)gridDim.x - 16 : (int)gridDim.x;
    for (int u = ub; u < 2 * PER; u += us) {
        int l = u / PER, r = u % PER;
        if (split) {
            const bool early = (l == 0 && r < 1280) || (l == 0 && r >= 1280 + 384 + 16 && r < PER - 2) || (r >= PER - 2);
            const bool late1 = (r >= 1280 && r < 1280 + 384 + 16) || (l == 1 && r >= 1280 + 384 + 16 && r < PER - 2);
            if (stage == 0 ? !early : !late1) continue;
        }
        if (r < 1280) { wtile(a.in[I_WIN] + (size_t)l * DM * DIN, DIN, (bf16_t*)(ws + WS_WIN) + (size_t)l * NPAD * DM, DM, (r % 80) * 64, (r / 80) * 64, 1, ldsf, l ? a.in[I_NG] + DM : nullptr); continue; }
        r -= 1280;
        if (r < 384) { wtile(a.in[I_WOUT] + (size_t)l * DMIX * DM, DM, (bf16_t*)(ws + WS_WOUT) + (size_t)l * DM * DMIX, DMIX, (r % 16) * 64, (r / 16) * 64, 0, ldsf); continue; }
        r -= 384;
        if (r < 8) { wtile(a.in[I_WA] + (size_t)(l * 8 + r) * 4096, 64, (bf16_t*)(ws + WS_WA) + (size_t)(l * 8 + r) * 4096, 64, 0, 0, 0, ldsf); continue; }
        r -= 8;
        if (r < 8) { wtile(a.in[I_WX] + (size_t)(l * 8 + r) * 4096, 64, (bf16_t*)(ws + WS_WX) + (size_t)(l * 8 + r) * 4096, 64, 0, 0, 0, ldsf); continue; }
        r -= 8;
        if (r < 32) { wtile(a.in[I_WCK] + (size_t)l * 131072, 64, (bf16_t*)(ws + WS_WCK) + (size_t)l * 131072, 2048, 0, r * 64, 0, ldsf); continue; }
        r -= 32;
        if (r < 32) { wtile(a.in[I_WCV] + (size_t)l * 131072, 64, (bf16_t*)(ws + WS_WCV) + (size_t)l * 131072, 2048, 0, r * 64, 0, ldsf); continue; }
        r -= 32;
        {
            const float* pe = a.in[r ? I_PEV : I_PEK] + (size_t)l * 2048; const float* w = a.in[r ? I_WCV : I_WCK] + (size_t)l * 131072;
            const int e = threadIdx.x & 63, part = threadIdx.x >> 6; float s = 0.f;
#pragma unroll 16
            for (int k = part * 256; k < part * 256 + 256; ++k) s += pe[k] * w[(size_t)k * 64 + e];
            ldsf[part * 64 + e] = s; __syncthreads();
            if (threadIdx.x < 64) { float t = 0.f; for (int p = 0; p < 8; ++p) t += ldsf[p * 64 + e]; ((float*)(ws + WS_BKV))[(l * 2 + r) * 64 + e] = t; }
            if (r == 1 && threadIdx.x < 64) { float* gn = (float*)(ws + WS_GAINS) + l * 320;
                gn[e] = a.in[I_NQG][l * 64 + e] * QS; gn[64 + e] = a.in[I_NKG][(l * 3 + 1) * 64 + e]; gn[128 + e] = a.in[I_NKG][(l * 3 + 2) * 64 + e]; gn[192 + e] = a.in[I_FQG][l * 64 + e] * QS; gn[256 + e] = a.in[I_FKG][l * 64 + e]; }
            if (r == 0 && threadIdx.x < 64) {
                float gq = fabsf(a.in[I_NQG][l * 64 + e]), k0 = fabsf(a.in[I_NKG][(l * 3 + 0) * 64 + e]), k1 = fabsf(a.in[I_NKG][(l * 3 + 1) * 64 + e]), k2 = fabsf(a.in[I_NKG][(l * 3 + 2) * 64 + e]);
                float fq = fabsf(a.in[I_FQG][l * 64 + e]), fk = fabsf(a.in[I_FKG][l * 64 + e]);
                for (int o = 32; o; o >>= 1) { gq = fmaxf(gq, __shfl_xor(gq, o)); k0 = fmaxf(k0, __shfl_xor(k0, o)); k1 = fmaxf(k1, __shfl_xor(k1, o)); k2 = fmaxf(k2, __shfl_xor(k2, o)); fq = fmaxf(fq, __shfl_xor(fq, o)); fk = fmaxf(fk, __shfl_xor(fk, o)); }
                if (e == 0) { float* bnd = (float*)(ws + WS_BND) + l * 4; bnd[0] = QS * 64.f * gq * k0 * 1.01f + 0.5f; bnd[1] = QS * 64.f * gq * k1 * 1.01f + 0.5f; bnd[2] = QS * 64.f * gq * k2 * 1.01f + 0.5f; bnd[3] = QS * 64.f * fq * fk * 1.01f + 0.5f; }
            }
            __syncthreads();
        }
    }
}

DI void win1_late(const Args& a, float* ldsf) {
    if (gridDim.x < 256 || blockIdx.x < 128) return;
    for (int r = (int)blockIdx.x - 128; r < 1280; r += (int)gridDim.x - 128)
        wtile(a.in[I_WIN] + (size_t)DM * DIN, DIN, (bf16_t*)(a.ws + WS_WIN) + (size_t)NPAD * DM, DM, (r % 80) * 64, (r / 80) * 64, 1, ldsf, a.in[I_NG] + DM);
}

DI void phase_rms(const float* x, const float* g, bf16_t* H) {
    const int tid_ = opaque_tid(); const int lane = tid_ & 63, wid = tid_ >> 6;
    const int stride = gridDim.x * 8;
    int row = blockIdx.x * 8 + wid;
    f32x4 v[4], vn[4];
    if (row < NT) {
#pragma unroll
        for (int i = 0; i < 4; ++i) vn[i] = ((const f32x4*)(x + (size_t)row * DM))[lane + 64 * i];
    }
    for (; row < NT; row += stride) {
#pragma unroll
        for (int i = 0; i < 4; ++i) v[i] = vn[i];
        if (row + stride < NT) {
#pragma unroll
            for (int i = 0; i < 4; ++i) vn[i] = ((const f32x4*)(x + (size_t)(row + stride) * DM))[lane + 64 * i];
        }
        float ss = 0.f;
#pragma unroll
        for (int i = 0; i < 4; ++i) ss += v[i][0] * v[i][0] + v[i][1] * v[i][1] + v[i][2] * v[i][2] + v[i][3] * v[i][3];
        ss = wave_sum(ss);
        const float r = rsqrtf(ss * (1.f / DM) + EPS);
#pragma unroll
        for (int i = 0; i < 4; ++i) {
            const f32x4 gg = ((const f32x4*)g)[lane + 64 * i];
            u32x2 o; o[0] = pk2(v[i][0] * r * gg[0], v[i][1] * r * gg[1]); o[1] = pk2(v[i][2] * r * gg[2], v[i][3] * r * gg[3]);
            *(u32x2*)(H + (size_t)row * DM + (lane + 64 * i) * 4) = o;
        }
    }
}

namespace pg8 {
#define PG8_LAS __attribute__((address_space(3)))
typedef unsigned short bf16_t;
typedef short bf16x8 __attribute__((ext_vector_type(8)));
typedef float f32x4 __attribute__((ext_vector_type(4)));
typedef unsigned u32x4 __attribute__((ext_vector_type(4)));
constexpr int BM = 256, BK = 64, HALF = 128, HTB = HALF * BK * 2  , STAGE_BYTES = 8 * HTB, NXCD = 8, WGM = 8;

__host__ __device__ __forceinline__ int lds_byte(int r, int c) { const int st = (r >> 4) * 2 + (c >> 5), rr = r & 15, cc = c & 31, ob = rr * 64 + cc * 2; return st * 1024 + (ob ^ (((ob >> 9) & 1) << 5)); }
__host__ __device__ __forceinline__ void stage_rc(int b, int& R, int& C) { const int st = b / 1024, sb = b % 1024, swz = sb ^ (((sb >> 9) & 1) << 5); R = (st >> 1) * 16 + swz / 64; C = (st & 1) * 32 + (swz % 64) / 2; }
__host__ __device__ __forceinline__ int perm32(int rho) { const int n = rho >> 4, i = rho & 15; return 8 * (i >> 2) + 4 * n + (i & 3); }

struct Unit { int pm, pn; };
struct Gemm { const bf16_t* A; const bf16_t* Bt; int M, N, K; };

struct StaticOrder {
    int nM, nN, nwg, G, c;
    __host__ __device__ void init(int M, int N, int G_, int c_) { nM = M / BM; nN = N / BM; nwg = nM * nN; G = G_; c = c_; }
    __host__ __device__ bool next(int i, Unit& u) const {
        const long L = (long)i * G + c; if (L >= nwg) return false;
        int wgid = (int)L; { const int q = nwg / NXCD, r = nwg % NXCD, xcd = wgid % NXCD, off = wgid / NXCD; wgid = (xcd < r ? xcd * (q + 1) : r * (q + 1) + (xcd - r) * q) + off; }
        const int nig = WGM * nN, gid = wgid / nig, fm = gid * WGM, gsz = (nM - fm) < WGM ? (nM - fm) : WGM;
        u.pm = fm + ((wgid % nig) % gsz); u.pn = (wgid % nig) / gsz; return true;
    }
    __device__ __forceinline__ void a_ready(const Unit&) const {}
    __device__ __forceinline__ void done(const Unit&) const {}
};
__device__ __forceinline__ unsigned cvt_pk_bf16(float lo, float hi) { unsigned r; asm volatile("v_cvt_pk_bf16_f32 %0, %1, %2" : "=v"(r) : "v"(lo), "v"(hi)); return r; }

struct EpiProjF {
    static constexpr bool PERM = true, AFTER_DRAIN = false;
    bf16_t* P; const float* ss; PG8_LAS float* xs  ; const float* gains  ;
    __device__ __forceinline__ void operator()(const f32x4 (&acc)[2][2][4][2], const Unit& u, int wr, int wc, int fr, int fq) const {
        const int row0 = u.pm * BM + wr * 64 + fr;
        const int col0 = u.pn * BM + wc * 32 + 8 * fq;
        const int pn = u.pn, wid = wr * 4 + wc;
        const bool need = (pn == 4) | (pn == 5) | (pn == 7) | (pn == 8) | ((pn >= 11) & (pn <= 14));
        float hs[2][4][2];
        if (need) {
#pragma unroll
            for (int ai = 0; ai < 2; ++ai)
#pragma unroll
                for (int m = 0; m < 4; ++m)
#pragma unroll
                    for (int bj = 0; bj < 2; ++bj) { const f32x4 v0 = acc[ai][bj][m][0], v1 = acc[ai][bj][m][1];
                        float s = v0[0] * v0[0] + v0[1] * v0[1] + v0[2] * v0[2] + v0[3] * v0[3] + v1[0] * v1[0] + v1[1] * v1[1] + v1[2] * v1[2] + v1[3] * v1[3];
                        s += __shfl_xor(s, 16); s += __shfl_xor(s, 32);
                        hs[ai][m][bj] = s;
                        if (fq == 0) xs[(((wid * 2 + ai) * 4 + m) * 2 + bj) * 16 + fr] = s; }
            asm volatile("s_waitcnt lgkmcnt(0)" ::: "memory");
            __builtin_amdgcn_s_barrier();
        }
        const int kind = (pn <= 5) ? 0 : (pn == 7) ? 1 : (pn == 8) ? 2 : (pn <= 12) ? 3 : 4;
#pragma unroll
        for (int bj = 0; bj < 2; ++bj) {
            const bool hn = need && !((pn == 7 || pn == 8) && bj == 1);
            f32x4 g0 = (f32x4){1.f, 1.f, 1.f, 1.f}, g1 = g0;
            if (hn) { g0 = *(const f32x4*)(gains + kind * 64 + (wc & 1) * 32 + 8 * fq); g1 = *(const f32x4*)(gains + kind * 64 + (wc & 1) * 32 + 8 * fq + 4); }
#pragma unroll
            for (int ai = 0; ai < 2; ++ai)
#pragma unroll
                for (int m = 0; m < 4; ++m) { const int row = row0 + ai * HALF + m * 16;
                    const float rr = ss ? rsqrtf(ss[row] * (1.f / 1024) + 1e-6f) : 1.f;
                    float rs = rr;
                    if (hn) { const float tot = (hs[ai][m][bj] + xs[((((wid ^ 1) * 2 + ai) * 4 + m) * 2 + bj) * 16 + fr]) * rr * rr; rs = rr * rsqrtf(tot * (1.f / 64) + 1e-6f); }
                    const f32x4 v0 = acc[ai][bj][m][0] * rs * g0, v1 = acc[ai][bj][m][1] * rs * g1;
                    u32x4 w; w.x = cvt_pk_bf16(v0[0], v0[1]); w.y = cvt_pk_bf16(v0[2], v0[3]); w.z = cvt_pk_bf16(v1[0], v1[1]); w.w = cvt_pk_bf16(v1[2], v1[3]);
                    *(u32x4*)(P + (size_t)row * 4864 + col0 + bj * HALF) = w; }
        }
    }
};
struct EpiOutF {
    static constexpr bool PERM = true, AFTER_DRAIN = false;
    const float* res32; const bf16_t* res16; float* out32; bf16_t* out16; float* ss;
    __device__ __forceinline__ void operator()(const f32x4 (&acc)[2][2][4][2], const Unit& u, int wr, int wc, int fr, int fq) const {
        const int row0 = u.pm * BM + wr * 64 + fr, col0 = u.pn * BM + wc * 32 + 8 * fq;
#pragma unroll
        for (int ai = 0; ai < 2; ++ai)
#pragma unroll
            for (int m = 0; m < 4; ++m) { const int row = row0 + ai * HALF + m * 16; const size_t off = (size_t)row * 1024 + col0;
                float sq = 0.f;
#pragma unroll
                for (int bj = 0; bj < 2; ++bj) {
                    f32x4 r0, r1;
                    if (res16) { const u32x4 rb = *(const u32x4*)(res16 + off + bj * HALF);
                        r0 = (f32x4){__uint_as_float(rb[0] << 16), __uint_as_float(rb[0] & 0xffff0000u), __uint_as_float(rb[1] << 16), __uint_as_float(rb[1] & 0xffff0000u)};
                        r1 = (f32x4){__uint_as_float(rb[2] << 16), __uint_as_float(rb[2] & 0xffff0000u), __uint_as_float(rb[3] << 16), __uint_as_float(rb[3] & 0xffff0000u)}; }
                    else { r0 = *(const f32x4*)(res32 + off + bj * HALF); r1 = *(const f32x4*)(res32 + off + bj * HALF + 4); }
                    const f32x4 o0 = r0 + acc[ai][bj][m][0], o1 = r1 + acc[ai][bj][m][1];
                    if (out32) { *(f32x4*)(out32 + off + bj * HALF) = o0; *(f32x4*)(out32 + off + bj * HALF + 4) = o1; }
                    if (out16) { sq += o0[0] * o0[0] + o0[1] * o0[1] + o0[2] * o0[2] + o0[3] * o0[3] + o1[0] * o1[0] + o1[1] * o1[1] + o1[2] * o1[2] + o1[3] * o1[3];
                        u32x4 w; w.x = cvt_pk_bf16(o0[0], o0[1]); w.y = cvt_pk_bf16(o0[2], o0[3]); w.z = cvt_pk_bf16(o1[0], o1[1]); w.w = cvt_pk_bf16(o1[2], o1[3]);
                        *(u32x4*)(out16 + off + bj * HALF) = w; }
                    __builtin_amdgcn_sched_barrier(0); }
                if (out16) { sq += __shfl_xor(sq, 16); sq += __shfl_xor(sq, 32); if (fq == 0) atomicAdd(ss + row, sq); } }
    }
};

template <class Epi, class Sched, bool ALIGN_EPI = false, bool SP2 = false>
__device__ __forceinline__ void gemm_phase(PG8_LAS unsigned char* lds, const Gemm g, const Sched& S, const Epi& E) {
    int tid = threadIdx.x; asm volatile("" : "+v"(tid));
    const int wid = __builtin_amdgcn_readfirstlane(tid >> 6), lane = tid & 63, wr = wid >> 2, wc = wid & 3, fr = lane & 15, fq = lane >> 4;
    const int K = g.K, nt = K / BK;
    unsigned voffA[2], voffB[2];
#pragma unroll
    for (int i = 0; i < 2; ++i) { int R, C; stage_rc(tid * 16 + i * 8192, R, C); const int Rb = Epi::PERM ? ((R & ~31) + perm32(R & 31)) : R;
        voffA[i] = (unsigned)(R * K + C) * 2u; voffB[i] = (unsigned)(Rb * K + C) * 2u; }
    const size_t kstep = (size_t)(BK * 2);
    const size_t hstep = (size_t)HALF * K * 2;
    const size_t tstep = 2 * hstep;
    const unsigned ldsw = (unsigned)wid * 1024u;
    const int aoff = lds_byte(wr * 64 + fr, fq * 8), boff = lds_byte(wc * 32 + fr, fq * 8);
#define PG8_SA(b, h) (((b) * 2 + (h)) * HTB)
#define PG8_SB(b, h) ((4 + (b) * 2 + (h)) * HTB)
#define PG8_STAGE(bufoff, gbase, voff) do { _Pragma("unroll") for (int _i = 0; _i < 2; ++_i) \
        __builtin_amdgcn_global_load_lds((const unsigned*)((const char*)(gbase) + (voff)[_i]), (PG8_LAS unsigned*)(lds + (bufoff) + ldsw + _i * 8192), 16, 0, 0); } while (0)
#define PG8_LDA(dst, b, h) do { _Pragma("unroll") for (int m = 0; m < 4; ++m) _Pragma("unroll") for (int k = 0; k < 2; ++k) dst[m][k] = *(const PG8_LAS bf16x8*)(lds + PG8_SA(b, h) + aoff + m * 2048 + k * 1024); } while (0)
#define PG8_LDB(dst, b, h) do { _Pragma("unroll") for (int n = 0; n < 2; ++n) _Pragma("unroll") for (int k = 0; k < 2; ++k) dst[n][k] = *(const PG8_LAS bf16x8*)(lds + PG8_SB(b, h) + boff + n * 2048 + k * 1024); } while (0)
#define PG8_MMA(ai, bj, At, Bt) do { __builtin_amdgcn_s_setprio(1); _Pragma("unroll") for (int m = 0; m < 4; ++m) _Pragma("unroll") for (int n = 0; n < 2; ++n) _Pragma("unroll") for (int k = 0; k < 2; ++k) \
        acc[ai][bj][m][n] = __builtin_amdgcn_mfma_f32_16x16x32_bf16(Bt[n][k], At[m][k], acc[ai][bj][m][n], 0, 0, 0); __builtin_amdgcn_s_setprio(0); } while (0)
#define PG8_WAIT_V(n) asm volatile("s_waitcnt vmcnt(" #n ")" ::: "memory")
#define PG8_WAIT_L(n) asm volatile("s_waitcnt lgkmcnt(" #n ")" ::: "memory")
#define PG8_BAR __builtin_amdgcn_s_barrier()
#define PG8_SCHED __builtin_amdgcn_sched_barrier(0)
    Unit cur, nxt; int ui = 0;
    if (!S.next(0, cur)) return;
    f32x4 acc[2][2][4][2];
#pragma unroll
    for (int a = 0; a < 2; ++a)
#pragma unroll
        for (int b = 0; b < 2; ++b)
#pragma unroll
            for (int m = 0; m < 4; ++m)
#pragma unroll
                for (int n = 0; n < 2; ++n) acc[a][b][m][n] = (f32x4){0.f, 0.f, 0.f, 0.f};
    bf16x8 At[4][2], B0[2][2], B1[2][2];
    const char* cA = (const char*)g.A + (size_t)cur.pm * tstep; const char* cB = (const char*)g.Bt + (size_t)cur.pn * tstep;
    S.a_ready(cur);
    if constexpr (SP2) {
        PG8_STAGE(PG8_SB(0, 0), cB, voffB); PG8_STAGE(PG8_SB(0, 1), cB + hstep, voffB); PG8_STAGE(PG8_SA(0, 0), cA, voffA); PG8_STAGE(PG8_SA(0, 1), cA + hstep, voffA);
        if (wr == 1) PG8_BAR;
        PG8_WAIT_V(2); PG8_BAR;
        PG8_STAGE(PG8_SB(1, 0), cB + kstep, voffB); PG8_STAGE(PG8_SA(1, 0), cA + kstep, voffA); PG8_STAGE(PG8_SB(1, 1), cB + hstep + kstep, voffB);
        PG8_WAIT_V(6); PG8_BAR;
    } else {
        PG8_STAGE(PG8_SB(0, 0), cB, voffB); PG8_STAGE(PG8_SA(0, 0), cA, voffA); PG8_STAGE(PG8_SB(0, 1), cB + hstep, voffB); PG8_STAGE(PG8_SA(0, 1), cA + hstep, voffA);
        if (wr == 1) PG8_BAR;
        PG8_WAIT_V(4); PG8_BAR;
        PG8_STAGE(PG8_SB(1, 0), cB + kstep, voffB); PG8_STAGE(PG8_SA(1, 0), cA + kstep, voffA); PG8_STAGE(PG8_SB(1, 1), cB + hstep + kstep, voffB);
        PG8_WAIT_V(6); PG8_BAR;
    }
    for (;;) {
        const bool has_next = S.next(ui + 1, nxt);
        const char* nA = has_next ? (const char*)g.A + (size_t)nxt.pm * tstep : cA; const char* nB = has_next ? (const char*)g.Bt + (size_t)nxt.pn * tstep : cB;
        for (int t = 0; t < nt; t += 2) {
            const bool last = (t == nt - 2);
            const char* a1 = cA + (size_t)(t + 1) * kstep;
            const char* a2 = last ? nA : cA + (size_t)(t + 2) * kstep; const char* b2 = last ? nB : cB + (size_t)(t + 2) * kstep;
            const char* a3 = a2 + kstep; const char* b3 = b2 + kstep;
            if (last && has_next) S.a_ready(nxt);
            if constexpr (SP2) {
            PG8_LDB(B0, 0, 0); PG8_LDB(B1, 0, 1); PG8_SCHED; PG8_LDA(At, 0, 0); PG8_STAGE(PG8_SA(1, 1), a1 + hstep, voffA);
            PG8_WAIT_V(8); PG8_WAIT_L(0); PG8_BAR; PG8_MMA(0, 0, At, B0); PG8_MMA(0, 1, At, B1); PG8_BAR; PG8_SCHED;
            PG8_LDA(At, 0, 1); PG8_STAGE(PG8_SB(0, 0), b2, voffB); PG8_STAGE(PG8_SB(0, 1), b2 + hstep, voffB); PG8_STAGE(PG8_SA(0, 0), a2, voffA);
            PG8_WAIT_V(8); PG8_WAIT_L(0); PG8_BAR; PG8_MMA(1, 0, At, B0); PG8_MMA(1, 1, At, B1); PG8_BAR; PG8_SCHED;
            PG8_LDB(B0, 1, 0); PG8_LDB(B1, 1, 1); PG8_SCHED; PG8_LDA(At, 1, 0); PG8_STAGE(PG8_SA(0, 1), a2 + hstep, voffA);
            PG8_WAIT_V(8); PG8_WAIT_L(0); PG8_BAR; PG8_MMA(0, 0, At, B0); PG8_MMA(0, 1, At, B1); PG8_BAR; PG8_SCHED;
            PG8_LDA(At, 1, 1); PG8_STAGE(PG8_SB(1, 0), b3, voffB); PG8_STAGE(PG8_SB(1, 1), b3 + hstep, voffB); PG8_STAGE(PG8_SA(1, 0), a3, voffA);
            PG8_WAIT_V(8); PG8_WAIT_L(0); PG8_BAR; PG8_MMA(1, 0, At, B0); PG8_MMA(1, 1, At, B1); PG8_BAR; PG8_SCHED;
            } else {
            PG8_LDB(B0, 0, 0); PG8_SCHED; PG8_LDA(At, 0, 0); PG8_STAGE(PG8_SA(1, 1), a1 + hstep, voffA);
            PG8_WAIT_L(8); PG8_BAR; PG8_WAIT_L(0); PG8_MMA(0, 0, At, B0); PG8_BAR; PG8_SCHED;
            PG8_LDB(B1, 0, 1); PG8_STAGE(PG8_SB(0, 0), b2, voffB);
            PG8_BAR; PG8_WAIT_L(0); PG8_MMA(0, 1, At, B1); PG8_BAR;
            PG8_LDA(At, 0, 1); PG8_STAGE(PG8_SA(0, 0), a2, voffA);
            PG8_BAR; PG8_WAIT_L(0); PG8_MMA(1, 0, At, B0); PG8_BAR; PG8_SCHED;
            PG8_STAGE(PG8_SB(0, 1), b2 + hstep, voffB);
            PG8_WAIT_V(6); PG8_BAR; PG8_MMA(1, 1, At, B1); PG8_BAR;
            PG8_LDB(B0, 1, 0); PG8_SCHED; PG8_LDA(At, 1, 0); PG8_STAGE(PG8_SA(0, 1), a2 + hstep, voffA);
            PG8_WAIT_L(8); PG8_BAR; PG8_WAIT_L(0); PG8_MMA(0, 0, At, B0); PG8_BAR; PG8_SCHED;
            PG8_LDB(B1, 1, 1); PG8_STAGE(PG8_SB(1, 0), b3, voffB);
            PG8_BAR; PG8_WAIT_L(0); PG8_MMA(0, 1, At, B1); PG8_BAR;
            PG8_LDA(At, 1, 1); PG8_STAGE(PG8_SA(1, 0), a3, voffA);
            PG8_BAR; PG8_WAIT_L(0); PG8_MMA(1, 0, At, B0); PG8_BAR; PG8_SCHED;
            PG8_STAGE(PG8_SB(1, 1), b3 + hstep, voffB);
            PG8_WAIT_V(6); PG8_BAR; PG8_MMA(1, 1, At, B1); PG8_BAR;
            }
        }
        if constexpr (ALIGN_EPI) { if (wr == 0) PG8_BAR; }
        if constexpr (!Epi::AFTER_DRAIN) { E(acc, cur, wr, wc, fr, fq); S.done(cur); }
        if (!has_next) break;
#pragma unroll
        for (int a = 0; a < 2; ++a)
#pragma unroll
            for (int b = 0; b < 2; ++b)
#pragma unroll
                for (int m = 0; m < 4; ++m)
#pragma unroll
                    for (int n = 0; n < 2; ++n) acc[a][b][m][n] = (f32x4){0.f, 0.f, 0.f, 0.f};
        cur = nxt; cA = nA; cB = nB; ++ui;
        if constexpr (ALIGN_EPI) { if (wr == 1) PG8_BAR; }
    }
    PG8_WAIT_V(0);
    if constexpr (!ALIGN_EPI) { if (wr == 0) PG8_BAR; }
    PG8_BAR;
    if constexpr (Epi::AFTER_DRAIN) { E.fused(acc, cur, wr, wc, fr, fq, lds, wid, lane); S.done(cur); }
#undef PG8_SA
#undef PG8_SB
#undef PG8_STAGE
#undef PG8_LDA
#undef PG8_LDB
#undef PG8_MMA
#undef PG8_WAIT_V
#undef PG8_WAIT_L
#undef PG8_BAR
#undef PG8_SCHED
}
}


DI void gates_gemm(const bf16_t* H, const bf16_t* WgT  , float* GL, const float* ss, bool upper_half_only) {
    const int tid_ = opaque_tid(); const int lane = tid_ & 63, wid = tid_ >> 6, r32 = lane & 31, hi = lane >> 5;
    const int nb = (upper_half_only && gridDim.x >= 256) ? (int)gridDim.x - 128 : (int)gridDim.x, b0 = (int)gridDim.x - nb;
    if ((int)blockIdx.x < b0) return;
    for (int u = ((int)blockIdx.x - b0) + nb * wid; u < NT / 32; u += nb * 8) {
        const bf16_t* ap = H + (size_t)(u * 32 + r32) * DM + hi * 8; const bf16_t* bp = WgT + (size_t)r32 * DM + hi * 8;
        f32x16 acc;
#pragma unroll
        for (int i = 0; i < 16; ++i) acc[i] = 0.f;
#pragma unroll 8
        for (int k = 0; k < DM; k += 16) acc = __builtin_amdgcn_mfma_f32_32x32x16_bf16(*(const bf16x8*)(ap + k), *(const bf16x8*)(bp + k), acc, 0, 0, 0);
#pragma unroll
        for (int i = 0; i < 16; ++i) { const int row = u * 32 + (i & 3) + 8 * (i >> 2) + 4 * hi; const float rs = ss ? rsqrtf(ss[row] * (1.f / 1024) + EPS) : 1.f; GL[(size_t)row * 32 + r32] = acc[i] * rs; }
    }
}

DI float log_sigmoid_(float x) { return fminf(x, 0.f) - log1pf(__expf(-fabsf(x))); }
DI void prep_cumsum(const Args& a, int l, float* LS) {
    const float* GL = (const float*)(a.ws + WS_GL); float* C2 = (float*)(a.ws + WS_C2);
    const int tid = opaque_tid(), lane = tid & 63, wid = tid >> 6;
    for (int b = blockIdx.x; b < NB; b += gridDim.x) {
        __syncthreads();
#pragma unroll
        for (int i = 0; i < 4; ++i) {
            const int t = tid + 512 * i;
            const f32x4 v0 = *(const f32x4*)(GL + (size_t)(b * SEQ + t) * 32 + 24), v1 = *(const f32x4*)(GL + (size_t)(b * SEQ + t) * 32 + 28);
#pragma unroll
            for (int h = 0; h < 4; ++h) { LS[h * 2112 + (t >> 5) * 33 + (t & 31)] = log_sigmoid_(v0[h] + a.in[I_FFB][l * 8 + h]); LS[(h + 4) * 2112 + (t >> 5) * 33 + (t & 31)] = log_sigmoid_(v1[h] + a.in[I_FFB][l * 8 + 4 + h]); }
        }
        __syncthreads();
        {   float* row = LS + wid * 2112 + lane * 33;
            float tot = 0.f;
            for (int k = 0; k < 32; ++k) tot += row[k];
            float inc = tot;
#pragma unroll
            for (int o = 1; o < 64; o <<= 1) { const float n = __shfl_up(inc, o); if (lane >= o) inc += n; }
            float run = inc - tot;
            for (int k = 0; k < 32; ++k) { run += row[k]; row[k] = run * LOG2E; }
        }
        __syncthreads();
#pragma unroll
        for (int i = 0; i < 4; ++i) { const int t = tid + 512 * i;
#pragma unroll
            for (int h = 0; h < 8; ++h) C2[(size_t)(b * 8 + h) * SEQ + t] = LS[h * 2112 + (t >> 5) * 33 + (t & 31)]; }
    }
    __syncthreads();
}
DI void prep_compress(const Args& a, int l, const bf16_t* P) {
    unsigned char* ws = a.ws;
    const int tid_ = opaque_tid(); const int lane = tid_ & 63, wid = tid_ >> 6, fr = lane & 15, fq = lane >> 4;
    const int nbk = gridDim.x > 32 ? (int)gridDim.x - 16 : (int)gridDim.x, bk0 = (int)gridDim.x - nbk;
    if ((int)blockIdx.x < bk0) return;
    for (int it = ((int)blockIdx.x - bk0) + nbk * wid; it < NB * 2 * 2 * 8; it += nbk * 8) {
        const int nq = it & 7, kv = (it >> 3) & 1, g = (it >> 4) & 1, b = it >> 5;
        const int n = 16 * nq + fr; const bool ok = n < 127;
        const bf16_t* src = P + (size_t)(b * SEQ + (ok ? 16 * n : 0)) * PP + (kv ? C_VC : C_KC) + g * 64 + fq * 8;
        const bf16_t* W = (const bf16_t*)(ws + (kv ? WS_WCV : WS_WCK)) + (size_t)l * 131072 + (size_t)fr * 2048 + fq * 8;
        f32x4 acc[4];
#pragma unroll
        for (int nt = 0; nt < 4; ++nt) acc[nt] = (f32x4){0.f, 0.f, 0.f, 0.f};
#pragma unroll 4
        for (int ks = 0; ks < 64; ++ks) {
            bf16x8 af = *(const bf16x8*)(src + (size_t)(ks >> 1) * PP + (ks & 1) * 32);
            if (!ok) af = (bf16x8){0, 0, 0, 0, 0, 0, 0, 0};
#pragma unroll
            for (int nt = 0; nt < 4; ++nt) { const bf16x8 bw = *(const bf16x8*)(W + (size_t)nt * 16 * 2048 + ks * 32); acc[nt] = __builtin_amdgcn_mfma_f32_16x16x32_bf16(af, bw, acc[nt], 0, 0, 0); }
        }
        const float* bias = (const float*)(ws + WS_BKV) + (l * 2 + kv) * 64;
        float v[4][4];
#pragma unroll
        for (int nt = 0; nt < 4; ++nt)
#pragma unroll
            for (int i = 0; i < 4; ++i) v[nt][i] = acc[nt][i] + bias[16 * nt + fr];
        bf16_t* out = (bf16_t*)(ws + (kv ? WS_VCMP : WS_KCMP)) + (size_t)(b * 2 + g) * 128 * 64;
#pragma unroll
        for (int i = 0; i < 4; ++i) {
            const int row = 16 * nq + 4 * fq + i;
            float sc = 1.f;
            if (kv == 0) { float ss = v[0][i] * v[0][i] + v[1][i] * v[1][i] + v[2][i] * v[2][i] + v[3][i] * v[3][i];
                ss += __shfl_xor(ss, 1); ss += __shfl_xor(ss, 2); ss += __shfl_xor(ss, 4); ss += __shfl_xor(ss, 8); sc = rsqrtf(ss * (1.f / 64) + EPS); }
#pragma unroll
            for (int nt = 0; nt < 4; ++nt) { const int e = 16 * nt + fr; float o = v[nt][i] * sc; if (kv == 0) o *= a.in[I_NKG][(l * 3 + 0) * 64 + e]; if (row >= 127) o = 0.f;
                out[(size_t)row * 64 + e] = (bf16_t)f2bf(o); }
        }
    }
}


constexpr int A_KB = 0, A_VB = 18432, A_CB = A_VB + 16384, A_IG = A_CB + 512, A_IL = A_IG + 33792, A_SELM = A_IL + 33792, A_UN = A_SELM + 256, A_UNIT = A_UN + 16, A_SC = A_UNIT + 16, A_KG = A_SC + 2048, A_END = A_KG + 512;
static_assert(A_END <= LDS_BYTES, "attention LDS map");
struct ACtx { int r32, hi, tid, tok; bf16x8 qr[4]; };
typedef float f32x2_t __attribute__((ext_vector_type(2))); typedef __bf16 bf16x2_t __attribute__((ext_vector_type(2)));
typedef short v4i16_t __attribute__((ext_vector_type(4)));
#define LAS3 __attribute__((address_space(3)))
DI unsigned cvtpk(float lo, float hi) { f32x2_t v = {lo, hi}; bf16x2_t bb = __builtin_convertvector(v, bf16x2_t); return __builtin_bit_cast(unsigned, bb); }
DI v4i16_t vtr(const LAS3 unsigned char* p) { return __builtin_amdgcn_ds_read_tr16_b64_v4i16((LAS3 v4i16_t*)p); }

DI void load_q(ACtx& x, const bf16_t* qrow) {
#pragma unroll
    for (int d0 = 0; d0 < 4; ++d0) x.qr[d0] = *(const bf16x8*)(qrow + d0 * 16 + x.hi * 8);
}

template <int MODE, bool ONLINE>
DI void attn_tile_compute(const unsigned char* lds, int cur, int j, const ACtx& x, unsigned selm, int cblk, int wtokmin, float bref, float ctb, f32x16 (&oT)[2], float& m, float& l) {
    const bf16_t* KB = (const bf16_t*)(lds + A_KB) + cur * 4608;
    const int lane = x.tid & 63;
    f32x16 p0, p1;
    if (MODE == 3) {
        const float* CB = (const float*)(lds + A_CB) + cur * 64 + 4 * x.hi;
#pragma unroll
        for (int q = 0; q < 4; ++q) { const f32x4 c0 = *(const f32x4*)(CB + 8 * q), c1 = *(const f32x4*)(CB + 32 + 8 * q);
#pragma unroll
            for (int i = 0; i < 4; ++i) { p0[4 * q + i] = (ONLINE ? 0.f : ctb) - c0[i]; p1[4 * q + i] = (ONLINE ? 0.f : ctb) - c1[i]; } }
    } else {
#pragma unroll
        for (int i = 0; i < 16; ++i) { p0[i] = ONLINE ? 0.f : -bref; p1[i] = ONLINE ? 0.f : -bref; }
    }
#pragma unroll
    for (int d0 = 0; d0 < 4; ++d0) {
        const bf16x8 k0 = *(const bf16x8*)(KB + x.r32 * 72 + d0 * 16 + x.hi * 8);
        const bf16x8 k1 = *(const bf16x8*)(KB + (32 + x.r32) * 72 + d0 * 16 + x.hi * 8);
        p0 = __builtin_amdgcn_mfma_f32_32x32x16_bf16(k0, x.qr[d0], p0, 0, 0, 0);
        p1 = __builtin_amdgcn_mfma_f32_32x32x16_bf16(k1, x.qr[d0], p1, 0, 0, 0);
    }
    const float NEG = -INFINITY;
    const int kb = 64 * j + 4 * x.hi;
#define KK(r) (kb + ((r) & 3) + 8 * ((r) >> 2))
    if (MODE == 3) {
        if (64 * j + 63 > wtokmin) {
#pragma unroll
            for (int r = 0; r < 16; ++r) { const int kk = KK(r); if (kk > x.tok) p0[r] = NEG; if (kk + 32 > x.tok) p1[r] = NEG; }
        }
    } else if (MODE == 0) {
#pragma unroll
        for (int r = 0; r < 16; ++r) { const int n = KK(r); if (16 * n + 31 > x.tok) p0[r] = NEG; if (16 * (n + 32) + 31 > x.tok) p1[r] = NEG; }
    } else if (MODE == 1) {
        const bool on = (selm >> j) & 1u;
        const bool allon = __ballot(on) == ~0ull;
        if (j == cblk) {
#pragma unroll
            for (int r = 0; r < 16; ++r) { const int kk = KK(r); if (!on || kk > x.tok) p0[r] = NEG; if (!on || kk + 32 > x.tok) p1[r] = NEG; }
        } else if (!allon) {
#pragma unroll
            for (int r = 0; r < 16; ++r) { if (!on) { p0[r] = NEG; p1[r] = NEG; } }
        }
    } else {
        if (j == cblk) {
#pragma unroll
            for (int r = 0; r < 16; ++r) { const int kk = KK(r); if (kk > x.tok) p0[r] = NEG; if (kk + 32 > x.tok) p1[r] = NEG; }
        } else if (j == cblk - 8) {
#pragma unroll
            for (int r = 0; r < 16; ++r) { const int kk = KK(r); if (x.tok - kk >= 512) p0[r] = NEG; if (x.tok - kk - 32 >= 512) p1[r] = NEG; }
        }
    }
#undef KK
    if (ONLINE) {
        float mx = fmaxf(p0[0], p1[0]);
#pragma unroll
        for (int r = 1; r < 16; ++r) mx = fmaxf(mx, fmaxf(p0[r], p1[r]));
        mx = fmaxf(mx, __shfl_xor(mx, 32));
        const float mn = fmaxf(m, mx);
        if (__any(mn > m)) {
            const float sc = __builtin_amdgcn_exp2f(m - mn); l *= sc;
#pragma unroll
            for (int r = 0; r < 16; ++r) { oT[0][r] *= sc; oT[1][r] *= sc; }
        }
        m = mn;
#pragma unroll
        for (int r = 0; r < 16; ++r) { p0[r] -= mn; p1[r] -= mn; }
    }
    f32x2_t ls2 = {0.f, 0.f};
#pragma unroll
    for (int r = 0; r < 16; r += 2) { p0[r] = __builtin_amdgcn_exp2f(p0[r]); p0[r + 1] = __builtin_amdgcn_exp2f(p0[r + 1]); p1[r] = __builtin_amdgcn_exp2f(p1[r]); p1[r + 1] = __builtin_amdgcn_exp2f(p1[r + 1]);
        ls2 += (f32x2_t){p0[r], p0[r + 1]}; ls2 += (f32x2_t){p1[r], p1[r + 1]}; }
    l += ls2[0] + ls2[1];
    bf16x8 pf[4];
#pragma unroll
    for (int s = 0; s < 2; ++s) {
        u32x4 a0, a1;
#pragma unroll
        for (int i = 0; i < 4; ++i) { a0[i] = cvtpk(p0[8 * s + 2 * i], p0[8 * s + 2 * i + 1]); a1[i] = cvtpk(p1[8 * s + 2 * i], p1[8 * s + 2 * i + 1]); }
        pf[s] = __builtin_bit_cast(bf16x8, a0); pf[2 + s] = __builtin_bit_cast(bf16x8, a1);
    }
    const LAS3 unsigned char* vp = (const LAS3 unsigned char*)(lds + A_VB) + cur * 8192 + ((lane >> 4) & 1) * 32 + (lane & 3) * 8 + (4 * x.hi + ((lane & 15) >> 2)) * 64;
#pragma unroll
    for (int dh = 0; dh < 2; ++dh)
#pragma unroll
        for (int ks = 0; ks < 4; ++ks) {
            const v4i16_t lo = vtr(vp + dh * 4096 + ks * 1024), hi4 = vtr(vp + dh * 4096 + ks * 1024 + 512);
            const bf16x8 vf = (bf16x8){lo[0], lo[1], lo[2], lo[3], hi4[0], hi4[1], hi4[2], hi4[3]};
            oT[dh] = __builtin_amdgcn_mfma_f32_32x32x16_bf16(vf, pf[ks], oT[dh], 0, 0, 0);
        }
}

template <int MODE, bool ONLINE>
DI void attn_branch(unsigned char* lds, const bf16_t* Kg, int kp, const bf16_t* Vg, int vp, const float* Cg, int kgofs, unsigned tiles,
                    const ACtx& x, unsigned selm, int cblk, int wtokmin, int wtokmax, float bref, float ctb, f32x16 (&oT)[2], float& m, float& l) {
    const int tid = x.tid, srow = tid >> 3, sc8 = tid & 7;
    bf16_t* KB = (bf16_t*)(lds + A_KB); unsigned char* VB = lds + A_VB; float* CB = (float*)(lds + A_CB);
    const int kofs = srow * 72 + sc8 * 8, vofs = ((sc8 >> 2) * 4 + (srow >> 4)) * 1024 + (srow & 15) * 64 + (sc8 & 3) * 16;
    unsigned rem = tiles; if (!rem) return;
    u32x4 krA, vrA, krB, vrB; f32x4 crA = {0.f, 0.f, 0.f, 0.f}, crB = {0.f, 0.f, 0.f, 0.f};
#define POP(jv) do { jv = -1; if (rem) { jv = __builtin_ctz(rem); rem &= rem - 1; } } while (0)
#define LOADT(jj, kr, vr, cr) do { kr = *(const u32x4*)(Kg + (size_t)(64 * (jj) + srow) * kp + sc8 * 8); vr = *(const u32x4*)(Vg + (size_t)(64 * (jj) + srow) * vp + sc8 * 8); \
        if (MODE == 3 && tid < 16) cr = *(const f32x4*)(Cg + 64 * (jj) + tid * 4); } while (0)
#define STORET(buf, kr, vr, cr) do { *(u32x4*)(KB + (buf) * 4608 + kofs) = kr; *(u32x4*)(VB + (buf) * 8192 + vofs) = vr; if (MODE == 3 && tid < 16) *(f32x4*)(CB + (buf) * 64 + tid * 4) = cr; } while (0)
#define ACTIVE(jj) ((MODE == 1) ? (__ballot((selm >> (jj)) & 1u) != 0ull) : ((MODE == 3) ? (64 * (jj) <= wtokmax) : true))
    int j0, j1, j2, j3;
    POP(j0); LOADT(j0, krA, vrA, crA); STORET(0, krA, vrA, crA);
    POP(j1); if (j1 >= 0) LOADT(j1, krA, vrA, crA);
    __syncthreads();
    int cur = 0;
    for (;;) {
        POP(j2); if (j2 >= 0) LOADT(j2, krB, vrB, crB);
        if (ACTIVE(j0)) attn_tile_compute<MODE, ONLINE>(lds, cur, j0, x, selm, cblk, wtokmin, bref, ctb, oT, m, l);
        if (j1 >= 0) STORET(cur ^ 1, krA, vrA, crA);
        __syncthreads();
        if (j1 < 0) break;
        cur ^= 1;
        POP(j3); if (j3 >= 0) LOADT(j3, krA, vrA, crA);
        if (ACTIVE(j1)) attn_tile_compute<MODE, ONLINE>(lds, cur, j1, x, selm, cblk, wtokmin, bref, ctb, oT, m, l);
        if (j2 >= 0) STORET(cur ^ 1, krB, vrB, crB);
        __syncthreads();
        if (j2 < 0) break;
        cur ^= 1; j0 = j2; j1 = j3;
    }
#undef POP
#undef ACTIVE
#undef LOADT
#undef STORET
}
DI void zero_o(f32x16 (&oT)[2]) {
#pragma unroll
    for (int r = 0; r < 16; ++r) { oT[0][r] = 0.f; oT[1][r] = 0.f; }
}

template <bool ONLINE> DI void nsa_unit(const Args& a, int l, unsigned char* lds, int b, int g, int c) {
    unsigned char* ws = a.ws;
    const bf16_t* P = (const bf16_t*)(ws + WS_P); bf16_t* Y = (bf16_t*)(ws + WS_HY); const float* GL = (const float*)(ws + WS_GL);
    ACtx x; x.tid = threadIdx.x; asm volatile("" : "+v"(x.tid));
    const int lane = x.tid & 63, wid = __builtin_amdgcn_readfirstlane(x.tid >> 6); x.r32 = lane & 31; x.hi = lane >> 5;
    const int hq = 4 * g + (wid & 3), tokl = 32 * (wid >> 2) + x.r32; x.tok = 64 * c + tokl;
    const size_t row = (size_t)(b * SEQ + x.tok);
    load_q(x, P + row * PP + C_NQ + hq * 64);
#define GATE(k) sigmoidf_(GL[row * 32 + hq * 3 + (k)] + a.in[I_GB][l * 24 + hq * 3 + (k)])
    float* IG = (float*)(lds + A_IG); float* IL = (float*)(lds + A_IL); unsigned* SELM = (unsigned*)(lds + A_SELM); unsigned* UN = (unsigned*)(lds + A_UN);
    if (x.tid == 0) UN[0] = 0u;
    f32x16 oT[2], tot[2]; zero_o(oT); zero_o(tot);
    float m = -1e30f, ls = 0.f;
    const float* bnd = (const float*)(ws + WS_BND) + l * 4;
    const float b_cmp = bnd[0], b_slc = bnd[1], b_win = bnd[2];
    constexpr bool online = ONLINE;
#define BRANCH(MODE, ...) do { attn_branch<MODE, ONLINE>(__VA_ARGS__); } while (0)
    const bf16_t* KC = (const bf16_t*)(ws + WS_KCMP) + (size_t)(b * 2 + g) * 128 * 64; const bf16_t* VC = (const bf16_t*)(ws + WS_VCMP) + (size_t)(b * 2 + g) * 128 * 64;
    const int ncmpt = c >= 16 ? 2 : 1;
    BRANCH(0, lds, KC, 64, VC, 64, nullptr, 0, c >= 16 ? 3u : 1u, x, 0u, c, 0, 0, b_cmp, 0.f, oT, m, ls);
    const float cref = online ? m : b_cmp;
    {   float lt = ls + __shfl_xor(ls, 32); const float inv = lt > 0.f ? 1.f / lt : 0.f; const float g0 = GATE(0);
#pragma unroll
        for (int r = 0; r < 16; ++r) { tot[0][r] = oT[0][r] * (inv * g0); tot[1][r] = oT[1][r] * (inv * g0); }
        for (int tt = 0; tt < ncmpt; ++tt) {
            const bf16_t* KB = (const bf16_t*)(lds + A_KB) + tt * 4608;
            f32x16 p0, p1;
#pragma unroll
            for (int i = 0; i < 16; ++i) { p0[i] = -cref; p1[i] = -cref; }
#pragma unroll
            for (int d0 = 0; d0 < 4; ++d0) {
                const bf16x8 k0 = *(const bf16x8*)(KB + x.r32 * 72 + d0 * 16 + x.hi * 8); const bf16x8 k1 = *(const bf16x8*)(KB + (32 + x.r32) * 72 + d0 * 16 + x.hi * 8);
                p0 = __builtin_amdgcn_mfma_f32_32x32x16_bf16(k0, x.qr[d0], p0, 0, 0, 0); p1 = __builtin_amdgcn_mfma_f32_32x32x16_bf16(k1, x.qr[d0], p1, 0, 0, 0);
            }
            const int kb = 64 * tt + 4 * x.hi;
#pragma unroll
            for (int r = 0; r < 16; ++r) { const int n = kb + (r & 3) + 8 * (r >> 2);
                p0[r] = (16 * n + 31 <= x.tok) ? __builtin_amdgcn_exp2f(p0[r]) * inv : 0.f; p1[r] = (16 * (n + 32) + 31 <= x.tok) ? __builtin_amdgcn_exp2f(p1[r]) * inv : 0.f; }
            float* ig = IG + ((wid & 3) * 64 + tokl) * 33; float* il = IL + ((wid & 3) * 64 + tokl) * 33;
#pragma unroll
            for (int q = 0; q < 4; ++q) { const int jj = 16 * tt + 2 * q + x.hi;
                ig[jj] = p0[4 * q] + p0[4 * q + 1] + p0[4 * q + 2] + p0[4 * q + 3]; il[jj] = p0[4 * q + 3];
                ig[jj + 8] = p1[4 * q] + p1[4 * q + 1] + p1[4 * q + 2] + p1[4 * q + 3]; il[jj + 8] = p1[4 * q + 3]; }
        }
    }
    __syncthreads();
    {   int j = lane & 31; asm volatile("" : "+v"(j));
        unsigned wor = 0u;
#pragma unroll
        for (int it = 0; it < 4; ++it) {
            const int tl = 8 * wid + 2 * it + (lane >> 5);
            float imp = 0.f;
#pragma unroll
            for (int h4 = 0; h4 < 4; ++h4) { imp += IG[(h4 * 64 + tl) * 33 + j]; if (j > 0) imp += IL[(h4 * 64 + tl) * 33 + j - 1]; }
            const bool valid = j <= c, forced = (j == 0) || (j == c) || (j == c - 1);
            const float score = !valid ? -1e30f : (forced ? 1e9f : imp);
            float* scw = (float*)(lds + A_SC) + wid * 64;
            scw[lane] = score;
            __builtin_amdgcn_s_waitcnt(0xc07f); __builtin_amdgcn_wave_barrier();
            int rank = 0;
#pragma unroll
            for (int k4 = 0; k4 < 8; ++k4) { const f32x4 sk = *(const f32x4*)(scw + (lane & 32) + 4 * k4);
#pragma unroll
                for (int i = 0; i < 4; ++i) rank += (sk[i] > score) || (sk[i] == score && 4 * k4 + i < j); }
            __builtin_amdgcn_wave_barrier();
            const unsigned long long bal = __ballot(valid && rank < 16);
            const unsigned mine = (lane >> 5) ? (unsigned)(bal >> 32) : (unsigned)bal;
            if (j == 0) SELM[tl] = mine;
            wor |= (unsigned)bal | (unsigned)(bal >> 32);
        }
        if (lane == 0) atomicOr(UN, wor);
    }
    __syncthreads();
    const unsigned selm = SELM[tokl]; const unsigned un = UN[0];
    float* TOT = (float*)(lds + A_IG) + wid * 2048 + lane;
#pragma unroll
    for (int r = 0; r < 16; ++r) { TOT[r * 64] = tot[0][r]; TOT[(16 + r) * 64] = tot[1][r]; }
    zero_o(oT); m = -1e30f; ls = 0.f;
    BRANCH(1, lds, P + (size_t)b * SEQ * PP + C_KS + g * 64, PP, P + (size_t)b * SEQ * PP + C_VS + g * 64, PP, nullptr, 0, un, x, selm, c, 0, 0, b_slc, 0.f, oT, m, ls);
    {   float lt = ls + __shfl_xor(ls, 32); const float inv = lt > 0.f ? GATE(1) / lt : 0.f;
#pragma unroll
        for (int r = 0; r < 16; ++r) { TOT[r * 64] += oT[0][r] * inv; TOT[(16 + r) * 64] += oT[1][r] * inv; } }
    zero_o(oT); m = -1e30f; ls = 0.f;
    {   const int jlo = c >= 8 ? c - 8 : 0; const unsigned wt = (c >= 31 ? 0xffffffffu : ((1u << (c + 1)) - 1u)) & ~((1u << jlo) - 1u);
        BRANCH(2, lds, P + (size_t)b * SEQ * PP + C_KW + g * 64, PP, P + (size_t)b * SEQ * PP + C_VW + g * 64, PP, nullptr, 64, wt, x, 0u, c, 0, 0, b_win, 0.f, oT, m, ls); }
    {   float lt = ls + __shfl_xor(ls, 32); const float inv = lt > 0.f ? GATE(2) / lt : 0.f;
#pragma unroll
        for (int r = 0; r < 16; ++r) { tot[0][r] = TOT[r * 64] + oT[0][r] * inv; tot[1][r] = TOT[(16 + r) * 64] + oT[1][r] * inv; } }
#pragma unroll
    for (int dh = 0; dh < 2; ++dh)
#pragma unroll
        for (int q = 0; q < 4; ++q) {
            const int d = 32 * dh + 8 * q + 4 * x.hi;
            const u32x2 zz = *(const u32x2*)(P + row * PP + C_NZ + hq * 64 + d);
            const float z0 = bf2f(zz[0] & 0xffffu), z1 = bf2f(zz[0] >> 16), z2 = bf2f(zz[1] & 0xffffu), z3 = bf2f(zz[1] >> 16);
            u32x2 o; o[0] = cvtpk(tot[dh][4 * q] * siluf_(z0), tot[dh][4 * q + 1] * siluf_(z1)); o[1] = cvtpk(tot[dh][4 * q + 2] * siluf_(z2), tot[dh][4 * q + 3] * siluf_(z3));
            *(u32x2*)(Y + row * DMIX + 512 + hq * 64 + d) = o;
        }
}

template <bool ONLINE> DI void fox_unit(const Args& a, int l, unsigned char* lds, int b, int h, int c) {
    unsigned char* ws = a.ws;
    const bf16_t* P = (const bf16_t*)(ws + WS_P); bf16_t* Y = (bf16_t*)(ws + WS_HY);
    ACtx x; x.tid = threadIdx.x; asm volatile("" : "+v"(x.tid));
    const int lane = x.tid & 63, wid = __builtin_amdgcn_readfirstlane(x.tid >> 6); x.r32 = lane & 31; x.hi = lane >> 5;
    x.tok = 256 * c + 32 * wid + x.r32;
    const size_t row = (size_t)(b * SEQ + x.tok);
    load_q(x, P + row * PP + C_FQ + h * 64);
    const float* c2 = (const float*)(ws + WS_C2) + (size_t)(b * 8 + h) * SEQ;
    f32x16 oT[2]; zero_o(oT); float m = -1e30f, ls = 0.f;
    const int ntile = 4 * c + 4; const unsigned tiles = ntile >= 32 ? 0xffffffffu : ((1u << ntile) - 1u);
    unsigned tiles_ = tiles;
    if (!ONLINE) {
        const float cj = c2[64 * (lane & 31) + 63], c0 = c2[256 * c];
        tiles_ &= ~(unsigned)__ballot((lane < 32) && (c0 - cj <= -152.f));
    }
    const float b_fox = ((const float*)(ws + WS_BND))[l * 4 + 3]; const float ctb = c2[x.tok] - b_fox;
    attn_branch<3, ONLINE>(lds, P + (size_t)b * SEQ * PP + C_FK + h * 64, PP, P + (size_t)b * SEQ * PP + C_FV + h * 64, PP, c2, 0, tiles_, x, 0u, 0, 256 * c + 32 * wid, 256 * c + 32 * wid + 31, b_fox, ctb, oT, m, ls);
    float lt = ls + __shfl_xor(ls, 32); const float inv = lt > 0.f ? 1.f / lt : 0.f;
#pragma unroll
    for (int dh = 0; dh < 2; ++dh)
#pragma unroll
        for (int q = 0; q < 4; ++q) {
            const int d = 32 * dh + 8 * q + 4 * x.hi;
            const u32x2 zz = *(const u32x2*)(P + row * PP + C_FZ + h * 64 + d);
            const float z0 = bf2f(zz[0] & 0xffffu), z1 = bf2f(zz[0] >> 16), z2 = bf2f(zz[1] & 0xffffu), z3 = bf2f(zz[1] >> 16);
            u32x2 o; o[0] = cvtpk(oT[dh][4 * q] * inv * siluf_(z0), oT[dh][4 * q + 1] * inv * siluf_(z1)); o[1] = cvtpk(oT[dh][4 * q + 2] * inv * siluf_(z2), oT[dh][4 * q + 3] * inv * siluf_(z3));
            *(u32x2*)(Y + row * DMIX + 1024 + h * 64 + d) = o;
        }
}


constexpr int L_WA = 0, L_WX = 9216, L_XB = 18432, L_XF = 27648, L_G = 44032, L_SA = L_G + 2 * 64 * 65 * 4, L_SB = L_SA + 2048, L_CY = L_SB + 2048, L_END = L_CY + 512;
static_assert(L_END <= LDS_BYTES, "LRU LDS map");
DI float fsig(float x) { return __builtin_amdgcn_rcpf(1.f + __expf(-x)); }
DI float neg_expm1(float x, float ex) {
    const float t = x * (1.f + x * (0.5f + x * (0.16666667f + x * (0.041666668f + x * (0.0083333338f + x * 0.0013888889f)))));
    return (x > -0.25f) ? -t : 1.f - ex;
}
DI void lru_unit(const Args& a, int l, unsigned char* lds, int b, int h) {
    unsigned char* ws = a.ws;
    const bf16_t* P = (const bf16_t*)(ws + WS_P); bf16_t* Y = (bf16_t*)(ws + WS_HY);
    int tid = threadIdx.x; asm volatile("" : "+v"(tid));
    const int lane = tid & 63, wid = __builtin_amdgcn_readfirstlane(tid >> 6);
    bf16_t* WAl = (bf16_t*)(lds + L_WA); bf16_t* WXl = (bf16_t*)(lds + L_WX); bf16_t* XB = (bf16_t*)(lds + L_XB);
    float* XF = (float*)(lds + L_XF); float* G = (float*)(lds + L_G); float* SA = (float*)(lds + L_SA); float* SB = (float*)(lds + L_SB); float* CY = (float*)(lds + L_CY);
    __syncthreads();
    {   const int r = tid >> 3, c8 = (tid & 7) * 8;
        *(u32x4*)(WAl + r * 72 + c8) = *(const u32x4*)((const bf16_t*)(ws + WS_WA) + (size_t)(l * 8 + h) * 4096 + r * 64 + c8);
        *(u32x4*)(WXl + r * 72 + c8) = *(const u32x4*)((const bf16_t*)(ws + WS_WX) + (size_t)(l * 8 + h) * 4096 + r * 64 + c8);
        if (tid < 128) CY[tid] = 0.f; }
    const int tk1 = tid >> 3, c8 = (tid & 7) * 8, chb = h * 64 + c8;
    float cw[4][8], cb8[8];
#pragma unroll
    for (int i = 0; i < 8; ++i) { cb8[i] = a.in[I_CB][l * 512 + chb + i];
#pragma unroll
        for (int k = 0; k < 4; ++k) cw[k][i] = a.in[I_CW][(l * 4 + k) * 512 + chb + i]; }
    const int ch = tid & 63, sg = tid >> 6, chg = h * 64 + ch;
    const float ba = a.in[I_BA][l * 512 + chg], bx = a.in[I_BX][l * 512 + chg], lam = a.in[I_LAM][l * 512 + chg];
    const float sp8 = -8.f * (fmaxf(-lam, 0.f) + log1pf(__expf(-fabsf(lam))));
    const int fr = lane & 15, fq = lane >> 4, mat = wid >> 2, strip = wid & 3;
    const bf16_t* pu = P + (size_t)b * SEQ * PP + C_U + chb;
    u32x4 ur[4];
#pragma unroll
    for (int k = 0; k < 4; ++k) { const int t = tk1 - 3 + k; ur[k] = (t >= 0) ? *(const u32x4*)(pu + (size_t)t * PP) : (u32x4){0u, 0u, 0u, 0u}; }
    for (int tile = 0; tile < SEQ / 64; ++tile) {
        const int t0 = tile * 64;
        {   float xc[8];
#pragma unroll
            for (int i = 0; i < 8; ++i) xc[i] = cb8[i];
#pragma unroll
            for (int k = 0; k < 4; ++k) { float uf[8]; unpack8(ur[k], uf);
#pragma unroll
                for (int i = 0; i < 8; ++i) xc[i] += cw[k][i] * uf[i]; }
            *(f32x4*)(XF + tk1 * 64 + c8) = (f32x4){xc[0], xc[1], xc[2], xc[3]}; *(f32x4*)(XF + tk1 * 64 + c8 + 4) = (f32x4){xc[4], xc[5], xc[6], xc[7]};
            u32x4 pk; pk[0] = pk2(xc[0], xc[1]); pk[1] = pk2(xc[2], xc[3]); pk[2] = pk2(xc[4], xc[5]); pk[3] = pk2(xc[6], xc[7]);
            *(u32x4*)(XB + tk1 * 72 + c8) = pk;
            if (tile + 1 < SEQ / 64) {
#pragma unroll
                for (int k = 0; k < 4; ++k) ur[k] = *(const u32x4*)(pu + (size_t)(t0 + 64 + tk1 - 3 + k) * PP);
            }
        }
        __syncthreads();
        {   const bf16_t* W = mat ? WXl : WAl;
            f32x4 acc[4];
#pragma unroll
            for (int nt = 0; nt < 4; ++nt) acc[nt] = (f32x4){0.f, 0.f, 0.f, 0.f};
#pragma unroll
            for (int ks = 0; ks < 2; ++ks) {
                const bf16x8 af = *(const bf16x8*)(XB + (16 * strip + fr) * 72 + ks * 32 + fq * 8);
#pragma unroll
                for (int nt = 0; nt < 4; ++nt) { const bf16x8 bw = *(const bf16x8*)(W + (16 * nt + fr) * 72 + ks * 32 + fq * 8); acc[nt] = __builtin_amdgcn_mfma_f32_16x16x32_bf16(af, bw, acc[nt], 0, 0, 0); }
            }
            float* Gm = G + mat * 64 * 65;
#pragma unroll
            for (int nt = 0; nt < 4; ++nt)
#pragma unroll
                for (int i = 0; i < 4; ++i) Gm[(16 * strip + 4 * fq + i) * 65 + 16 * nt + fr] = acc[nt][i];
        }
        __syncthreads();
        {   const bf16_t* pz = P + (size_t)(b * SEQ + t0 + sg * 8) * PP + C_Z + chg;
            bf16_t zr[8];
#pragma unroll
            for (int k = 0; k < 8; ++k) zr[k] = pz[(size_t)k * PP];
            float av[8], bv[8]; float A = 1.f, Bc = 0.f;
#pragma unroll
            for (int k = 0; k < 8; ++k) {
                const int tk = sg * 8 + k;
                const float r = __builtin_amdgcn_rcpf(1.f + __builtin_amdgcn_exp2f((G[tk * 65 + ch] + ba) * -LOG2E)), ig = __builtin_amdgcn_rcpf(1.f + __builtin_amdgcn_exp2f((G[64 * 65 + tk * 65 + ch] + bx) * -LOG2E)), xcv = XF[tk * 64 + ch];
                const float la = r * sp8;
                av[k] = __builtin_amdgcn_exp2f(la * LOG2E); bv[k] = __builtin_amdgcn_sqrtf(neg_expm1(2.f * la, av[k] * av[k])) * (ig * xcv);
                Bc = av[k] * Bc + bv[k]; A *= av[k];
            }
            SA[sg * 64 + ch] = A; SB[sg * 64 + ch] = Bc;
            __syncthreads();
            float hs = CY[(tile & 1) * 64 + ch];
            for (int s = 0; s < sg; ++s) hs = SA[s * 64 + ch] * hs + SB[s * 64 + ch];
            bf16_t* py = Y + (size_t)(b * SEQ + t0 + sg * 8) * DMIX + chg;
#pragma unroll
            for (int k = 0; k < 8; ++k) { hs = av[k] * hs + bv[k]; const float zf = bf2f(zr[k]); py[(size_t)k * DMIX] = (bf16_t)f2bf(hs * zf * fsig(zf)); }
            if (sg == 7) CY[((tile & 1) ^ 1) * 64 + ch] = hs;
        }
    }
    __syncthreads();
}


template <bool ONLINE> DI void phase_mix(const Args& a, int l, unsigned char* lds, int cofs = 0, bool only_lru = false) {
    unsigned* ctr = (unsigned*)(a.ws + WS_CTL) + l * 16 + cofs;
    volatile int* UNIT = (volatile int*)(lds + A_UNIT);
    if (blockIdx.x < 128) lru_unit(a, l, lds, blockIdx.x >> 3, blockIdx.x & 7);
    if (only_lru) return;
    __syncthreads();
    if (threadIdx.x == 0) UNIT[0] = (int)atomicAdd(ctr, 1u);
    __syncthreads();
    for (int u = UNIT[0]; u < 1024; ) {
        int nxt = 0; if (threadIdx.x == 0) nxt = (int)atomicAdd(ctr, 1u);
        nsa_unit<ONLINE>(a, l, lds, (u & 31) >> 1, u & 1, 31 - (u >> 5));
        if (threadIdx.x == 0) UNIT[0] = nxt;
        __syncthreads();
        u = UNIT[0];
    }
    __syncthreads();
    if (threadIdx.x == 0) UNIT[0] = (int)atomicAdd(ctr + 1, 1u);
    __syncthreads();
    for (int u = UNIT[0]; u < 1024; ) {
        int nxt = 0; if (threadIdx.x == 0) nxt = (int)atomicAdd(ctr + 1, 1u);
        fox_unit<ONLINE>(a, l, lds, (u & 127) >> 3, u & 7, 7 - (u >> 7));
        if (threadIdx.x == 0) UNIT[0] = nxt;
        __syncthreads();
        u = UNIT[0];
    }
}

#define XB_TMO      128
#define XB_XCNT(j)  (256  + 64 * (j))
#define XB_XSUB(j)  (1280 + 64 * (j))
#define XB_XGEN(j)  (2304 + 64 * (j))
#define XB_TOP      3328
#define XB_TOPGEN   3392
#define XCD_BAR_WORDS 3456
#define XB_SPIN_CAP (1u << 18)
DI unsigned xb_ld(unsigned* p)              { return __hip_atomic_load(p, __ATOMIC_RELAXED, __HIP_MEMORY_SCOPE_AGENT); }
DI unsigned xb_add(unsigned* p, unsigned v) { return __hip_atomic_fetch_add(p, v, __ATOMIC_RELAXED, __HIP_MEMORY_SCOPE_AGENT); }
DI unsigned xb_xcc_id() { return (unsigned)__builtin_amdgcn_s_getreg((3 << 11) | 20) & 0xFu; }
#define XB_SPIN(cond, bar) do { unsigned _sp = 0; while (cond) { __builtin_amdgcn_s_sleep(1); \
    if ((++_sp & 255u) == 0u) { if (xb_ld(&(bar)[XB_TMO])) break; if (_sp > XB_SPIN_CAP) { atomicAdd(&(bar)[XB_TMO], 1u); break; } } } } while (0)
struct XcdBarrier { unsigned* bar; unsigned x; volatile LAS3 unsigned* st; };
DI XcdBarrier xcd_barrier_post(unsigned* bar, volatile LAS3 unsigned* st) {
    XcdBarrier b; b.bar = bar; b.x = xb_xcc_id(); b.st = st;
    if (threadIdx.x == 0) (void)xb_add(&bar[XB_XCNT(b.x)], 1u);
    return b;
}
DI void xcd_barrier_complete(unsigned* bar, unsigned x, unsigned& nloc, unsigned& nx) {
    const unsigned G = gridDim.x * gridDim.y * gridDim.z;
    unsigned sum, cnt, mine, sp = 0u;
    for (;;) {
        sum = 0u; cnt = 0u; mine = 0u;
#pragma unroll
        for (unsigned j = 0; j < 16; ++j) { const unsigned c = xb_ld(&bar[XB_XCNT(j)]); sum += c; cnt += (c > 0u) ? 1u : 0u; mine = (j == x) ? c : mine; }
        if (sum == G) break;
        __builtin_amdgcn_s_sleep(1);
        if ((++sp & 255u) == 0u) { if (xb_ld(&bar[XB_TMO])) break; if (sp > XB_SPIN_CAP) { atomicAdd(&bar[XB_TMO], 1u); break; } }
    }
    nloc = mine > 0u ? mine : 1u; nx = cnt > 0u ? cnt : 1u;
}
DI void xcd_barrier(const XcdBarrier& b) {
    asm volatile("s_waitcnt vmcnt(0)" ::: "memory");
    __syncthreads();
    if (threadIdx.x == 0) {
        unsigned* bar = b.bar;
        __builtin_amdgcn_s_waitcnt(0);
        unsigned nloc = b.st[0], nx = b.st[1];
        if (nloc == 0u) { xcd_barrier_complete(bar, b.x, nloc, nx); b.st[0] = nloc; b.st[1] = nx; }
        const unsigned old = xb_add(&bar[XB_XSUB(b.x)], 1u);
        const unsigned gen = old / nloc;
        if (old + 1u == (gen + 1u) * nloc) {
            __builtin_amdgcn_fence(__ATOMIC_RELEASE, "agent");
            asm volatile("s_waitcnt vmcnt(0)" ::: "memory");
            const unsigned og = xb_add(&bar[XB_TOP], 1u);
            const unsigned tg = og / nx;
            if (og + 1u == (tg + 1u) * nx) xb_add(&bar[XB_TOPGEN], 1u);
            else XB_SPIN(xb_ld(&bar[XB_TOPGEN]) == tg, bar);
            __builtin_amdgcn_fence(__ATOMIC_ACQUIRE, "agent");
            xb_add(&bar[XB_XGEN(b.x)], 1u);
            asm volatile("s_waitcnt vmcnt(0)" ::: "memory");
        } else {
            XB_SPIN(xb_ld(&bar[XB_XGEN(b.x)]) == gen, bar);
            __builtin_amdgcn_fence(__ATOMIC_ACQUIRE, "agent");
            asm volatile("s_waitcnt vmcnt(0)" ::: "memory");
        }
    }
    __syncthreads();
}

#ifndef DUP
#define DUP 0
#endif
#define LP_PTRS unsigned char* ws = a.ws; bf16_t* P = (bf16_t*)(ws + WS_P); bf16_t* HY = (bf16_t*)(ws + WS_HY); bf16_t* H = (bf16_t*)(ws + WS_H); float* SS = (float*)(ws + WS_SS); float* GL = (float*)(ws + WS_GL); const float* xin = L ? a.out : a.in[I_X]; (void)P; (void)HY; (void)H; (void)SS; (void)GL; (void)xin
template <int L> DI void layer_phases(const Args& a, const XcdBarrier& bar, unsigned char* lds) {
    {   LP_PTRS; const bf16_t* W = (const bf16_t*)(ws + WS_WIN) + (size_t)L * NPAD * DM;
        pg8::Gemm g{H, W, NT, PP, DM}; pg8::StaticOrder S; S.init(NT, PP, (int)gridDim.x, (int)blockIdx.x);
        pg8::EpiProjF E{P, L ? SS : nullptr, (PG8_LAS float*)((PG8_LAS unsigned char*)lds + pg8::STAGE_BYTES), (const float*)(ws + WS_GAINS) + L * 320}; pg8::gemm_phase<pg8::EpiProjF, pg8::StaticOrder, true, true>((PG8_LAS unsigned char*)lds, g, S, E);
        gates_gemm(H, W + (size_t)PP * DM, GL, L ? SS : nullptr, L == 1);
        if (L == 0) { __syncthreads(); win1_late(a, (float*)lds); }
        if (DUP == 2 && L == 0) { xcd_barrier(bar); pg8::gemm_phase<pg8::EpiProjF, pg8::StaticOrder, true, true>((PG8_LAS unsigned char*)lds, g, S, E); gates_gemm(H, W + (size_t)PP * DM, GL, L ? SS : nullptr, false); } }
    xcd_barrier(bar);
    {   LP_PTRS; prep_cumsum(a, L, (float*)lds); prep_compress(a, L, P); if (L == 0) { __syncthreads(); phase_wprep(a, (float*)lds, 1); }
        if (DUP == 3 && L == 0) { xcd_barrier(bar); prep_cumsum(a, L, (float*)lds); prep_compress(a, L, P); } }
    xcd_barrier(bar);
    {   const float* bnd = (const float*)(a.ws + WS_BND) + L * 4;
        const bool online = fmaxf(fmaxf(bnd[0], bnd[1]), fmaxf(bnd[2], bnd[3])) > 60.f;
        if (online) phase_mix<true>(a, L, lds); else phase_mix<false>(a, L, lds);
        if (DUP == 4 && L == 0) { xcd_barrier(bar); phase_mix<false>(a, L, lds, 4); } }
    xcd_barrier(bar);
    {   LP_PTRS; pg8::Gemm g{HY, (const bf16_t*)(ws + WS_WOUT) + (size_t)L * DM * DMIX, NT, DM, DMIX}; pg8::StaticOrder S; S.init(NT, DM, (int)gridDim.x, (int)blockIdx.x);
        pg8::EpiOutF E{L ? nullptr : a.in[I_X], L ? H : nullptr, L ? a.out : nullptr, L ? nullptr : H, SS}; pg8::gemm_phase<pg8::EpiOutF, pg8::StaticOrder, true, true>((PG8_LAS unsigned char*)lds, g, S, E); }
}
__global__ void __launch_bounds__(512, 2) mk(Args a) {
    extern __shared__ __attribute__((aligned(16))) unsigned char lds[];
    __shared__ unsigned xb_st[2];
    cg::grid_group grid = cg::this_grid();
    if (threadIdx.x < 2) xb_st[threadIdx.x] = 0u;
    __syncthreads();
    const XcdBarrier bar = xcd_barrier_post((unsigned*)(a.ws + WS_CTL + 1024), (volatile LAS3 unsigned*)xb_st);
    phase_wprep(a, (float*)lds, 0);
    phase_rms(a.in[I_X], a.in[I_NG], (bf16_t*)(a.ws + WS_H));
    for (int i = blockIdx.x * 512 + threadIdx.x; i < NT; i += gridDim.x * 512) ((float*)(a.ws + WS_SS))[i] = 0.f;
    if (a.ph_lo < 0) grid.sync();
    xcd_barrier(bar);
    layer_phases<0>(a, bar, lds);
    xcd_barrier(bar);
    layer_phases<1>(a, bar, lds);
}

extern "C" void kernel_launch(void* const* d_in, const int* in_sizes, int n_in, void* d_out, int out_size, void* d_ws, size_t ws_size, hipStream_t stream) {
    static int grid = 0;
    if (grid == 0) {
        if (n_in != 21 || ws_size < WS_END) { fprintf(stderr, "kernel_launch: unexpected n_in %d / ws_size %zu (need %zu)\n", n_in, ws_size, (size_t)WS_END); grid = -1; return; }
        int dev = 0, cus = 0, per_cu = 0;
        (void)hipGetDevice(&dev); (void)hipDeviceGetAttribute(&cus, hipDeviceAttributeMultiprocessorCount, dev);
        (void)hipFuncSetAttribute((const void*)mk, hipFuncAttributeMaxDynamicSharedMemorySize, LDS_BYTES);
        (void)hipOccupancyMaxActiveBlocksPerMultiprocessor(&per_cu, (const void*)mk, 512, LDS_BYTES);
        if (per_cu < 1) { fprintf(stderr, "kernel_launch: occupancy query says %d blocks/CU\n", per_cu); per_cu = 1; }
        if (per_cu > 1) per_cu = 1;
        grid = cus * per_cu;
        (void)hipGetLastError();
    }
    if (grid < 0) return;
    if (hipMemsetAsync((char*)d_ws + WS_CTL, 0, WS_CTL_BYTES, stream) != hipSuccess) { fprintf(stderr, "kernel_launch: memset failed\n"); return; }
    Args a{};
    for (int i = 0; i < 21; ++i) a.in[i] = (const float*)d_in[i];
    a.out = (float*)d_out; a.ws = (unsigned char*)d_ws; a.ph_lo = 0; a.ph_hi = 13;
    void* args[] = {&a};
    hipError_t e = hipLaunchCooperativeKernel((const void*)mk, dim3(grid), dim3(512), args, LDS_BYTES, stream);
    if (e != hipSuccess) fprintf(stderr, "cooperative launch failed: %s (grid %d)\n", hipGetErrorString(e), grid);
}
```
